# Optimizing an MI355X kernel written in HIP

```python
import math
import jax
import jax.numpy as jnp
from jax import lax
import numpy as np

D_MODEL = 1024
BATCH = 8
SEQ = 8192
DEPTH = 2
DEC_BATCH = 4
DEC_SEQ = 4096
PAST_LEN = 128

D_MIX = 1024
D_PLE = 256
GRID_W = 64
ROPE_THETA = 10000.0
EPS = 1e-6
Q_BLOCK = 128
NEG_INF = -1e30

A_HEADS = 4
A_QK_DIM = 32
A_V_DIM = 64
B_HEADS = 4
B_KV_HEADS = 2
B_HEAD_DIM = 64
B_WINDOW = 128
C_HEADS = 4
C_HEAD_DIM = 64
C_MAX_ROWS = 8
C_WIN_COLS = 16
D_HEADS = 4
D_Q_RANK = 256
D_KV_RANK = 128
D_NOPE = 64
D_ROPE = 32
D_V = 64

IN_SIZES = (
    A_HEADS * 2 * A_QK_DIM, A_HEADS * 2 * A_QK_DIM, A_HEADS * A_V_DIM,
    B_HEADS * B_HEAD_DIM, B_KV_HEADS * B_HEAD_DIM, B_KV_HEADS * B_HEAD_DIM,
    C_HEADS * C_HEAD_DIM, C_HEADS * C_HEAD_DIM, C_HEADS * C_HEAD_DIM,
    D_Q_RANK, D_KV_RANK, D_ROPE,
    D_MIX,
)
D_IN = sum(IN_SIZES)

kernel_name = 'hybrid_parallel_head_encoder'


def _split_points():
    pts, acc = [], 0
    for n in IN_SIZES[:-1]:
        acc += n
        pts.append(acc)
    return pts


def rmsnorm(x, g):
    xf = x.astype(jnp.float32)
    y = xf * lax.rsqrt(jnp.mean(xf * xf, axis=-1, keepdims=True) + EPS)
    return (y * g.astype(jnp.float32)).astype(x.dtype)


def rope_tables(n, dim):
    inv = 1.0 / (ROPE_THETA ** (jnp.arange(0, dim, 2, dtype=jnp.float32) / dim))
    ang = jnp.arange(n, dtype=jnp.float32)[:, None] * inv[None, :]
    return jnp.cos(ang), jnp.sin(ang)


def apply_rope(x, cos, sin):
    half = x.shape[-1] // 2
    xf = x.astype(jnp.float32)
    x1, x2 = xf[..., :half], xf[..., half:]
    c, sn = cos[:, None, :], sin[:, None, :]
    return jnp.concatenate([x1 * c - x2 * sn, x2 * c + x1 * sn], axis=-1).astype(x.dtype)


def sweep_query_blocks(fn, *qs):
    b, s = qs[0].shape[:2]
    nb = s // Q_BLOCK
    blk = tuple(jnp.moveaxis(q.reshape((b, nb, Q_BLOCK) + q.shape[2:]), 1, 0) for q in qs)
    out = lax.map(lambda a: fn(*a), blk)
    out = jnp.moveaxis(out, 0, 1)
    return out.reshape((b, s) + out.shape[3:])


def diff_attention(q, k, v, lam_vecs, lam_init, subln_g, cos, sin):
    b, s = q.shape[:2]
    q = apply_rope(q.reshape(b, s, A_HEADS * 2, A_QK_DIM), cos, sin).reshape(b, s, A_HEADS, 2, A_QK_DIM)
    k = apply_rope(k.reshape(b, s, A_HEADS * 2, A_QK_DIM), cos, sin).reshape(b, s, A_HEADS, 2, A_QK_DIM)
    lv = lam_vecs.astype(jnp.float32)
    lam = jnp.exp(jnp.sum(lv[0] * lv[1])) - jnp.exp(jnp.sum(lv[2] * lv[3])) + lam_init
    scale = A_QK_DIM ** -0.5

    def block(qb):
        sc = jnp.einsum('bqhmd,bkhmd->bhmqk', qb, k).astype(jnp.float32) * scale
        pr = jax.nn.softmax(sc, axis=-1)
        pr = pr[:, :, 0] - lam * pr[:, :, 1]
        return jnp.einsum('bhqk,bkhd->bqhd', pr.astype(v.dtype), v)

    o = sweep_query_blocks(block, q)
    o = rmsnorm(o, subln_g) * (1.0 - lam_init)
    return o.reshape(b, s, A_HEADS * A_V_DIM)


def window_gqa(q, k, v, sink, cos, sin):
    b, s = q.shape[:2]
    g = B_HEADS // B_KV_HEADS
    w = B_WINDOW
    nb = s // w
    q = apply_rope(q, cos, sin)
    k = apply_rope(k, cos, sin)

    def band(t):
        tb = jnp.pad(t, ((0, 0), (w, w), (0, 0), (0, 0))).reshape(b, nb + 2, w, B_KV_HEADS, B_HEAD_DIM)
        return jnp.concatenate([tb[:, :-2], tb[:, 1:-1], tb[:, 2:]], axis=2)

    kb, vb = band(k), band(v)
    qb = q.reshape(b, nb, w, B_KV_HEADS, g, B_HEAD_DIM)
    sc = jnp.einsum('bnqkgd,bnckd->bnkgqc', qb, kb).astype(jnp.float32) * (B_HEAD_DIM ** -0.5)
    rel = jnp.arange(3 * w)[None, :] - w - jnp.arange(w)[:, None]
    key_pos = jnp.arange(nb)[:, None] * w - w + jnp.arange(3 * w)[None, :]
    valid = (jnp.abs(rel) <= w)[None] & ((key_pos >= 0) & (key_pos < s))[:, None, :]
    sc = jnp.where(valid[None, :, None, None], sc, NEG_INF)
    sink_col = jnp.broadcast_to(sink.astype(jnp.float32).reshape(1, 1, B_KV_HEADS, g, 1, 1), sc.shape[:-1] + (1,))
    pr = jax.nn.softmax(jnp.concatenate([sc, sink_col], axis=-1), axis=-1)[..., :-1]
    o = jnp.einsum('bnkgqc,bnckd->bnqkgd', pr.astype(v.dtype), vb)
    return o.reshape(b, s, B_HEADS * B_HEAD_DIM)


def neighbourhood_attention(q, k, v, rpb):
    b, s = q.shape[:2]
    rows = s // GRID_W
    kr = min(C_MAX_ROWS, rows)
    shp = (b, rows, GRID_W, C_HEADS, C_HEAD_DIM)
    qg, kg, vg = q.reshape(shp), k.reshape(shp), v.reshape(shp)
    r = jnp.arange(rows)
    row_idx = jnp.clip(r - kr // 2, 0, rows - kr)[:, None] + jnp.arange(kr)[None, :]
    kw, vw = kg[:, row_idx], vg[:, row_idx]
    sc = jnp.einsum('brqhd,brjchd->bhrqjc', qg, kw).astype(jnp.float32) * (C_HEAD_DIM ** -0.5)
    c = jnp.arange(GRID_W)
    col_start = jnp.clip(c - C_WIN_COLS // 2, 0, GRID_W - C_WIN_COLS)
    col_valid = (c[None, :] >= col_start[:, None]) & (c[None, :] < col_start[:, None] + C_WIN_COLS)
    dr = row_idx - r[:, None] + (C_MAX_ROWS - 1)
    dc = jnp.clip(c[None, :] - c[:, None], -(C_WIN_COLS - 1), C_WIN_COLS - 1) + (C_WIN_COLS - 1)
    bias = rpb.astype(jnp.float32)[:, dr[:, None, :, None], dc[None, :, None, :]]
    sc = jnp.where(col_valid[:, None, :], sc + bias[None], NEG_INF)
    pr = jax.nn.softmax(sc, axis=(-2, -1))
    o = jnp.einsum('bhrqjc,brjchd->brqhd', pr.astype(v.dtype), vw)
    return o.reshape(b, s, C_HEADS * C_HEAD_DIM)


def mla(c_q, c_kv, k_rope, q_norm_g, kv_norm_g, w_uq, w_ukv, cos, sin):
    b, s = c_q.shape[:2]
    q = (rmsnorm(c_q, q_norm_g) @ w_uq).reshape(b, s, D_HEADS, D_NOPE + D_ROPE)
    kv = (rmsnorm(c_kv, kv_norm_g) @ w_ukv).reshape(b, s, D_HEADS, D_NOPE + D_V)
    q_nope, q_pe = q[..., :D_NOPE], apply_rope(q[..., D_NOPE:], cos, sin)
    k_nope, v = kv[..., :D_NOPE], kv[..., D_NOPE:]
    k_pe = apply_rope(k_rope.reshape(b, s, 1, D_ROPE), cos, sin)[:, :, 0]
    scale = (D_NOPE + D_ROPE) ** -0.5

    def block(qn, qp):
        sc = (jnp.einsum('bqhd,bkhd->bhqk', qn, k_nope).astype(jnp.float32)
              + jnp.einsum('bqhd,bkd->bhqk', qp, k_pe).astype(jnp.float32)) * scale
        pr = jax.nn.softmax(sc, axis=-1)
        return jnp.einsum('bhqk,bkhd->bqhd', pr.astype(v.dtype), v)

    o = sweep_query_blocks(block, q_nope, q_pe)
    return o.reshape(b, s, D_HEADS * D_V)


def trunk(x, p, norm_g, w_in, a_lambda, a_subln_g, b_sink, c_rpb, d_q_norm_g, d_kv_norm_g,
          d_w_uq, d_w_ukv, w_out, ple_norm_g, w_ple_gate, w_ple_proj, final_norm_g):
    b, s, _ = x.shape
    cos32, sin32 = rope_tables(s, A_QK_DIM)
    cos64, sin64 = rope_tables(s, B_HEAD_DIM)
    cosd, sind = rope_tables(s, D_ROPE)
    pts = _split_points()
    h = x
    for i in range(DEPTH):
        hn = rmsnorm(h, norm_g[i])
        z = hn @ w_in[i]
        (aq, ak, av, bq, bk, bv, cq, ck, cv, dcq, dckv, dkr, gate) = jnp.split(z, pts, axis=-1)
        lam_init = 0.8 - 0.6 * math.exp(-0.3 * i)
        o_a = diff_attention(aq.reshape(b, s, A_HEADS, 2, A_QK_DIM), ak.reshape(b, s, A_HEADS, 2, A_QK_DIM),
                             av.reshape(b, s, A_HEADS, A_V_DIM), a_lambda[i], lam_init, a_subln_g[i],
                             cos32, sin32)
        o_b = window_gqa(bq.reshape(b, s, B_HEADS, B_HEAD_DIM), bk.reshape(b, s, B_KV_HEADS, B_HEAD_DIM),
                         bv.reshape(b, s, B_KV_HEADS, B_HEAD_DIM), b_sink[i], cos64, sin64)
        o_c = neighbourhood_attention(cq.reshape(b, s, C_HEADS, C_HEAD_DIM), ck.reshape(b, s, C_HEADS, C_HEAD_DIM),
                                      cv.reshape(b, s, C_HEADS, C_HEAD_DIM), c_rpb[i])
        o_d = mla(dcq, dckv, dkr, d_q_norm_g[i], d_kv_norm_g[i], d_w_uq[i], d_w_ukv[i], cosd, sind)
        mix = jnp.concatenate([o_a, o_b, o_c, o_d], axis=-1) * jax.nn.silu(gate)
        h = h + mix @ w_out[i]
        ple_gate = jax.nn.sigmoid(rmsnorm(h, ple_norm_g[i]) @ w_ple_gate[i])
        h = h + ple_gate * (p[i] @ w_ple_proj[i])
    return rmsnorm(h, final_norm_g)


def setup_inputs(seed: int = 0) -> dict:
    key = jax.random.key(seed)
    ks = jax.random.split(key, 19)
    f32 = jnp.float32

    def nrm(k, shape, scale=1.0):
        return jax.random.normal(k, shape, f32) * scale

    def gain(k, shape):
        return 1.0 + 0.05 * jax.random.normal(k, shape, f32)

    return {
        'x_prompt': nrm(ks[0], (BATCH, SEQ, D_MODEL)),
        'x_sample': nrm(ks[1], (DEC_BATCH, DEC_SEQ, D_MODEL)),
        'p_prompt': nrm(ks[2], (DEPTH, BATCH, SEQ, D_PLE)),
        'p_sample': nrm(ks[3], (DEPTH, DEC_BATCH, DEC_SEQ, D_PLE)),
        'norm_g': gain(ks[4], (DEPTH, D_MODEL)),
        'w_in': nrm(ks[5], (DEPTH, D_MODEL, D_IN), D_MODEL ** -0.5),
        'a_lambda': nrm(ks[6], (DEPTH, 4, A_QK_DIM), 0.1),
        'a_subln_g': gain(ks[7], (DEPTH, A_V_DIM)),
        'b_sink': nrm(ks[8], (DEPTH, B_HEADS), 0.5),
        'c_rpb': nrm(ks[9], (DEPTH, C_HEADS, 2 * C_MAX_ROWS - 1, 2 * C_WIN_COLS - 1), 0.1),
        'd_q_norm_g': gain(ks[10], (DEPTH, D_Q_RANK)),
        'd_kv_norm_g': gain(ks[11], (DEPTH, D_KV_RANK)),
        'd_w_uq': nrm(ks[12], (DEPTH, D_Q_RANK, D_HEADS * (D_NOPE + D_ROPE)), D_Q_RANK ** -0.5),
        'd_w_ukv': nrm(ks[13], (DEPTH, D_KV_RANK, D_HEADS * (D_NOPE + D_V)), D_KV_RANK ** -0.5),
        'w_out': nrm(ks[14], (DEPTH, D_MIX, D_MODEL), D_MIX ** -0.5),
        'ple_norm_g': gain(ks[15], (DEPTH, D_MODEL)),
        'w_ple_gate': nrm(ks[16], (DEPTH, D_MODEL, D_MODEL), D_MODEL ** -0.5),
        'w_ple_proj': nrm(ks[17], (DEPTH, D_PLE, D_MODEL), D_PLE ** -0.5),
        'final_norm_g': gain(ks[18], (D_MODEL,)),
    }


def reference(x_prompt, x_sample, p_prompt, p_sample, norm_g, w_in, a_lambda, a_subln_g, b_sink, c_rpb,
              d_q_norm_g, d_kv_norm_g, d_w_uq, d_w_ukv, w_out, ple_norm_g, w_ple_gate, w_ple_proj,
              final_norm_g):
    y_prompt = trunk(x_prompt, p_prompt, norm_g, w_in, a_lambda, a_subln_g, b_sink, c_rpb, d_q_norm_g,
                     d_kv_norm_g, d_w_uq, d_w_ukv, w_out, ple_norm_g, w_ple_gate, w_ple_proj, final_norm_g)
    y_sample = trunk(x_sample, p_sample, norm_g, w_in, a_lambda, a_subln_g, b_sink, c_rpb, d_q_norm_g,
                     d_kv_norm_g, d_w_uq, d_w_ukv, w_out, ple_norm_g, w_ple_gate, w_ple_proj, final_norm_g)
    return (y_prompt, y_sample)
```

```cpp
#include <hip/hip_runtime.h>
#include <hip/hip_cooperative_groups.h>
#include <stdint.h>
#include <stdio.h>
namespace cg = cooperative_groups;

typedef __attribute__((ext_vector_type(8))) short bf16x8;
typedef __attribute__((ext_vector_type(4))) short s16x4;
typedef __attribute__((ext_vector_type(16))) float f32x16;
typedef short v4i16_t __attribute__((ext_vector_type(4)));
typedef __bf16 bf16v2 __attribute__((ext_vector_type(2)));
typedef unsigned short bf16_t;
typedef unsigned u32x4 __attribute__((ext_vector_type(4)));
typedef float f32x2 __attribute__((ext_vector_type(2)));
typedef float f32x4 __attribute__((ext_vector_type(4)));
typedef __attribute__((address_space(3))) unsigned* lds_uptr;
typedef __attribute__((address_space(3))) const char* lds_cptr;

#define DI __device__ __forceinline__
#define MFMA(a, b, c) __builtin_amdgcn_mfma_f32_32x32x16_bf16((a), (b), (c), 0, 0, 0)

constexpr int NTOK = 81920, NPROMPT = 65536, DM = 1024, DIN = 3488, DINP = 3584, ZLD = 3488;
constexpr int Z_AQ = 0, Z_AK = 256, Z_AV = 512, Z_BQ = 768, Z_BK = 1024, Z_BV = 1152, Z_CQ = 1280, Z_CK = 1536, Z_CV = 1792,
              Z_DCQ = 2048, Z_DCKV = 2304, Z_DKR = 2432, Z_GATE = 2464;
constexpr float LOG2E = 1.4426950408889634f;
constexpr float SCALE_A = 0.17677669529663687f * LOG2E;
constexpr float SCALE_B = 0.125f * LOG2E;
constexpr float SCALE_C = 0.125f * LOG2E;
constexpr float SCALE_D = 0.10206207261596575f * LOG2E;
constexpr float EPS = 1e-6f;

constexpr int G_ROWB = 144;
constexpr int G_TILEB = 256 * G_ROWB;
constexpr int SM_RS = 4 * G_TILEB;
constexpr int SM_BIAS = 46080;
constexpr int SMEM_BYTES = SM_RS + 1024;
constexpr int NTHR = 512;

struct Params {
  const float* x_prompt; const float* x_sample; const float* p_prompt; const float* p_sample;
  const float* norm_g; const float* w_in; const float* a_lambda; const float* a_subln_g; const float* b_sink; const float* c_rpb;
  const float* d_q_norm_g; const float* d_kv_norm_g; const float* d_w_uq; const float* d_w_ukv; const float* w_out; const float* ple_norm_g;
  const float* w_ple_gate; const float* w_ple_proj; const float* final_norm_g;
  float* out;
  bf16_t* hn;
  bf16_t* z;
  bf16_t* qd;
  bf16_t* pb;
  bf16_t* kvd;
  bf16_t* winT; bf16_t* wuqT; bf16_t* wukvT; bf16_t* woutT; bf16_t* wpgT; bf16_t* wppT;
  float2* cs32; float2* cs64; float* lam;
};

DI unsigned cvtpk(float lo, float hi) { bf16v2 v = {(__bf16)lo, (__bf16)hi}; return __builtin_bit_cast(unsigned, v); }
DI bf16_t f2bf(float x) { __bf16 b = (__bf16)x; return __builtin_bit_cast(bf16_t, b); }
DI float bf2f(unsigned v16) { return __uint_as_float(v16 << 16); }
DI float bflo(unsigned u) { return __uint_as_float(u << 16); }
DI float bfhi(unsigned u) { return __uint_as_float(u & 0xffff0000u); }
DI int otid() { int t = threadIdx.x; asm volatile("" : "+v"(t)); return t; }
DI int crow(int i, int h) { return (i & 3) + 8 * (i >> 2) + 4 * h; }
DI float ex2(float x) { return __builtin_amdgcn_exp2f(x); }
DI float sigm(float x) { return 1.f / (1.f + __expf(-x)); }
DI const float* xrow(const Params& p, int row) { return row < NPROMPT ? p.x_prompt + (size_t)row * DM : p.x_sample + (size_t)(row - NPROMPT) * DM; }
DI int pos_of(int row) { return row < NPROMPT ? (row & 8191) : (row & 4095); }
DI int pos_mask(int m0) { return m0 < NPROMPT ? 8191 : 4095; }
DI float swap_max(float m) { auto rr = __builtin_amdgcn_permlane32_swap(__float_as_uint(m), __float_as_uint(m), false, false); return fmaxf(__uint_as_float(rr[0]), __uint_as_float(rr[1])); }
DI float swap_sum(float m) { auto rr = __builtin_amdgcn_permlane32_swap(__float_as_uint(m), __float_as_uint(m), false, false); return __uint_as_float(rr[0]) + __uint_as_float(rr[1]); }
DI s16x4 vtr(const char* p) { return __builtin_bit_cast(s16x4, __builtin_amdgcn_ds_read_tr16_b64_v4i16((__attribute__((address_space(3))) v4i16_t*)(lds_cptr)p)); }

DI void transpose_tile(const float* __restrict__ W, int K, int N, bf16_t* __restrict__ WT, const float* __restrict__ gfold, int tile, char* smem) {
  const int kt = K >> 6;
  const int n0 = (tile / kt) * 64, k0 = (tile % kt) * 64;
  float* t = (float*)smem;
  const int tid = otid();
  __syncthreads();
  if (tid < 256) {
    const int nn = tid & 63, kb = tid >> 6;
#pragma unroll
    for (int i = 0; i < 16; ++i) {
      const int kk = kb + 4 * i;
      float v = 0.f;
      if (n0 + nn < N) { v = W[(size_t)(k0 + kk) * N + n0 + nn]; if (gfold) v *= gfold[k0 + kk]; }
      t[kk * 65 + nn] = v;
    }
  }
  __syncthreads();
  if (tid < 256) {
    const int nl = tid >> 2, kq = (tid & 3) * 16;
    unsigned u[8];
#pragma unroll
    for (int j = 0; j < 8; ++j) u[j] = cvtpk(t[(kq + 2 * j) * 65 + nl], t[(kq + 2 * j + 1) * 65 + nl]);
    uint4* dst = (uint4*)(WT + (size_t)(n0 + nl) * K + k0 + kq);
    dst[0] = make_uint4(u[0], u[1], u[2], u[3]);
    dst[1] = make_uint4(u[4], u[5], u[6], u[7]);
  }
}

DI void phase_prep(const Params& p, char* smem) {
  for (int v = blockIdx.x; v < 2 * 1512; v += gridDim.x) {
    const int layer = v / 1512; int t = v % 1512;
    if (t < 896) { transpose_tile(p.w_in + (size_t)layer * DM * DIN, DM, DIN, p.winT + (size_t)layer * DINP * DM, nullptr, t, smem); continue; }
    t -= 896;
    if (t < 24) { transpose_tile(p.d_w_uq + (size_t)layer * 256 * 384, 256, 384, p.wuqT + (size_t)layer * 384 * 256, p.d_q_norm_g + layer * 256, t, smem); continue; }
    t -= 24;
    if (t < 16) { transpose_tile(p.d_w_ukv + (size_t)layer * 128 * 512, 128, 512, p.wukvT + (size_t)layer * 512 * 128, p.d_kv_norm_g + layer * 128, t, smem); continue; }
    t -= 16;
    if (t < 256) { transpose_tile(p.w_out + (size_t)layer * DM * DM, DM, DM, p.woutT + (size_t)layer * DM * DM, nullptr, t, smem); continue; }
    t -= 256;
    if (t < 256) { transpose_tile(p.w_ple_gate + (size_t)layer * DM * DM, DM, DM, p.wpgT + (size_t)layer * DM * DM, nullptr, t, smem); continue; }
    t -= 256;
    transpose_tile(p.w_ple_proj + (size_t)layer * 256 * DM, 256, DM, p.wppT + (size_t)layer * DM * 256, nullptr, t, smem);
  }
  const int gt = blockIdx.x * NTHR + otid(), nt = gridDim.x * NTHR;
  for (int i = gt; i < 8192 * 48; i += nt) {
    int pos, f, dim; float2* dst;
    if (i < 8192 * 16) { pos = i >> 4; f = i & 15; dim = 32; dst = p.cs32 + i; }
    else { const int j = i - 8192 * 16; pos = j >> 5; f = j & 31; dim = 64; dst = p.cs64 + j; }
    const float inv = exp2f(-(float)(2 * f) / (float)dim * 13.287712379549449f);
    const double ang = (double)pos * (double)inv;
    double rev = ang * 0.15915494309189535;
    rev = rev - __builtin_rint(rev);
    const float fr = (float)rev;
    *dst = make_float2(__builtin_amdgcn_cosf(fr), __builtin_amdgcn_sinf(fr));
  }
  if (blockIdx.x == 0 && threadIdx.x < 2) {
    const int layer = threadIdx.x;
    const float* lv = p.a_lambda + layer * 128;
    float s1 = 0.f, s2 = 0.f;
    for (int i = 0; i < 32; ++i) { s1 += lv[i] * lv[32 + i]; s2 += lv[64 + i] * lv[96 + i]; }
    const float lam_init = 0.8f - 0.6f * expf(-0.3f * (float)layer);
    p.lam[layer] = expf(s1) - expf(s2) + lam_init;
  }
}

DI void phase_norm(const Params& p, int layer, int kind) {
  const int tid_ = otid(); const int lane = tid_ & 63, wave = __builtin_amdgcn_readfirstlane(tid_ >> 6);
  const float* g = kind == 0 ? p.norm_g + layer * DM : (kind == 1 ? p.ple_norm_g + layer * DM : p.final_norm_g);
  float4 g4[4];
#pragma unroll
  for (int j = 0; j < 4; ++j) g4[j] = ((const float4*)g)[lane + 64 * j];
  for (int row = blockIdx.x * 8 + wave; row < NTOK; row += gridDim.x * 8) {
    const float* src = (kind == 0 && layer == 0) ? xrow(p, row) : p.out + (size_t)row * DM;
    float4 v[4];
#pragma unroll
    for (int j = 0; j < 4; ++j) v[j] = ((const float4*)src)[lane + 64 * j];
    float ss = 0.f;
#pragma unroll
    for (int j = 0; j < 4; ++j) ss += v[j].x * v[j].x + v[j].y * v[j].y + v[j].z * v[j].z + v[j].w * v[j].w;
#pragma unroll
    for (int o = 32; o >= 1; o >>= 1) ss += __shfl_xor(ss, o);
    const float rs = rsqrtf(ss * (1.f / 1024.f) + EPS);
    if (kind == 2) {
      float4* dst = (float4*)(p.out + (size_t)row * DM);
#pragma unroll
      for (int j = 0; j < 4; ++j) dst[lane + 64 * j] = make_float4(v[j].x * rs * g4[j].x, v[j].y * rs * g4[j].y, v[j].z * rs * g4[j].z, v[j].w * rs * g4[j].w);
    } else {
      uint2* dst = (uint2*)(p.hn + (size_t)row * DM);
#pragma unroll
      for (int j = 0; j < 4; ++j) dst[lane + 64 * j] = make_uint2(cvtpk(v[j].x * rs * g4[j].x, v[j].y * rs * g4[j].y), cvtpk(v[j].z * rs * g4[j].z, v[j].w * rs * g4[j].w));
      if (kind == 0) {
        const float* ps = row < NPROMPT ? p.p_prompt + ((size_t)layer * NPROMPT + row) * 256 : p.p_sample + ((size_t)layer * (NTOK - NPROMPT) + (row - NPROMPT)) * 256;
        const float4 pv = ((const float4*)ps)[lane];
        ((uint2*)(p.pb + (size_t)row * 256))[lane] = make_uint2(cvtpk(pv.x, pv.y), cvtpk(pv.z, pv.w));
      }
    }
  }
}

DI void gemm_core(const bf16_t* __restrict__ A, int lda, const bf16_t* __restrict__ W, int ldw, int K, f32x16 (&acc)[4][2], char* smem) {
  const int tid = otid(), lane = tid & 63, wave = __builtin_amdgcn_readfirstlane(tid >> 6), wm = wave >> 2, wn = wave & 3, r = lane & 31, h = lane >> 5;
  const int lrow = tid >> 3, lcc = tid & 7;
  const char* ag = (const char*)(A + (size_t)lrow * lda + lcc * 8);
  const char* wg = (const char*)(W + (size_t)lrow * ldw + lcc * 8);
  const size_t astep = (size_t)64 * lda * 2, wstep = (size_t)64 * ldw * 2;
  char* As = smem; char* Bs = smem + 2 * G_TILEB;
  const int soff = lrow * G_ROWB + lcc * 16;
  u32x4 ra[4], rb[4];
#pragma unroll
  for (int i = 0; i < 4; ++i) { ra[i] = *(const u32x4*)(ag + i * astep); rb[i] = *(const u32x4*)(wg + i * wstep); }
#pragma unroll
  for (int i = 0; i < 4; ++i) { *(u32x4*)(As + soff + i * 64 * G_ROWB) = ra[i]; *(u32x4*)(Bs + soff + i * 64 * G_ROWB) = rb[i]; }
  __syncthreads();
  const int nk = K >> 6;
  const int aoff = (wm * 128 + r) * G_ROWB + h * 16;
  const int boff = (wn * 64 + r) * G_ROWB + h * 16;
#pragma unroll 1
  for (int kt = 0; kt < nk; ++kt) {
    const int cur = kt & 1;
    if (kt + 1 < nk) {
#pragma unroll
      for (int i = 0; i < 4; ++i) { ra[i] = *(const u32x4*)(ag + i * astep + (size_t)(kt + 1) * 128); rb[i] = *(const u32x4*)(wg + i * wstep + (size_t)(kt + 1) * 128); }
    }
    const char* Ac = As + cur * G_TILEB + aoff; const char* Bc = Bs + cur * G_TILEB + boff;
#pragma unroll
    for (int ks = 0; ks < 4; ++ks) {
      const bf16x8 b0 = *(const bf16x8*)(Bc + ks * 32), b1 = *(const bf16x8*)(Bc + 32 * G_ROWB + ks * 32);
#pragma unroll
      for (int ti = 0; ti < 4; ++ti) {
        const bf16x8 a = *(const bf16x8*)(Ac + ti * 32 * G_ROWB + ks * 32);
        acc[ti][0] = MFMA(b0, a, acc[ti][0]); acc[ti][1] = MFMA(b1, a, acc[ti][1]);
      }
    }
    if (kt + 1 < nk) {
      const int nb = cur ^ 1;
#pragma unroll
      for (int i = 0; i < 4; ++i) { *(u32x4*)(As + nb * G_TILEB + soff + i * 64 * G_ROWB) = ra[i]; *(u32x4*)(Bs + nb * G_TILEB + soff + i * 64 * G_ROWB) = rb[i]; }
    }
    __syncthreads();
  }
}

DI void zero_acc(f32x16 (&acc)[4][2]) {
#pragma unroll
  for (int a = 0; a < 4; ++a)
#pragma unroll
    for (int b = 0; b < 2; ++b) acc[a][b] = f32x16{};
}

DI uint2 pack4(float a, float b, float c, float d) { return make_uint2(cvtpk(a, b), cvtpk(c, d)); }
DI void rope_quad(const float2* cs, const f32x16& t1, const f32x16& t2, int q1, int q2, float sc, bf16_t* d1, bf16_t* d2) {
  const float4 c01 = ((const float4*)cs)[0], c23 = ((const float4*)cs)[1];
  const float c[4] = {c01.x, c01.z, c23.x, c23.z}, sn[4] = {c01.y, c01.w, c23.y, c23.w};
  float o1[4], o2[4];
#pragma unroll
  for (int j = 0; j < 4; ++j) {
    const float x1 = t1[q1 * 4 + j], x2 = t2[q2 * 4 + j];
    o1[j] = (x1 * c[j] - x2 * sn[j]) * sc; o2[j] = (x2 * c[j] + x1 * sn[j]) * sc;
  }
  *(uint2*)d1 = pack4(o1[0], o1[1], o1[2], o1[3]);
  *(uint2*)d2 = pack4(o2[0], o2[1], o2[2], o2[3]);
}

DI void g8_stage_rc(int b, int& R, int& C) {
  const int st = b / 1024, sb = b % 1024, swz = sb ^ (((sb >> 9) & 1) << 5);
  R = (st >> 1) * 16 + swz / 64; C = (st & 1) * 32 + (swz % 64) / 2;
}
#define G8_MFMA(a, b, c) __builtin_amdgcn_mfma_f32_16x16x32_bf16((a), (b), (c), 0, 0, 0)
template <bool STAGE0_ONLY>
DI void gemm8_impl(const bf16_t* __restrict__ P, int ldp, const bf16_t* __restrict__ Q, int ldq, int K, f32x4 (&acc)[2][2][4][2], char* smem, bool staged) {
  const int tid = otid(), lane = tid & 63, wid = __builtin_amdgcn_readfirstlane(tid >> 6), wr = wid >> 2, wc = wid & 3, fr = lane & 15, fq = lane >> 4;
  int r0, c0;
  g8_stage_rc(tid * 16, r0, c0);
  const unsigned pof = (unsigned)(r0 * ldp + c0) * 2u, qof = (unsigned)(r0 * ldq + c0) * 2u;
  const char* const Pb = (const char*)P; const char* const Qb = (const char*)Q;
  char* const sdst = smem + tid * 16;
  const int ob = fr * 64 + fq * 16, obs = ob ^ (((ob >> 9) & 1) << 5);
  const char* const ard = smem + wr * 8192 + obs;
  const char* const brd = smem + wc * 4096 + obs;
#define G8_SA(b, hh) (((b) * 2 + (hh)) * 16384)
#define G8_SB(b, hh) ((4 + (b) * 2 + (hh)) * 16384)
#define G8_STAGE_P(b, hh, kt) { const char* u_ = Pb + ((size_t)((hh) * 128) * ldp + (size_t)(kt) * 64) * 2;                \
    __builtin_amdgcn_global_load_lds((const unsigned*)(u_ + pof), (lds_uptr)(sdst + G8_SA(b, hh)), 16, 0, 0);               \
    __builtin_amdgcn_global_load_lds((const unsigned*)(u_ + (size_t)ldp * 128 + pof), (lds_uptr)(sdst + G8_SA(b, hh) + 8192), 16, 0, 0); }
#define G8_STAGE_Q(b, hh, kt) { const char* u_ = Qb + ((size_t)((hh) * 128) * ldq + (size_t)(kt) * 64) * 2;                \
    __builtin_amdgcn_global_load_lds((const unsigned*)(u_ + qof), (lds_uptr)(sdst + G8_SB(b, hh)), 16, 0, 0);               \
    __builtin_amdgcn_global_load_lds((const unsigned*)(u_ + (size_t)ldq * 128 + qof), (lds_uptr)(sdst + G8_SB(b, hh) + 8192), 16, 0, 0); }
#define G8_LDA(dst, b, hh) _Pragma("unroll") for (int m = 0; m < 4; ++m) _Pragma("unroll") for (int k = 0; k < 2; ++k) \
    dst[m][k] = *(const bf16x8*)(ard + G8_SA(b, hh) + m * 2048 + k * 1024)
#define G8_LDB(dst, b, hh) _Pragma("unroll") for (int n = 0; n < 2; ++n) _Pragma("unroll") for (int k = 0; k < 2; ++k) \
    dst[n][k] = *(const bf16x8*)(brd + G8_SB(b, hh) + n * 2048 + k * 1024)
#define G8_MMA(ai, bj, At_, Bt_) do { __builtin_amdgcn_s_setprio(1);                                                      \
    _Pragma("unroll") for (int m = 0; m < 4; ++m) _Pragma("unroll") for (int n = 0; n < 2; ++n) _Pragma("unroll") for (int k = 0; k < 2; ++k) \
      acc[ai][bj][m][n] = G8_MFMA(At_[m][k], Bt_[n][k], acc[ai][bj][m][n]);                                                \
    __builtin_amdgcn_s_setprio(0); } while (0)
#define G8_WAIT_V(n) asm volatile("s_waitcnt vmcnt(" #n ")" ::: "memory")
#define G8_WAIT_L(n) asm volatile("s_waitcnt lgkmcnt(" #n ")" ::: "memory")
#define G8_BAR __builtin_amdgcn_s_barrier()
#define G8_SCHED __builtin_amdgcn_sched_barrier(0)
  bf16x8 At[4][2], B0[2][2], B1[2][2];
  const int nt = K >> 6;
  if (STAGE0_ONLY) {
    G8_STAGE_Q(0, 0, 0); G8_STAGE_P(0, 0, 0);
    G8_STAGE_Q(0, 1, 0); G8_STAGE_P(0, 1, 0);
    return;
  }
  if (!staged) {
    __syncthreads();
    G8_STAGE_Q(0, 0, 0); G8_STAGE_P(0, 0, 0);
    G8_STAGE_Q(0, 1, 0); G8_STAGE_P(0, 1, 0);
  }
  if (wr == 1) G8_BAR;
  G8_WAIT_V(4); G8_BAR;
  G8_STAGE_Q(1, 0, 1); G8_STAGE_P(1, 0, 1); G8_STAGE_Q(1, 1, 1);
  G8_WAIT_V(6); G8_BAR;
#pragma unroll 1
  for (int t = 0; t < nt - 2; t += 2) {
    G8_LDB(B0, 0, 0); G8_SCHED; G8_LDA(At, 0, 0); G8_STAGE_P(1, 1, t + 1);
    G8_WAIT_L(8); G8_BAR; G8_WAIT_L(0); G8_MMA(0, 0, At, B0); G8_BAR; G8_SCHED;
    G8_LDB(B1, 0, 1); G8_STAGE_Q(0, 0, t + 2);
    G8_BAR; G8_WAIT_L(0); G8_MMA(0, 1, At, B1); G8_BAR;
    G8_LDA(At, 0, 1); G8_STAGE_P(0, 0, t + 2);
    G8_BAR; G8_WAIT_L(0); G8_MMA(1, 0, At, B0); G8_BAR; G8_SCHED;
    G8_STAGE_Q(0, 1, t + 2);
    G8_WAIT_V(6); G8_BAR; G8_MMA(1, 1, At, B1); G8_BAR;
    G8_LDB(B0, 1, 0); G8_SCHED; G8_LDA(At, 1, 0); G8_STAGE_P(0, 1, t + 2);
    G8_WAIT_L(8); G8_BAR; G8_WAIT_L(0); G8_MMA(0, 0, At, B0); G8_BAR; G8_SCHED;
    G8_LDB(B1, 1, 1); G8_STAGE_Q(1, 0, t + 3);
    G8_BAR; G8_WAIT_L(0); G8_MMA(0, 1, At, B1); G8_BAR;
    G8_LDA(At, 1, 1); G8_STAGE_P(1, 0, t + 3);
    G8_BAR; G8_WAIT_L(0); G8_MMA(1, 0, At, B0); G8_BAR; G8_SCHED;
    G8_STAGE_Q(1, 1, t + 3);
    G8_WAIT_V(6); G8_BAR; G8_MMA(1, 1, At, B1); G8_BAR;
  }
  { G8_LDB(B0, 0, 0); G8_LDA(At, 0, 0); G8_STAGE_P(1, 1, nt - 1);
    G8_BAR; G8_WAIT_L(0); G8_MMA(0, 0, At, B0); G8_BAR;
    G8_LDB(B1, 0, 1); G8_BAR; G8_WAIT_L(0); G8_MMA(0, 1, At, B1); G8_BAR;
    G8_LDA(At, 0, 1); G8_WAIT_V(4); G8_BAR; G8_WAIT_L(0); G8_MMA(1, 0, At, B0); G8_MMA(1, 1, At, B1); G8_BAR; }
  { G8_LDB(B0, 1, 0); G8_LDA(At, 1, 0); G8_WAIT_V(2); G8_BAR; G8_WAIT_L(0); G8_MMA(0, 0, At, B0); G8_BAR;
    G8_LDB(B1, 1, 1); G8_WAIT_V(0); G8_BAR; G8_WAIT_L(0); G8_MMA(0, 1, At, B1); G8_BAR;
    G8_LDA(At, 1, 1); G8_BAR; G8_WAIT_L(0); G8_MMA(1, 0, At, B0); G8_MMA(1, 1, At, B1); G8_BAR; }
  if (wr == 0) G8_BAR;
#undef G8_SA
#undef G8_SB
#undef G8_STAGE_P
#undef G8_STAGE_Q
#undef G8_LDA
#undef G8_LDB
#undef G8_MMA
#undef G8_WAIT_V
#undef G8_WAIT_L
#undef G8_BAR
#undef G8_SCHED
}

DI void gemm8(const bf16_t* P, int ldp, const bf16_t* Q, int ldq, int K, f32x4 (&acc)[2][2][4][2], char* smem, bool staged) {
  gemm8_impl<false>(P, ldp, Q, ldq, K, acc, smem, staged);
}
DI void gemm8_stage0(const bf16_t* P, int ldp, const bf16_t* Q, int ldq, f32x4 (&acc)[2][2][4][2], char* smem) {
  gemm8_impl<true>(P, ldp, Q, ldq, 256, acc, smem, false);
}
struct NextTile { const bf16_t* P; const bf16_t* Q; int ldp; int ldq; bool has; };
DI void zero_acc8(f32x4 (&acc)[2][2][4][2]) {
#pragma unroll
  for (int a = 0; a < 2; ++a)
#pragma unroll
    for (int b = 0; b < 2; ++b)
#pragma unroll
      for (int m = 0; m < 4; ++m)
#pragma unroll
        for (int n = 0; n < 2; ++n) acc[a][b][m][n] = f32x4{0.f, 0.f, 0.f, 0.f};
}
DI uint2 pack4v(f32x4 v, float sc) { return make_uint2(cvtpk(v[0] * sc, v[1] * sc), cvtpk(v[2] * sc, v[3] * sc)); }
DI void rope_quad4(const float2* cs, f32x4 x1, f32x4 x2, float sc, bf16_t* d1, bf16_t* d2) {
  const float4 c01 = ((const float4*)cs)[0], c23 = ((const float4*)cs)[1];
  const float c[4] = {c01.x, c01.z, c23.x, c23.z}, sn[4] = {c01.y, c01.w, c23.y, c23.w};
  float o1[4], o2[4];
#pragma unroll
  for (int j = 0; j < 4; ++j) { o1[j] = (x1[j] * c[j] - x2[j] * sn[j]) * sc; o2[j] = (x2[j] * c[j] + x1[j] * sn[j]) * sc; }
  *(uint2*)d1 = pack4(o1[0], o1[1], o1[2], o1[3]);
  *(uint2*)d2 = pack4(o2[0], o2[1], o2[2], o2[3]);
}

DI void inproj_tile(const Params& p, int layer, int tm, int tn, char* smem, bool staged, const NextTile& nx) {
  f32x4 acc[2][2][4][2]; zero_acc8(acc);
  const int m0 = tm * 256, n0 = tn * 256;
  gemm8(p.winT + ((size_t)layer * DINP + n0) * DM, DM, p.hn + (size_t)m0 * DM, DM, DM, acc, smem, staged);
  if (nx.has) gemm8_stage0(nx.P, nx.ldp, nx.Q, nx.ldq, acc, smem);
  const int tid_ = otid(); const int lane = tid_ & 63, wid = __builtin_amdgcn_readfirstlane(tid_ >> 6), wr = wid >> 2, wc = wid & 3, fr = lane & 15, fq = lane >> 4;
  const int pmask = pos_mask(m0);
#pragma unroll
  for (int bj = 0; bj < 2; ++bj)
#pragma unroll
    for (int n = 0; n < 2; ++n) {
      const int row = m0 + bj * 128 + wc * 32 + n * 16 + fr;
      const int pos = row & pmask;
      bf16_t* zrow = p.z + (size_t)row * ZLD;
#pragma unroll
      for (int ai = 0; ai < 2; ++ai) {
        const int fb = n0 + ai * 128 + wr * 64;
        if (fb >= Z_BQ && fb < Z_BV) {
          const float sc = fb < Z_BK ? SCALE_B : 1.f;
#pragma unroll
          for (int m = 0; m < 2; ++m) {
            const int f0 = m * 16 + fq * 4;
            rope_quad4(p.cs64 + pos * 32 + f0, acc[ai][bj][m][n], acc[ai][bj][m + 2][n], sc, zrow + fb + f0, zrow + fb + 32 + f0);
          }
        } else {
#pragma unroll
          for (int tj = 0; tj < 2; ++tj) {
            const int n32 = fb + tj * 32;
            if (n32 >= DIN) continue;
            const bool rope = (n32 < Z_AV) || (n32 == Z_DKR);
            const float sc = (n32 < Z_AK) ? SCALE_A : ((n32 >= Z_CQ && n32 < Z_CK) ? SCALE_C : 1.f);
            if (rope) {
              rope_quad4(p.cs32 + pos * 16 + fq * 4, acc[ai][bj][2 * tj][n], acc[ai][bj][2 * tj + 1][n], sc, zrow + n32 + fq * 4, zrow + n32 + 16 + fq * 4);
            } else {
              *(uint2*)(zrow + n32 + fq * 4) = pack4v(acc[ai][bj][2 * tj][n], sc);
              *(uint2*)(zrow + n32 + 16 + fq * 4) = pack4v(acc[ai][bj][2 * tj + 1][n], sc);
            }
          }
        }
      }
    }
}

DI void tile_rs(const bf16_t* A, int lda, int K, float* rsv) {
  const int t = otid();
  const uint4* src = (const uint4*)(A + (size_t)(t >> 1) * lda + (t & 1) * (K >> 1));
  float ss = 0.f;
  for (int c = 0; c < (K >> 4); ++c) {
    const uint4 u = src[c];
    ss += bflo(u.x) * bflo(u.x) + bfhi(u.x) * bfhi(u.x) + bflo(u.y) * bflo(u.y) + bfhi(u.y) * bfhi(u.y)
        + bflo(u.z) * bflo(u.z) + bfhi(u.z) * bfhi(u.z) + bflo(u.w) * bflo(u.w) + bfhi(u.w) * bfhi(u.w);
  }
  ss += __shfl_xor(ss, 1);
  if ((t & 1) == 0) rsv[t >> 1] = rsqrtf(ss / (float)K + EPS);
}

DI void upproj_tile(const Params& p, int layer, int tm, int sel, char* smem) {
  const int m0 = tm * 256;
  const int pmask = pos_mask(m0);
  float* rsv = (float*)(smem + SM_RS);
  const int tid_ = otid(); const int lane = tid_ & 63, wave = __builtin_amdgcn_readfirstlane(tid_ >> 6), wm = wave >> 2, wn = wave & 3, r = lane & 31, h = lane >> 5;
  f32x16 acc[4][2]; zero_acc(acc);
  __syncthreads();
  if (sel < 2) {
    const int n0 = sel * 256;
    const bf16_t* A = p.z + (size_t)m0 * ZLD + Z_DCQ;
    tile_rs(A, ZLD, 256, rsv);
    gemm_core(A, ZLD, p.wuqT + ((size_t)layer * 384 + n0) * 256, 256, 256, acc, smem);
#pragma unroll
    for (int ti = 0; ti < 4; ++ti) {
      const int rl = wm * 128 + ti * 32 + r, row = m0 + rl;
      const float rsc = rsv[rl] * SCALE_D;
      bf16_t* qrow = p.qd + (size_t)row * 384;
#pragma unroll
      for (int tj = 0; tj < 2; ++tj) {
        const int n = n0 + wn * 64 + tj * 32;
        if (n >= 384) continue;
        if ((n % 96) == 64) {
#pragma unroll
          for (int g = 0; g < 2; ++g) {
            const int f0 = 8 * g + 4 * h;
            rope_quad(p.cs32 + (row & pmask) * 16 + f0, acc[ti][tj], acc[ti][tj], g, g + 2, rsc, qrow + n + f0, qrow + n + 16 + f0);
          }
        } else {
#pragma unroll
          for (int g = 0; g < 4; ++g)
            *(uint2*)(qrow + n + 8 * g + 4 * h) = pack4(acc[ti][tj][4 * g] * rsc, acc[ti][tj][4 * g + 1] * rsc, acc[ti][tj][4 * g + 2] * rsc, acc[ti][tj][4 * g + 3] * rsc);
        }
      }
    }
  } else {
    const int n0 = (sel - 2) * 256;
    const bf16_t* A = p.z + (size_t)m0 * ZLD + Z_DCKV;
    tile_rs(A, ZLD, 128, rsv);
    gemm_core(A, ZLD, p.wukvT + ((size_t)layer * 512 + n0) * 128, 128, 128, acc, smem);
#pragma unroll
    for (int ti = 0; ti < 4; ++ti) {
      const int rl = wm * 128 + ti * 32 + r, row = m0 + rl;
      const float rsc = rsv[rl];
      bf16_t* krow = p.kvd + (size_t)row * 512 + n0 + wn * 64;
#pragma unroll
      for (int tj = 0; tj < 2; ++tj)
#pragma unroll
        for (int g = 0; g < 4; ++g)
          *(uint2*)(krow + tj * 32 + 8 * g + 4 * h) = pack4(acc[ti][tj][4 * g] * rsc, acc[ti][tj][4 * g + 1] * rsc, acc[ti][tj][4 * g + 2] * rsc, acc[ti][tj][4 * g + 3] * rsc);
    }
  }
}

DI void outproj_tile(const Params& p, int layer, int tm, int tn, char* smem, bool staged, const NextTile& nx) {
  f32x4 acc[2][2][4][2]; zero_acc8(acc);
  const int m0 = tm * 256, n0 = tn * 256;
  gemm8(p.woutT + ((size_t)layer * DM + n0) * DM, DM, p.hn + (size_t)m0 * DM, DM, DM, acc, smem, staged);
  if (nx.has) gemm8_stage0(nx.P, nx.ldp, nx.Q, nx.ldq, acc, smem);
  const int tid_ = otid(); const int lane = tid_ & 63, wid = __builtin_amdgcn_readfirstlane(tid_ >> 6), wr = wid >> 2, wc = wid & 3, fr = lane & 15, fq = lane >> 4;
#pragma unroll
  for (int bj = 0; bj < 2; ++bj)
#pragma unroll
    for (int n = 0; n < 2; ++n) {
      const int row = m0 + bj * 128 + wc * 32 + n * 16 + fr;
      const float* hrow = (layer == 0 ? xrow(p, row) : p.out + (size_t)row * DM) + n0 + wr * 64 + fq * 4;
      float* orow = p.out + (size_t)row * DM + n0 + wr * 64 + fq * 4;
#pragma unroll
      for (int ai = 0; ai < 2; ++ai)
#pragma unroll
        for (int m = 0; m < 4; ++m) {
          const float4 hv = *(const float4*)(hrow + ai * 128 + m * 16);
          const f32x4 a = acc[ai][bj][m][n];
          *(float4*)(orow + ai * 128 + m * 16) = make_float4(hv.x + a[0], hv.y + a[1], hv.z + a[2], hv.w + a[3]);
        }
    }
}

DI void pproj_tile(const Params& p, int layer, int tm, int tn, char* smem, bool staged, const NextTile& nx) {
  f32x4 acc[2][2][4][2]; zero_acc8(acc);
  const int m0 = tm * 256, n0 = tn * 256;
  gemm8(p.wppT + ((size_t)layer * DM + n0) * 256, 256, p.pb + (size_t)m0 * 256, 256, 256, acc, smem, staged);
  if (nx.has) gemm8_stage0(nx.P, nx.ldp, nx.Q, nx.ldq, acc, smem);
  const int tid_ = otid(); const int lane = tid_ & 63, wid = __builtin_amdgcn_readfirstlane(tid_ >> 6), wr = wid >> 2, wc = wid & 3, fr = lane & 15, fq = lane >> 4;
#pragma unroll
  for (int bj = 0; bj < 2; ++bj)
#pragma unroll
    for (int n = 0; n < 2; ++n) {
      const int row = m0 + bj * 128 + wc * 32 + n * 16 + fr;
      bf16_t* prow = p.z + (size_t)row * DM + n0 + wr * 64 + fq * 4;
#pragma unroll
      for (int ai = 0; ai < 2; ++ai)
#pragma unroll
        for (int m = 0; m < 4; ++m) *(uint2*)(prow + ai * 128 + m * 16) = pack4v(acc[ai][bj][m][n], 1.f);
    }
}

DI void ple_tile(const Params& p, int layer, int tm, int tn, char* smem, bool staged, const NextTile& nx) {
  f32x4 acc[2][2][4][2]; zero_acc8(acc);
  const int m0 = tm * 256, n0 = tn * 256;
  gemm8(p.wpgT + ((size_t)layer * DM + n0) * DM, DM, p.hn + (size_t)m0 * DM, DM, DM, acc, smem, staged);
  if (nx.has) gemm8_stage0(nx.P, nx.ldp, nx.Q, nx.ldq, acc, smem);
  const int tid_ = otid(); const int lane = tid_ & 63, wid = __builtin_amdgcn_readfirstlane(tid_ >> 6), wr = wid >> 2, wc = wid & 3, fr = lane & 15, fq = lane >> 4;
#pragma unroll
  for (int bj = 0; bj < 2; ++bj)
#pragma unroll
    for (int n = 0; n < 2; ++n) {
      const int row = m0 + bj * 128 + wc * 32 + n * 16 + fr;
      float* orow = p.out + (size_t)row * DM + n0 + wr * 64 + fq * 4;
      const bf16_t* prow = p.z + (size_t)row * DM + n0 + wr * 64 + fq * 4;
#pragma unroll
      for (int ai = 0; ai < 2; ++ai)
#pragma unroll
        for (int m = 0; m < 4; ++m) {
          const float4 ov = *(const float4*)(orow + ai * 128 + m * 16);
          const uint2 pu = *(const uint2*)(prow + ai * 128 + m * 16);
          const f32x4 a = acc[ai][bj][m][n];
          *(float4*)(orow + ai * 128 + m * 16) = make_float4(ov.x + sigm(a[0]) * bflo(pu.x), ov.y + sigm(a[1]) * bfhi(pu.x),
                                                            ov.z + sigm(a[2]) * bflo(pu.y), ov.w + sigm(a[3]) * bfhi(pu.y));
        }
    }
}

template <int MODE>
DI void attn_item(const Params& p, int layer, int v, char* smem) {
  constexpr int NMAPS = (MODE == 0) ? 2 : 1;
  constexpr int KS = (MODE == 0) ? 2 : ((MODE == 3) ? 6 : 4);
  constexpr int DK = (MODE == 3) ? 96 : 64;
  constexpr int KSTR = (DK + 8) * 2;
  constexpr int VSTR = 144;
  constexpr int KBUF = 64 * KSTR;
  constexpr int BUFB = KBUF + 64 * VSTR;
  constexpr bool LAZY = (MODE == 0 || MODE == 3);
  const int tid = otid(), lane = tid & 63, wave = __builtin_amdgcn_readfirstlane(tid >> 6), r = lane & 31, h = lane >> 5;
  int seq, head, qt, S, row0;
  if (v < 1024) {
    const int b = v & 255, k = v >> 8, x = b & 7, j = b >> 3, pr = x + 8 * k;
    seq = pr >> 2; head = pr & 3; qt = j; S = 8192; row0 = seq * 8192;
  } else {
    const int b = v - 1024, x = b & 7, j = b >> 3, pr = x + 8 * (j >> 4);
    seq = pr >> 2; head = pr & 3; qt = j & 15; S = 4096; row0 = NPROMPT + seq * 4096;
  }
  const int q0 = qt * 256, nkt = S >> 6;
  int kt_lo = 0, kt_hi = nkt, cR = 0, clo = 0;
  if (MODE == 1) { kt_lo = max(0, 4 * qt - 2); kt_hi = min(nkt, 4 * qt + 6); }
  if (MODE == 2) {
    const int R0 = 4 * qt;
    kt_lo = min(max(R0 - 4, 0), nkt - 8); kt_hi = min(max(R0 - 1, 0), nkt - 8) + 8;
    cR = R0 + (wave >> 1); clo = min(max(cR - 4, 0), nkt - 8);
  }
  const bf16_t *qp, *kp, *vp; int ldq, ldk, ldv;
  if (MODE == 0) { qp = p.z + Z_AQ + head * 64; kp = p.z + Z_AK + head * 64; vp = p.z + Z_AV + head * 64; ldq = ldk = ldv = ZLD; }
  else if (MODE == 1) { qp = p.z + Z_BQ + head * 64; kp = p.z + Z_BK + (head >> 1) * 64; vp = p.z + Z_BV + (head >> 1) * 64; ldq = ldk = ldv = ZLD; }
  else if (MODE == 2) { qp = p.z + Z_CQ + head * 64; kp = p.z + Z_CK + head * 64; vp = p.z + Z_CV + head * 64; ldq = ldk = ldv = ZLD; }
  else { qp = p.qd + head * 96; ldq = 384; kp = p.kvd + head * 128; vp = p.kvd + head * 128 + 64; ldk = ldv = 512; }

  float* bias = (float*)(smem + SM_BIAS);
  if (MODE == 2) {
    const float* rp = p.c_rpb + (size_t)(layer * 4 + head) * 465;
    for (int i = tid; i < 465; i += NTHR) bias[i] = rp[i] * LOG2E;
  }

  bf16x8 qf[NMAPS][KS];
  {
    const bf16_t* qrow = qp + (size_t)(row0 + q0 + wave * 32 + r) * ldq + 8 * h;
#pragma unroll
    for (int m = 0; m < NMAPS; ++m)
#pragma unroll
      for (int ks = 0; ks < KS; ++ks) qf[m][ks] = *(const bf16x8*)(qrow + (m * KS + ks) * 16);
  }
  float mrun[NMAPS], lrun[NMAPS];
  f32x16 o[NMAPS][2];
  f32x16 negm[NMAPS];
#pragma unroll
  for (int m = 0; m < NMAPS; ++m) { mrun[m] = LAZY ? 0.f : -1e30f; lrun[m] = 0.f; o[m][0] = f32x16{}; o[m][1] = f32x16{}; negm[m] = f32x16{}; }
  if (MODE == 1) { mrun[0] = p.b_sink[layer * 4 + head] * LOG2E; lrun[0] = (h == 0) ? 1.f : 0.f; }

  const int lrow = tid >> 3, lcc = tid & 7;
  const bf16_t* kg = kp + (size_t)(row0 + lrow) * ldk + lcc * 8;
  const bf16_t* vg = vp + (size_t)(row0 + lrow) * ldv + lcc * 8;
  const bf16_t* k2g = p.z + (size_t)(row0 + ((tid & 255) >> 2)) * ZLD + Z_DKR + (tid & 3) * 8;
  u32x4 kr0, vr0, k2r = u32x4{};
#define ATT_LOAD(kt_)                                                                              \
  {                                                                                                \
    const size_t ro_ = (size_t)(kt_) * 64;                                                         \
    kr0 = *(const u32x4*)(kg + ro_ * ldk);                                                         \
    vr0 = *(const u32x4*)(vg + ro_ * ldv);                                                         \
    if (MODE == 3) { if (tid < 256) k2r = *(const u32x4*)(k2g + ro_ * ZLD); }                      \
  }
#define ATT_STORE(buf_)                                                                            \
  {                                                                                                \
    char* kb_ = smem + (buf_) * BUFB;                                                              \
    *(u32x4*)(kb_ + lrow * KSTR + lcc * 16) = kr0;                                                 \
    *(u32x4*)(kb_ + KBUF + lrow * VSTR + lcc * 16) = vr0;                                          \
    if (MODE == 3) { if (tid < 256) *(u32x4*)(kb_ + (tid >> 2) * KSTR + 128 + (tid & 3) * 16) = k2r; } \
  }
  ATT_LOAD(kt_lo);
  ATT_STORE(0);
  __syncthreads();

  const int i16 = lane & 15;
  const int voff = (4 * h + (i16 >> 2)) * VSTR + (((lane >> 4) & 1) * 16 + (i16 & 3) * 4) * 2;
  const int qi = q0 + wave * 32 + r;
  const int cc = (wave & 1) * 32 + r;
  const int ccs = min(max(cc - 8, 0), 48);

#pragma unroll 1
  for (int kt = kt_lo; kt < kt_hi; ++kt) {
    const int cur = (kt - kt_lo) & 1;
    if (kt + 1 < kt_hi) ATT_LOAD(kt + 1);
    const bool active = (MODE == 2) ? (kt >= clo && kt < clo + 8)
                      : ((MODE == 1) ? (kt * 64 + 63 >= q0 + wave * 32 - 128 && kt * 64 <= q0 + wave * 32 + 31 + 128) : true);
    if (active) {
      const char* kb = smem + cur * BUFB;
      const char* vb = kb + KBUF;
      bf16x8 pf[NMAPS][2][2];
#pragma unroll
      for (int m = 0; m < NMAPS; ++m) {
        f32x16 st[2];
#pragma unroll
        for (int sub = 0; sub < 2; ++sub) {
          f32x16 s;
          if (LAZY) s = negm[m]; else s = f32x16{};
#pragma unroll
          for (int ks = 0; ks < KS; ++ks) {
            const bf16x8 kf = *(const bf16x8*)(kb + (sub * 32 + r) * KSTR + ((m * KS + ks) * 16 + 8 * h) * 2);
            s = MFMA(kf, qf[m][ks], s);
          }
          st[sub] = s;
        }
        if (MODE == 1) {
          int tb = kt * 64 + 4 * h - qi + 128;
          asm volatile("" : "+v"(tb));
#pragma unroll
          for (int sub = 0; sub < 2; ++sub)
#pragma unroll
            for (int i = 0; i < 16; ++i) {
              const int c0 = sub * 32 + (i & 3) + 8 * (i >> 2);
              if ((unsigned)(tb + c0) > 256u) st[sub][i] = -INFINITY;
            }
        }
        if (MODE == 2) {
          int tcc = 4 * h - cc + 15 + (kt - cR + 7) * 31, tcs = 4 * h - ccs;
          asm volatile("" : "+v"(tcc), "+v"(tcs));
#pragma unroll
          for (int sub = 0; sub < 2; ++sub)
#pragma unroll
            for (int i = 0; i < 16; ++i) {
              const int c0 = sub * 32 + (i & 3) + 8 * (i >> 2);
              const bool valid = (unsigned)(c0 + tcs) < 16u;
              const int idx = valid ? tcc + c0 : 0;
              const float bv = bias[idx];
              st[sub][i] = valid ? st[sub][i] + bv : -INFINITY;
            }
        }
        float mx = fmaxf(fmaxf(st[0][0], st[0][1]), st[1][0]);
        {
          float mb = fmaxf(fmaxf(st[0][2], st[0][3]), st[1][1]);
          mx = fmaxf(fmaxf(mx, st[1][2]), st[1][3]);
#pragma unroll
          for (int i = 4; i < 16; i += 4) {
            mx = fmaxf(fmaxf(mx, st[0][i]), st[0][i + 1]); mb = fmaxf(fmaxf(mb, st[0][i + 2]), st[0][i + 3]);
            mx = fmaxf(fmaxf(mx, st[1][i]), st[1][i + 1]); mb = fmaxf(fmaxf(mb, st[1][i + 2]), st[1][i + 3]);
          }
          mx = fmaxf(mx, mb);
        }
        mx = swap_max(mx);
        if (LAZY) {
          const bool first = (kt == kt_lo);
          if (first || __builtin_amdgcn_ballot_w64(mx > 8.f) != 0) {
            const float delta = first ? mx : fmaxf(mx, 0.f);
            const float alpha = first ? 1.f : ex2(-delta);
            mrun[m] += delta;
            lrun[m] *= alpha;
#pragma unroll
            for (int i = 0; i < 16; ++i) { o[m][0][i] *= alpha; o[m][1][i] *= alpha; st[0][i] -= delta; st[1][i] -= delta; }
            const float nm = -mrun[m];
#pragma unroll
            for (int i = 0; i < 16; ++i) negm[m][i] = nm;
          }
          f32x2 l2 = {0.f, 0.f};
#pragma unroll
          for (int sub = 0; sub < 2; ++sub)
#pragma unroll
            for (int i = 0; i < 16; i += 2) {
              const float p0 = ex2(st[sub][i]), p1 = ex2(st[sub][i + 1]);
              st[sub][i] = p0; st[sub][i + 1] = p1;
              l2 += f32x2{p0, p1};
            }
          lrun[m] += l2[0] + l2[1];
        } else {
          const float mnew = fmaxf(mrun[m], mx);
          const float alpha = ex2(mrun[m] - mnew);
          mrun[m] = mnew;
          float ls = 0.f;
#pragma unroll
          for (int sub = 0; sub < 2; ++sub)
#pragma unroll
            for (int i = 0; i < 16; ++i) { const float pv = ex2(st[sub][i] - mnew); ls += pv; st[sub][i] = pv; }
          lrun[m] = lrun[m] * alpha + ls;
#pragma unroll
          for (int i = 0; i < 16; ++i) { o[m][0][i] *= alpha; o[m][1][i] *= alpha; }
        }
#pragma unroll
        for (int sub = 0; sub < 2; ++sub)
#pragma unroll
          for (int kk = 0; kk < 2; ++kk) {
            const uint4 u = make_uint4(cvtpk(st[sub][8 * kk + 0], st[sub][8 * kk + 1]), cvtpk(st[sub][8 * kk + 2], st[sub][8 * kk + 3]),
                                       cvtpk(st[sub][8 * kk + 4], st[sub][8 * kk + 5]), cvtpk(st[sub][8 * kk + 6], st[sub][8 * kk + 7]));
            pf[m][sub][kk] = __builtin_bit_cast(bf16x8, u);
          }
      }
#pragma unroll
      for (int sub = 0; sub < 2; ++sub)
#pragma unroll
        for (int kk = 0; kk < 2; ++kk)
#pragma unroll
          for (int dvt = 0; dvt < 2; ++dvt) {
            const char* va = vb + voff + (sub * 32 + kk * 16) * VSTR + dvt * 64;
            const s16x4 lo = vtr(va), hi = vtr(va + 8 * VSTR);
            const bf16x8 vf = __builtin_shufflevector(lo, hi, 0, 1, 2, 3, 4, 5, 6, 7);
#pragma unroll
            for (int m = 0; m < NMAPS; ++m) o[m][dvt] = MFMA(vf, pf[m][sub][kk], o[m][dvt]);
          }
    }
    if (kt + 1 < kt_hi) ATT_STORE(cur ^ 1);
    __syncthreads();
  }
#undef ATT_LOAD
#undef ATT_STORE

  float inv[NMAPS];
#pragma unroll
  for (int m = 0; m < NMAPS; ++m) inv[m] = 1.f / swap_sum(lrun[m]);
  f32x16 res[2];
  if (MODE == 0) {
    const float lam = p.lam[layer];
    const float lam_init = 0.8f - 0.6f * __expf(-0.3f * (float)layer);
    float ss = 0.f;
#pragma unroll
    for (int dvt = 0; dvt < 2; ++dvt)
#pragma unroll
      for (int i = 0; i < 16; ++i) { const float t = o[0][dvt][i] * inv[0] - lam * (o[NMAPS - 1][dvt][i] * inv[NMAPS - 1]); res[dvt][i] = t; ss += t * t; }
    ss = swap_sum(ss);
    const float rs = rsqrtf(ss * (1.f / 64.f) + EPS) * (1.f - lam_init);
    const float* sg = p.a_subln_g + layer * 64;
#pragma unroll
    for (int dvt = 0; dvt < 2; ++dvt)
#pragma unroll
      for (int i = 0; i < 16; ++i) res[dvt][i] *= rs * sg[dvt * 32 + crow(i, h)];
  } else {
#pragma unroll
    for (int dvt = 0; dvt < 2; ++dvt)
#pragma unroll
      for (int i = 0; i < 16; ++i) res[dvt][i] = o[0][dvt][i] * inv[0];
  }
  {
    const size_t row = (size_t)(row0 + qi);
    const bf16_t* gp = p.z + row * ZLD + Z_GATE + MODE * 256 + head * 64;
    bf16_t* mp = p.hn + row * DM + MODE * 256 + head * 64;
#pragma unroll
    for (int dvt = 0; dvt < 2; ++dvt)
#pragma unroll
      for (int ig = 0; ig < 4; ++ig) {
        const int dv0 = dvt * 32 + ig * 8 + 4 * h;
        const uint2 gu = *(const uint2*)(gp + dv0);
        const float g0 = bflo(gu.x), g1 = bfhi(gu.x), g2 = bflo(gu.y), g3 = bfhi(gu.y);
        const float a0 = res[dvt][ig * 4 + 0] * g0 * sigm(g0), a1 = res[dvt][ig * 4 + 1] * g1 * sigm(g1);
        const float a2 = res[dvt][ig * 4 + 2] * g2 * sigm(g2), a3 = res[dvt][ig * 4 + 3] * g3 * sigm(g3);
        *(uint2*)(mp + dv0) = make_uint2(cvtpk(a0, a1), cvtpk(a2, a3));
      }
  }
}

__global__ void __launch_bounds__(512, 2) mega_fwd(Params p) {
  __shared__ __attribute__((aligned(16))) char smem[SMEM_BYTES];
  cg::grid_group grid = cg::this_grid();
  const int nb = gridDim.x;

  phase_prep(p, smem);
  grid.sync();
#pragma unroll 1
  for (int layer = 0; layer < 2; ++layer) {
    phase_norm(p, layer, 0);
    grid.sync();
    {
      bool staged = false;
      for (int v = blockIdx.x; v < 18 * 256; v += nb) {
        const int b = v & 255, k = v >> 8, x = b & 7, j = b >> 3, st = k * 8 + x;
        if (st >= 140) continue;
        const int tm = (st / 7) * 16 + (j >> 1), tn = (st % 7) * 2 + (j & 1);
        NextTile nx;
        {
          const int v2 = v + nb, b2 = v2 & 255, k2 = v2 >> 8, st2 = k2 * 8 + (b2 & 7), j2 = b2 >> 3;
          nx.has = (v2 < 18 * 256) && (st2 < 140);
          const int tm2 = (st2 / 7) * 16 + (j2 >> 1), tn2 = (st2 % 7) * 2 + (j2 & 1);
          nx.P = p.winT + ((size_t)layer * DINP + tn2 * 256) * DM; nx.Q = p.hn + (size_t)tm2 * 256 * DM; nx.ldp = DM; nx.ldq = DM;
        }
        inproj_tile(p, layer, tm, tn, smem, staged, nx);
        staged = nx.has;
      }
    }
    grid.sync();
    for (int v = blockIdx.x; v < 1280 + 1280 + 1280 + 1280; v += nb) {
      if (v < 1280) attn_item<0>(p, layer, v, smem);
      else if (v < 2560) { const int u = v - 1280; upproj_tile(p, layer, u >> 2, u & 3, smem); }
      else if (v < 3840) attn_item<1>(p, layer, v - 2560, smem);
      else attn_item<2>(p, layer, v - 3840, smem);
    }
    grid.sync();
    for (int v = blockIdx.x; v < 1280; v += nb) attn_item<3>(p, layer, v, smem);
    grid.sync();
    {
      bool staged = false;
      for (int v = blockIdx.x; v < 2560; v += nb) {
        const int vv = v < 1280 ? v : v - 1280;
        const int b = vv & 255, k = vv >> 8, x = b & 7, j = b >> 3, st = k * 8 + x;
        NextTile nx;
        {
          const int v2 = v + nb, vv2 = v2 < 1280 ? v2 : v2 - 1280;
          const int b2 = vv2 & 255, st2 = (vv2 >> 8) * 8 + (b2 & 7), j2 = b2 >> 3, tm2 = st2 * 8 + (j2 >> 2), tn2 = j2 & 3;
          nx.has = v2 < 2560;
          if (v2 < 1280) { nx.P = p.woutT + ((size_t)layer * DM + tn2 * 256) * DM; nx.Q = p.hn + (size_t)tm2 * 256 * DM; nx.ldp = DM; nx.ldq = DM; }
          else { nx.P = p.wppT + ((size_t)layer * DM + tn2 * 256) * 256; nx.Q = p.pb + (size_t)tm2 * 256 * 256; nx.ldp = 256; nx.ldq = 256; }
        }
        if (v < 1280) outproj_tile(p, layer, st * 8 + (j >> 2), j & 3, smem, staged, nx);
        else pproj_tile(p, layer, st * 8 + (j >> 2), j & 3, smem, staged, nx);
        staged = nx.has;
      }
    }
    grid.sync();
    phase_norm(p, layer, 1);
    grid.sync();
    {
      bool staged = false;
      for (int v = blockIdx.x; v < 1280; v += nb) {
        const int b = v & 255, k = v >> 8, x = b & 7, j = b >> 3, st = k * 8 + x;
        NextTile nx;
        {
          const int v2 = v + nb, b2 = v2 & 255, st2 = (v2 >> 8) * 8 + (b2 & 7), j2 = b2 >> 3, tm2 = st2 * 8 + (j2 >> 2), tn2 = j2 & 3;
          nx.has = v2 < 1280;
          nx.P = p.wpgT + ((size_t)layer * DM + tn2 * 256) * DM; nx.Q = p.hn + (size_t)tm2 * 256 * DM; nx.ldp = DM; nx.ldq = DM;
        }
        ple_tile(p, layer, st * 8 + (j >> 2), j & 3, smem, staged, nx);
        staged = nx.has;
      }
    }
    grid.sync();
  }
  phase_norm(p, 0, 2);
}

extern "C" void kernel_launch(void* const* d_in, const int* in_sizes, int n_in, void* d_out, int out_size, void* d_ws, size_t ws_size,
                              hipStream_t stream) {
  Params p{};
  p.x_prompt = (const float*)d_in[0]; p.x_sample = (const float*)d_in[1]; p.p_prompt = (const float*)d_in[2]; p.p_sample = (const float*)d_in[3];
  p.norm_g = (const float*)d_in[4]; p.w_in = (const float*)d_in[5]; p.a_lambda = (const float*)d_in[6]; p.a_subln_g = (const float*)d_in[7];
  p.b_sink = (const float*)d_in[8]; p.c_rpb = (const float*)d_in[9]; p.d_q_norm_g = (const float*)d_in[10]; p.d_kv_norm_g = (const float*)d_in[11];
  p.d_w_uq = (const float*)d_in[12]; p.d_w_ukv = (const float*)d_in[13]; p.w_out = (const float*)d_in[14]; p.ple_norm_g = (const float*)d_in[15];
  p.w_ple_gate = (const float*)d_in[16]; p.w_ple_proj = (const float*)d_in[17]; p.final_norm_g = (const float*)d_in[18];
  p.out = (float*)d_out;
  char* w = (char*)d_ws; size_t off = 0;
  auto carve = [&](size_t bytes) { char* r = w + off; off += (bytes + 255) & ~(size_t)255; return r; };
  p.hn = (bf16_t*)carve((size_t)NTOK * DM * 2);
  p.z = (bf16_t*)carve((size_t)NTOK * ZLD * 2);
  p.qd = (bf16_t*)carve((size_t)NTOK * 384 * 2);
  p.pb = (bf16_t*)carve((size_t)NTOK * 256 * 2);
  p.kvd = (bf16_t*)carve((size_t)NTOK * 512 * 2);
  p.winT = (bf16_t*)carve((size_t)2 * DINP * DM * 2);
  p.wuqT = (bf16_t*)carve((size_t)2 * 384 * 256 * 2);
  p.wukvT = (bf16_t*)carve((size_t)2 * 512 * 128 * 2);
  p.woutT = (bf16_t*)carve((size_t)2 * DM * DM * 2);
  p.wpgT = (bf16_t*)carve((size_t)2 * DM * DM * 2);
  p.wppT = (bf16_t*)carve((size_t)2 * DM * 256 * 2);
  p.cs32 = (float2*)carve((size_t)8192 * 16 * 8);
  p.cs64 = (float2*)carve((size_t)8192 * 32 * 8);
  p.lam = (float*)carve(256);
  if (off > ws_size) { fprintf(stderr, "workspace too small: need %zu have %zu\n", off, ws_size); return; }
  static int grid_blocks = 0;
  if (!grid_blocks) {
    int dev = 0, cus = 0, per_cu = 0;
    hipGetDevice(&dev);
    hipDeviceGetAttribute(&cus, hipDeviceAttributeMultiprocessorCount, dev);
    hipOccupancyMaxActiveBlocksPerMultiprocessor(&per_cu, mega_fwd, NTHR, 0);
    if (per_cu > 1) per_cu = 1;
    if (per_cu < 1) per_cu = 1;
    grid_blocks = cus * per_cu;
  }
  void* args[] = {&p};
  hipError_t e = hipLaunchCooperativeKernel((void*)mega_fwd, dim3(grid_blocks), dim3(NTHR), args, 0, stream);
  if (e != hipSuccess) fprintf(stderr, "cooperative launch failed: %s (grid %d)\n", hipGetErrorString(e), grid_blocks);
}
```

```cpp
#include <hip/hip_runtime.h>
#include <hip/hip_cooperative_groups.h>
#include <stdint.h>
#include <stdio.h>
namespace cg = cooperative_groups;

typedef __attribute__((ext_vector_type(8))) short bf16x8;
typedef __attribute__((ext_vector_type(4))) short s16x4;
typedef __attribute__((ext_vector_type(16))) float f32x16;
typedef short v4i16_t __attribute__((ext_vector_type(4)));
typedef __bf16 bf16v2 __attribute__((ext_vector_type(2)));
typedef unsigned short bf16_t;
typedef unsigned u32x4 __attribute__((ext_vector_type(4)));
typedef float f32x2 __attribute__((ext_vector_type(2)));
typedef float f32x4 __attribute__((ext_vector_type(4)));
typedef __attribute__((address_space(3))) unsigned* lds_uptr;
typedef __attribute__((address_space(3))) const char* lds_cptr;

#define DI __device__ __forceinline__
#define MFMA(a, b, c) __builtin_amdgcn_mfma_f32_32x32x16_bf16((a), (b), (c), 0, 0, 0)

constexpr int NTOK = 81920, NPROMPT = 65536, DM = 1024, DIN = 3488, DINP = 3584, ZLD = 3488;
constexpr int Z_AQ = 0, Z_AK = 256, Z_AV = 512, Z_BQ = 768, Z_BK = 1024, Z_BV = 1152, Z_CQ = 1280, Z_CK = 1536, Z_CV = 1792,
              Z_DCQ = 2048, Z_DCKV = 2304, Z_DKR = 2432, Z_GATE = 2464;
constexpr float LOG2E = 1.4426950408889634f;
constexpr float SCALE_A = 0.17677669529663687f * LOG2E;
constexpr float SCALE_B = 0.125f * LOG2E;
constexpr float SCALE_C = 0.125f * LOG2E;
constexpr float SCALE_D = 0.10206207261596575f * LOG2E;
constexpr float EPS = 1e-6f;

constexpr int G_ROWB = 144;
constexpr int G_TILEB = 256 * G_ROWB;
constexpr int SM_RS = 4 * G_TILEB;
constexpr int SM_BIAS = 46080;
constexpr int SMEM_BYTES = SM_RS + 1024;
constexpr int NTHR = 512;

struct Params {
  const float* x_prompt; const float* x_sample; const float* p_prompt; const float* p_sample;
  const float* norm_g; const float* w_in; const float* a_lambda; const float* a_subln_g; const float* b_sink; const float* c_rpb;
  const float* d_q_norm_g; const float* d_kv_norm_g; const float* d_w_uq; const float* d_w_ukv; const float* w_out; const float* ple_norm_g;
  const float* w_ple_gate; const float* w_ple_proj; const float* final_norm_g;
  float* out;
  bf16_t* hn;
  bf16_t* z;
  bf16_t* qd;
  bf16_t* pb;
  bf16_t* kvd;
  bf16_t* winT; bf16_t* wuqT; bf16_t* wukvT; bf16_t* woutT; bf16_t* wpgT; bf16_t* wppT;
  float2* cs32; float2* cs64; float* lam;
};

DI unsigned cvtpk(float lo, float hi) { bf16v2 v = {(__bf16)lo, (__bf16)hi}; return __builtin_bit_cast(unsigned, v); }
DI bf16_t f2bf(float x) { __bf16 b = (__bf16)x; return __builtin_bit_cast(bf16_t, b); }
DI float bf2f(unsigned v16) { return __uint_as_float(v16 << 16); }
DI float bflo(unsigned u) { return __uint_as_float(u << 16); }
DI float bfhi(unsigned u) { return __uint_as_float(u & 0xffff0000u); }
DI int otid() { int t = threadIdx.x; asm volatile("" : "+v"(t)); return t; }
DI int crow(int i, int h) { return (i & 3) + 8 * (i >> 2) + 4 * h; }
DI float ex2(float x) { return __builtin_amdgcn_exp2f(x); }
DI float sigm(float x) { return 1.f / (1.f + __expf(-x)); }
DI const float* xrow(const Params& p, int row) { return row < NPROMPT ? p.x_prompt + (size_t)row * DM : p.x_sample + (size_t)(row - NPROMPT) * DM; }
DI int pos_of(int row) { return row < NPROMPT ? (row & 8191) : (row & 4095); }
DI int pos_mask(int m0) { return m0 < NPROMPT ? 8191 : 4095; }
DI float swap_max(float m) { auto rr = __builtin_amdgcn_permlane32_swap(__float_as_uint(m), __float_as_uint(m), false, false); return fmaxf(__uint_as_float(rr[0]), __uint_as_float(rr[1])); }
DI float swap_sum(float m) { auto rr = __builtin_amdgcn_permlane32_swap(__float_as_uint(m), __float_as_uint(m), false, false); return __uint_as_float(rr[0]) + __uint_as_float(rr[1]); }
DI s16x4 vtr(const char* p) { return __builtin_bit_cast(s16x4, __builtin_amdgcn_ds_read_tr16_b64_v4i16((__attribute__((address_space(3))) v4i16_t*)(lds_cptr)p)); }

DI void transpose_tile(const float* __restrict__ W, int K, int N, bf16_t* __restrict__ WT, const float* __restrict__ gfold, int tile, char* smem) {
  const int kt = K >> 6;
  const int n0 = (tile / kt) * 64, k0 = (tile % kt) * 64;
  float* t = (float*)smem;
  const int tid = otid();
  __syncthreads();
  if (tid < 256) {
    const int nn = tid & 63, kb = tid >> 6;
#pragma unroll
    for (int i = 0; i < 16; ++i) {
      const int kk = kb + 4 * i;
      float v = 0.f;
      if (n0 + nn < N) { v = W[(size_t)(k0 + kk) * N + n0 + nn]; if (gfold) v *= gfold[k0 + kk]; }
      t[kk * 65 + nn] = v;
    }
  }
  __syncthreads();
  if (tid < 256) {
    const int nl = tid >> 2, kq = (tid & 3) * 16;
    unsigned u[8];
#pragma unroll
    for (int j = 0; j < 8; ++j) u[j] = cvtpk(t[(kq + 2 * j) * 65 + nl], t[(kq + 2 * j + 1) * 65 + nl]);
    uint4* dst = (uint4*)(WT + (size_t)(n0 + nl) * K + k0 + kq);
    dst[0] = make_uint4(u[0], u[1], u[2], u[3]);
    dst[1] = make_uint4(u[4], u[5], u[6], u[7]);
  }
}

DI void phase_prep(const Params& p, char* smem) {
  for (int v = blockIdx.x; v < 2 * 1512; v += gridDim.x) {
    const int layer = v / 1512; int t = v % 1512;
    if (t < 896) { transpose_tile(p.w_in + (size_t)layer * DM * DIN, DM, DIN, p.winT + (size_t)layer * DINP * DM, nullptr, t, smem); continue; }
    t -= 896;
    if (t < 24) { transpose_tile(p.d_w_uq + (size_t)layer * 256 * 384, 256, 384, p.wuqT + (size_t)layer * 384 * 256, p.d_q_norm_g + layer * 256, t, smem); continue; }
    t -= 24;
    if (t < 16) { transpose_tile(p.d_w_ukv + (size_t)layer * 128 * 512, 128, 512, p.wukvT + (size_t)layer * 512 * 128, p.d_kv_norm_g + layer * 128, t, smem); continue; }
    t -= 16;
    if (t < 256) { transpose_tile(p.w_out + (size_t)layer * DM * DM, DM, DM, p.woutT + (size_t)layer * DM * DM, nullptr, t, smem); continue; }
    t -= 256;
    if (t < 256) { transpose_tile(p.w_ple_gate + (size_t)layer * DM * DM, DM, DM, p.wpgT + (size_t)layer * DM * DM, nullptr, t, smem); continue; }
    t -= 256;
    transpose_tile(p.w_ple_proj + (size_t)layer * 256 * DM, 256, DM, p.wppT + (size_t)layer * DM * 256, nullptr, t, smem);
  }
  const int gt = blockIdx.x * NTHR + otid(), nt = gridDim.x * NTHR;
  for (int i = gt; i < 8192 * 48; i += nt) {
    int pos, f, dim; float2* dst;
    if (i < 8192 * 16) { pos = i >> 4; f = i & 15; dim = 32; dst = p.cs32 + i; }
    else { const int j = i - 8192 * 16; pos = j >> 5; f = j & 31; dim = 64; dst = p.cs64 + j; }
    const float inv = exp2f(-(float)(2 * f) / (float)dim * 13.287712379549449f);
    const double ang = (double)pos * (double)inv;
    double rev = ang * 0.15915494309189535;
    rev = rev - __builtin_rint(rev);
    const float fr = (float)rev;
    *dst = make_float2(__builtin_amdgcn_cosf(fr), __builtin_amdgcn_sinf(fr));
  }
  if (blockIdx.x == 0 && threadIdx.x < 2) {
    const int layer = threadIdx.x;
    const float* lv = p.a_lambda + layer * 128;
    float s1 = 0.f, s2 = 0.f;
    for (int i = 0; i < 32; ++i) { s1 += lv[i] * lv[32 + i]; s2 += lv[64 + i] * lv[96 + i]; }
    const float lam_init = 0.8f - 0.6f * expf(-0.3f * (float)layer);
    p.lam[layer] = expf(s1) - expf(s2) + lam_init;
  }
}

DI void phase_norm(const Params& p, int layer, int kind) {
  const int tid_ = otid(); const int lane = tid_ & 63, wave = __builtin_amdgcn_readfirstlane(tid_ >> 6);
  const float* g = kind == 0 ? p.norm_g + layer * DM : (kind == 1 ? p.ple_norm_g + layer * DM : p.final_norm_g);
  float4 g4[4];
#pragma unroll
  for (int j = 0; j < 4; ++j) g4[j] = ((const float4*)g)[lane + 64 * j];
  for (int row = blockIdx.x * 8 + wave; row < NTOK; row += gridDim.x * 8) {
    const float* src = (kind == 0 && layer == 0) ? xrow(p, row) : p.out + (size_t)row * DM;
    float4 v[4];
#pragma unroll
    for (int j = 0; j < 4; ++j) v[j] = ((const float4*)src)[lane + 64 * j];
    float ss = 0.f;
#pragma unroll
    for (int j = 0; j < 4; ++j) ss += v[j].x * v[j].x + v[j].y * v[j].y + v[j].z * v[j].z + v[j].w * v[j].w;
#pragma unroll
    for (int o = 32; o >= 1; o >>= 1) ss += __shfl_xor(ss, o);
    const float rs = rsqrtf(ss * (1.f / 1024.f) + EPS);
    if (kind == 2) {
      float4* dst = (float4*)(p.out + (size_t)row * DM);
#pragma unroll
      for (int j = 0; j < 4; ++j) dst[lane + 64 * j] = make_float4(v[j].x * rs * g4[j].x, v[j].y * rs * g4[j].y, v[j].z * rs * g4[j].z, v[j].w * rs * g4[j].w);
    } else {
      uint2* dst = (uint2*)(p.hn + (size_t)row * DM);
#pragma unroll
      for (int j = 0; j < 4; ++j) dst[lane + 64 * j] = make_uint2(cvtpk(v[j].x * rs * g4[j].x, v[j].y * rs * g4[j].y), cvtpk(v[j].z * rs * g4[j].z, v[j].w * rs * g4[j].w));
      if (kind == 0) {
        const float* ps = row < NPROMPT ? p.p_prompt + ((size_t)layer * NPROMPT + row) * 256 : p.p_sample + ((size_t)layer * (NTOK - NPROMPT) + (row - NPROMPT)) * 256;
        const float4 pv = ((const float4*)ps)[lane];
        ((uint2*)(p.pb + (size_t)row * 256))[lane] = make_uint2(cvtpk(pv.x, pv.y), cvtpk(pv.z, pv.w));
      }
    }
  }
}

DI void gemm_core(const bf16_t* __restrict__ A, int lda, const bf16_t* __restrict__ W, int ldw, int K, f32x16 (&acc)[4][2], char* smem) {
  const int tid = otid(), lane = tid & 63, wave = __builtin_amdgcn_readfirstlane(tid >> 6), wm = wave >> 2, wn = wave & 3, r = lane & 31, h = lane >> 5;
  const int lrow = tid >> 3, lcc = tid & 7;
  const char* ag = (const char*)(A + (size_t)lrow * lda + lcc * 8);
  const char* wg = (const char*)(W + (size_t)lrow * ldw + lcc * 8);
  const size_t astep = (size_t)64 * lda * 2, wstep = (size_t)64 * ldw * 2;
  char* As = smem; char* Bs = smem + 2 * G_TILEB;
  const int soff = lrow * G_ROWB + lcc * 16;
  u32x4 ra[4], rb[4];
#pragma unroll
  for (int i = 0; i < 4; ++i) { ra[i] = *(const u32x4*)(ag + i * astep); rb[i] = *(const u32x4*)(wg + i * wstep); }
#pragma unroll
  for (int i = 0; i < 4; ++i) { *(u32x4*)(As + soff + i * 64 * G_ROWB) = ra[i]; *(u32x4*)(Bs + soff + i * 64 * G_ROWB) = rb[i]; }
  __syncthreads();
  const int nk = K >> 6;
  const int aoff = (wm * 128 + r) * G_ROWB + h * 16;
  const int boff = (wn * 64 + r) * G_ROWB + h * 16;
#pragma unroll 1
  for (int kt = 0; kt < nk; ++kt) {
    const int cur = kt & 1;
    if (kt + 1 < nk) {
#pragma unroll
      for (int i = 0; i < 4; ++i) { ra[i] = *(const u32x4*)(ag + i * astep + (size_t)(kt + 1) * 128); rb[i] = *(const u32x4*)(wg + i * wstep + (size_t)(kt + 1) * 128); }
    }
    const char* Ac = As + cur * G_TILEB + aoff; const char* Bc = Bs + cur * G_TILEB + boff;
#pragma unroll
    for (int ks = 0; ks < 4; ++ks) {
      const bf16x8 b0 = *(const bf16x8*)(Bc + ks * 32), b1 = *(const bf16x8*)(Bc + 32 * G_ROWB + ks * 32);
#pragma unroll
      for (int ti = 0; ti < 4; ++ti) {
        const bf16x8 a = *(const bf16x8*)(Ac + ti * 32 * G_ROWB + ks * 32);
        acc[ti][0] = MFMA(b0, a, acc[ti][0]); acc[ti][1] = MFMA(b1, a, acc[ti][1]);
      }
    }
    if (kt + 1 < nk) {
      const int nb = cur ^ 1;
#pragma unroll
      for (int i = 0; i < 4; ++i) { *(u32x4*)(As + nb * G_TILEB + soff + i * 64 * G_ROWB) = ra[i]; *(u32x4*)(Bs + nb * G_TILEB + soff + i * 64 * G_ROWB) = rb[i]; }
    }
    __syncthreads();
  }
}

DI void zero_acc(f32x16 (&acc)[4][2]) {
#pragma unroll
  for (int a = 0; a < 4; ++a)
#pragma unroll
    for (int b = 0; b < 2; ++b) acc[a][b] = f32x16{};
}

DI uint2 pack4(float a, float b, float c, float d) { return make_uint2(cvtpk(a, b), cvtpk(c, d)); }
DI void rope_quad(const float2* cs, const f32x16& t1, const f32x16& t2, int q1, int q2, float sc, bf16_t* d1, bf16_t* d2) {
  const float4 c01 = ((const float4*)cs)[0], c23 = ((const float4*)cs)[1];
  const float c[4] = {c01.x, c01.z, c23.x, c23.z}, sn[4] = {c01.y, c01.w, c23.y, c23.w};
  float o1[4], o2[4];
#pragma unroll
  for (int j = 0; j < 4; ++j) {
    const float x1 = t1[q1 * 4 + j], x2 = t2[q2 * 4 + j];
    o1[j] = (x1 * c[j] - x2 * sn[j]) * sc; o2[j] = (x2 * c[j] + x1 * sn[j]) * sc;
  }
  *(uint2*)d1 = pack4(o1[0], o1[1], o1[2], o1[3]);
  *(uint2*)d2 = pack4(o2[0], o2[1], o2[2], o2[3]);
}

DI void g8_stage_rc(int b, int& R, int& C) {
  const int st = b / 1024, sb = b % 1024, swz = sb ^ (((sb >> 9) & 1) << 5);
  R = (st >> 1) * 16 + swz / 64; C = (st & 1) * 32 + (swz % 64) / 2;
}
#define G8_MFMA(a, b, c) __builtin_amdgcn_mfma_f32_16x16x32_bf16((a), (b), (c), 0, 0, 0)
template <bool STAGE0_ONLY>
DI void gemm8_impl(const bf16_t* __restrict__ P, int ldp, const bf16_t* __restrict__ Q, int ldq, int K, f32x4 (&acc)[2][2][4][2], char* smem, bool staged) {
  const int tid = otid(), lane = tid & 63, wid = __builtin_amdgcn_readfirstlane(tid >> 6), wr = wid >> 2, wc = wid & 3, fr = lane & 15, fq = lane >> 4;
  int r0, c0;
  g8_stage_rc(tid * 16, r0, c0);
  const unsigned pof = (unsigned)(r0 * ldp + c0) * 2u, qof = (unsigned)(r0 * ldq + c0) * 2u;
  const char* const Pb = (const char*)P; const char* const Qb = (const char*)Q;
  char* const sdst = smem + tid * 16;
  const int ob = fr * 64 + fq * 16, obs = ob ^ (((ob >> 9) & 1) << 5);
  const char* const ard = smem + wr * 8192 + obs;
  const char* const brd = smem + wc * 4096 + obs;
#define G8_SA(b, hh) (((b) * 2 + (hh)) * 16384)
#define G8_SB(b, hh) ((4 + (b) * 2 + (hh)) * 16384)
#define G8_STAGE_P(b, hh, kt) { const char* u_ = Pb + ((size_t)((hh) * 128) * ldp + (size_t)(kt) * 64) * 2;                \
    __builtin_amdgcn_global_load_lds((const unsigned*)(u_ + pof), (lds_uptr)(sdst + G8_SA(b, hh)), 16, 0, 0);               \
    __builtin_amdgcn_global_load_lds((const unsigned*)(u_ + (size_t)ldp * 128 + pof), (lds_uptr)(sdst + G8_SA(b, hh) + 8192), 16, 0, 0); }
#define G8_STAGE_Q(b, hh, kt) { const char* u_ = Qb + ((size_t)((hh) * 128) * ldq + (size_t)(kt) * 64) * 2;                \
    __builtin_amdgcn_global_load_lds((const unsigned*)(u_ + qof), (lds_uptr)(sdst + G8_SB(b, hh)), 16, 0, 0);               \
    __builtin_amdgcn_global_load_lds((const unsigned*)(u_ + (size_t)ldq * 128 + qof), (lds_uptr)(sdst + G8_SB(b, hh) + 8192), 16, 0, 0); }
#define G8_LDA(dst, b, hh) _Pragma("unroll") for (int m = 0; m < 4; ++m) _Pragma("unroll") for (int k = 0; k < 2; ++k) \
    dst[m][k] = *(const bf16x8*)(ard + G8_SA(b, hh) + m * 2048 + k * 1024)
#define G8_LDB(dst, b, hh) _Pragma("unroll") for (int n = 0; n < 2; ++n) _Pragma("unroll") for (int k = 0; k < 2; ++k) \
    dst[n][k] = *(const bf16x8*)(brd + G8_SB(b, hh) + n * 2048 + k * 1024)
#define G8_MMA(ai, bj, At_, Bt_) do { __builtin_amdgcn_s_setprio(1);                                                      \
    _Pragma("unroll") for (int m = 0; m < 4; ++m) _Pragma("unroll") for (int n = 0; n < 2; ++n) _Pragma("unroll") for (int k = 0; k < 2; ++k) \
      acc[ai][bj][m][n] = G8_MFMA(At_[m][k], Bt_[n][k], acc[ai][bj][m][n]);                                                \
    __builtin_amdgcn_s_setprio(0); } while (0)
#define G8_WAIT_V(n) asm volatile("s_waitcnt vmcnt(" #n ")" ::: "memory")
#define G8_WAIT_L(n) asm volatile("s_waitcnt lgkmcnt(" #n ")" ::: "memory")
#define G8_BAR __builtin_amdgcn_s_barrier()
#define G8_SCHED __builtin_amdgcn_sched_barrier(0)
  bf16x8 At[4][2], B0[2][2], B1[2][2];
  const int nt = K >> 6;
  if (STAGE0_ONLY) {
    G8_STAGE_Q(0, 0, 0); G8_STAGE_P(0, 0, 0);
    G8_STAGE_Q(0, 1, 0); G8_STAGE_P(0, 1, 0);
    return;
  }
  if (!staged) {
    __syncthreads();
    G8_STAGE_Q(0, 0, 0); G8_STAGE_P(0, 0, 0);
    G8_STAGE_Q(0, 1, 0); G8_STAGE_P(0, 1, 0);
  }
  if (wr == 1) G8_BAR;
  G8_WAIT_V(4); G8_BAR;
  G8_STAGE_Q(1, 0, 1); G8_STAGE_P(1, 0, 1); G8_STAGE_Q(1, 1, 1);
  G8_WAIT_V(6); G8_BAR;
#pragma unroll 1
  for (int t = 0; t < nt - 2; t += 2) {
    G8_LDB(B0, 0, 0); G8_SCHED; G8_LDA(At, 0, 0); G8_STAGE_P(1, 1, t + 1);
    G8_WAIT_L(8); G8_BAR; G8_WAIT_L(0); G8_MMA(0, 0, At, B0); G8_BAR; G8_SCHED;
    G8_LDB(B1, 0, 1); G8_STAGE_Q(0, 0, t + 2);
    G8_BAR; G8_WAIT_L(0); G8_MMA(0, 1, At, B1); G8_BAR;
    G8_LDA(At, 0, 1); G8_STAGE_P(0, 0, t + 2);
    G8_BAR; G8_WAIT_L(0); G8_MMA(1, 0, At, B0); G8_BAR; G8_SCHED;
    G8_STAGE_Q(0, 1, t + 2);
    G8_WAIT_V(6); G8_BAR; G8_MMA(1, 1, At, B1); G8_BAR;
    G8_LDB(B0, 1, 0); G8_SCHED; G8_LDA(At, 1, 0); G8_STAGE_P(0, 1, t + 2);
    G8_WAIT_L(8); G8_BAR; G8_WAIT_L(0); G8_MMA(0, 0, At, B0); G8_BAR; G8_SCHED;
    G8_LDB(B1, 1, 1); G8_STAGE_Q(1, 0, t + 3);
    G8_BAR; G8_WAIT_L(0); G8_MMA(0, 1, At, B1); G8_BAR;
    G8_LDA(At, 1, 1); G8_STAGE_P(1, 0, t + 3);
    G8_BAR; G8_WAIT_L(0); G8_MMA(1, 0, At, B0); G8_BAR; G8_SCHED;
    G8_STAGE_Q(1, 1, t + 3);
    G8_WAIT_V(6); G8_BAR; G8_MMA(1, 1, At, B1); G8_BAR;
  }
  { G8_LDB(B0, 0, 0); G8_LDA(At, 0, 0); G8_STAGE_P(1, 1, nt - 1);
    G8_BAR; G8_WAIT_L(0); G8_MMA(0, 0, At, B0); G8_BAR;
    G8_LDB(B1, 0, 1); G8_BAR; G8_WAIT_L(0); G8_MMA(0, 1, At, B1); G8_BAR;
    G8_LDA(At, 0, 1); G8_WAIT_V(4); G8_BAR; G8_WAIT_L(0); G8_MMA(1, 0, At, B0); G8_MMA(1, 1, At, B1); G8_BAR; }
  { G8_LDB(B0, 1, 0); G8_LDA(At, 1, 0); G8_WAIT_V(2); G8_BAR; G8_WAIT_L(0); G8_MMA(0, 0, At, B0); G8_BAR;
    G8_LDB(B1, 1, 1); G8_WAIT_V(0); G8_BAR; G8_WAIT_L(0); G8_MMA(0, 1, At, B1); G8_BAR;
    G8_LDA(At, 1, 1); G8_BAR; G8_WAIT_L(0); G8_MMA(1, 0, At, B0); G8_MMA(1, 1, At, B1); G8_BAR; }
  if (wr == 0) G8_BAR;
#undef G8_SA
#undef G8_SB
#undef G8_STAGE_P
#undef G8_STAGE_Q
#undef G8_LDA
#undef G8_LDB
#undef G8_MMA
#undef G8_WAIT_V
#undef G8_WAIT_L
#undef G8_BAR
#undef G8_SCHED
}

DI void gemm8(const bf16_t* P, int ldp, const bf16_t* Q, int ldq, int K, f32x4 (&acc)[2][2][4][2], char* smem, bool staged) {
  gemm8_impl<false>(P, ldp, Q, ldq, K, acc, smem, staged);
}
DI void gemm8_stage0(const bf16_t* P, int ldp, const bf16_t* Q, int ldq, f32x4 (&acc)[2][2][4][2], char* smem) {
  gemm8_impl<true>(P, ldp, Q, ldq, 256, acc, smem, false);
}
struct NextTile { const bf16_t* P; const bf16_t* Q; int ldp; int ldq; bool has; };
DI void zero_acc8(f32x4 (&acc)[2][2][4][2]) {
#pragma unroll
  for (int a = 0; a < 2; ++a)
#pragma unroll
    for (int b = 0; b < 2; ++b)
#pragma unroll
      for (int m = 0; m < 4; ++m)
#pragma unroll
        for (int n = 0; n < 2; ++n) acc[a][b][m][n] = f32x4{0.f, 0.f, 0.f, 0.f};
}
DI uint2 pack4v(f32x4 v, float sc) { return make_uint2(cvtpk(v[0] * sc, v[1] * sc), cvtpk(v[2] * sc, v[3] * sc)); }
DI void rope_quad4(const float2* cs, f32x4 x1, f32x4 x2, float sc, bf16_t* d1, bf16_t* d2) {
  const float4 c01 = ((const float4*)cs)[0], c23 = ((const float4*)cs)[1];
  const float c[4] = {c01.x, c01.z, c23.x, c23.z}, sn[4] = {c01.y, c01.w, c23.y, c23.w};
  float o1[4], o2[4];
#pragma unroll
  for (int j = 0; j < 4; ++j) { o1[j] = (x1[j] * c[j] - x2[j] * sn[j]) * sc; o2[j] = (x2[j] * c[j] + x1[j] * sn[j]) * sc; }
  *(uint2*)d1 = pack4(o1[0], o1[1], o1[2], o1[3]);
  *(uint2*)d2 = pack4(o2[0], o2[1], o2[2], o2[3]);
}

DI void inproj_tile(const Params& p, int layer, int tm, int tn, char* smem, bool staged, const NextTile& nx) {
  f32x4 acc[2][2][4][2]; zero_acc8(acc);
  const int m0 = tm * 256, n0 = tn * 256;
  gemm8(p.winT + ((size_t)layer * DINP + n0) * DM, DM, p.hn + (size_t)m0 * DM, DM, DM, acc, smem, staged);
  if (nx.has) gemm8_stage0(nx.P, nx.ldp, nx.Q, nx.ldq, acc, smem);
  const int tid_ = otid(); const int lane = tid_ & 63, wid = __builtin_amdgcn_readfirstlane(tid_ >> 6), wr = wid >> 2, wc = wid & 3, fr = lane & 15, fq = lane >> 4;
  const int pmask = pos_mask(m0);
#pragma unroll
  for (int bj = 0; bj < 2; ++bj)
#pragma unroll
    for (int n = 0; n < 2; ++n) {
      const int row = m0 + bj * 128 + wc * 32 + n * 16 + fr;
      const int pos = row & pmask;
      bf16_t* zrow = p.z + (size_t)row * ZLD;
#pragma unroll
      for (int ai = 0; ai < 2; ++ai) {
        const int fb = n0 + ai * 128 + wr * 64;
        if (fb >= Z_BQ && fb < Z_BV) {
          const float sc = fb < Z_BK ? SCALE_B : 1.f;
#pragma unroll
          for (int m = 0; m < 2; ++m) {
            const int f0 = m * 16 + fq * 4;
            rope_quad4(p.cs64 + pos * 32 + f0, acc[ai][bj][m][n], acc[ai][bj][m + 2][n], sc, zrow + fb + f0, zrow + fb + 32 + f0);
          }
        } else {
#pragma unroll
          for (int tj = 0; tj < 2; ++tj) {
            const int n32 = fb + tj * 32;
            if (n32 >= DIN) continue;
            const bool rope = (n32 < Z_AV) || (n32 == Z_DKR);
            const float sc = (n32 < Z_AK) ? SCALE_A : ((n32 >= Z_CQ && n32 < Z_CK) ? SCALE_C : 1.f);
            if (rope) {
              rope_quad4(p.cs32 + pos * 16 + fq * 4, acc[ai][bj][2 * tj][n], acc[ai][bj][2 * tj + 1][n], sc, zrow + n32 + fq * 4, zrow + n32 + 16 + fq * 4);
            } else {
              *(uint2*)(zrow + n32 + fq * 4) = pack4v(acc[ai][bj][2 * tj][n], sc);
              *(uint2*)(zrow + n32 + 16 + fq * 4) = pack4v(acc[ai][bj][2 * tj + 1][n], sc);
            }
          }
        }
      }
    }
}

DI void tile_rs(const bf16_t* A, int lda, int K, float* rsv) {
  const int t = otid();
  const uint4* src = (const uint4*)(A + (size_t)(t >> 1) * lda + (t & 1) * (K >> 1));
  float ss = 0.f;
  for (int c = 0; c < (K >> 4); ++c) {
    const uint4 u = src[c];
    ss += bflo(u.x) * bflo(u.x) + bfhi(u.x) * bfhi(u.x) + bflo(u.y) * bflo(u.y) + bfhi(u.y) * bfhi(u.y)
        + bflo(u.z) * bflo(u.z) + bfhi(u.z) * bfhi(u.z) + bflo(u.w) * bflo(u.w) + bfhi(u.w) * bfhi(u.w);
  }
  ss += __shfl_xor(ss, 1);
  if ((t & 1) == 0) rsv[t >> 1] = rsqrtf(ss / (float)K + EPS);
}

DI void upproj_tile(const Params& p, int layer, int tm, int sel, char* smem) {
  const int m0 = tm * 256;
  const int pmask = pos_mask(m0);
  float* rsv = (float*)(smem + SM_RS);
  const int tid_ = otid(); const int lane = tid_ & 63, wave = __builtin_amdgcn_readfirstlane(tid_ >> 6), wm = wave >> 2, wn = wave & 3, r = lane & 31, h = lane >> 5;
  f32x16 acc[4][2]; zero_acc(acc);
  __syncthreads();
  if (sel < 2) {
    const int n0 = sel * 256;
    const bf16_t* A = p.z + (size_t)m0 * ZLD + Z_DCQ;
    tile_rs(A, ZLD, 256, rsv);
    gemm_core(A, ZLD, p.wuqT + ((size_t)layer * 384 + n0) * 256, 256, 256, acc, smem);
#pragma unroll
    for (int ti = 0; ti < 4; ++ti) {
      const int rl = wm * 128 + ti * 32 + r, row = m0 + rl;
      const float rsc = rsv[rl] * SCALE_D;
      bf16_t* qrow = p.qd + (size_t)row * 384;
#pragma unroll
      for (int tj = 0; tj < 2; ++tj) {
        const int n = n0 + wn * 64 + tj * 32;
        if (n >= 384) continue;
        if ((n % 96) == 64) {
#pragma unroll
          for (int g = 0; g < 2; ++g) {
            const int f0 = 8 * g + 4 * h;
            rope_quad(p.cs32 + (row & pmask) * 16 + f0, acc[ti][tj], acc[ti][tj], g, g + 2, rsc, qrow + n + f0, qrow + n + 16 + f0);
          }
        } else {
#pragma unroll
          for (int g = 0; g < 4; ++g)
            *(uint2*)(qrow + n + 8 * g + 4 * h) = pack4(acc[ti][tj][4 * g] * rsc, acc[ti][tj][4 * g + 1] * rsc, acc[ti][tj][4 * g + 2] * rsc, acc[ti][tj][4 * g + 3] * rsc);
        }
      }
    }
  } else {
    const int n0 = (sel - 2) * 256;
    const bf16_t* A = p.z + (size_t)m0 * ZLD + Z_DCKV;
    tile_rs(A, ZLD, 128, rsv);
    gemm_core(A, ZLD, p.wukvT + ((size_t)layer * 512 + n0) * 128, 128, 128, acc, smem);
#pragma unroll
    for (int ti = 0; ti < 4; ++ti) {
      const int rl = wm * 128 + ti * 32 + r, row = m0 + rl;
      const float rsc = rsv[rl];
      bf16_t* krow = p.kvd + (size_t)row * 512 + n0 + wn * 64;
#pragma unroll
      for (int tj = 0; tj < 2; ++tj)
#pragma unroll
        for (int g = 0; g < 4; ++g)
          *(uint2*)(krow + tj * 32 + 8 * g + 4 * h) = pack4(acc[ti][tj][4 * g] * rsc, acc[ti][tj][4 * g + 1] * rsc, acc[ti][tj][4 * g + 2] * rsc, acc[ti][tj][4 * g + 3] * rsc);
    }
  }
}

DI void outproj_tile(const Params& p, int layer, int tm, int tn, char* smem, bool staged, const NextTile& nx) {
  f32x4 acc[2][2][4][2]; zero_acc8(acc);
  const int m0 = tm * 256, n0 = tn * 256;
  gemm8(p.woutT + ((size_t)layer * DM + n0) * DM, DM, p.hn + (size_t)m0 * DM, DM, DM, acc, smem, staged);
  if (nx.has) gemm8_stage0(nx.P, nx.ldp, nx.Q, nx.ldq, acc, smem);
  const int tid_ = otid(); const int lane = tid_ & 63, wid = __builtin_amdgcn_readfirstlane(tid_ >> 6), wr = wid >> 2, wc = wid & 3, fr = lane & 15, fq = lane >> 4;
#pragma unroll
  for (int bj = 0; bj < 2; ++bj)
#pragma unroll
    for (int n = 0; n < 2; ++n) {
      const int row = m0 + bj * 128 + wc * 32 + n * 16 + fr;
      const float* hrow = (layer == 0 ? xrow(p, row) : p.out + (size_t)row * DM) + n0 + wr * 64 + fq * 4;
      float* orow = p.out + (size_t)row * DM + n0 + wr * 64 + fq * 4;
#pragma unroll
      for (int ai = 0; ai < 2; ++ai)
#pragma unroll
        for (int m = 0; m < 4; ++m) {
          const float4 hv = *(const float4*)(hrow + ai * 128 + m * 16);
          const f32x4 a = acc[ai][bj][m][n];
          *(float4*)(orow + ai * 128 + m * 16) = make_float4(hv.x + a[0], hv.y + a[1], hv.z + a[2], hv.w + a[3]);
        }
    }
}

DI void pproj_tile(const Params& p, int layer, int tm, int tn, char* smem, bool staged, const NextTile& nx) {
  f32x4 acc[2][2][4][2]; zero_acc8(acc);
  const int m0 = tm * 256, n0 = tn * 256;
  gemm8(p.wppT + ((size_t)layer * DM + n0) * 256, 256, p.pb + (size_t)m0 * 256, 256, 256, acc, smem, staged);
  if (nx.has) gemm8_stage0(nx.P, nx.ldp, nx.Q, nx.ldq, acc, smem);
  const int tid_ = otid(); const int lane = tid_ & 63, wid = __builtin_amdgcn_readfirstlane(tid_ >> 6), wr = wid >> 2, wc = wid & 3, fr = lane & 15, fq = lane >> 4;
#pragma unroll
  for (int bj = 0; bj < 2; ++bj)
#pragma unroll
    for (int n = 0; n < 2; ++n) {
      const int row = m0 + bj * 128 + wc * 32 + n * 16 + fr;
      bf16_t* prow = p.z + (size_t)row * DM + n0 + wr * 64 + fq * 4;
#pragma unroll
      for (int ai = 0; ai < 2; ++ai)
#pragma unroll
        for (int m = 0; m < 4; ++m) *(uint2*)(prow + ai * 128 + m * 16) = pack4v(acc[ai][bj][m][n], 1.f);
    }
}

DI void ple_tile(const Params& p, int layer, int tm, int tn, char* smem, bool staged, const NextTile& nx) {
  f32x4 acc[2][2][4][2]; zero_acc8(acc);
  const int m0 = tm * 256, n0 = tn * 256;
  gemm8(p.wpgT + ((size_t)layer * DM + n0) * DM, DM, p.hn + (size_t)m0 * DM, DM, DM, acc, smem, staged);
  if (nx.has) gemm8_stage0(nx.P, nx.ldp, nx.Q, nx.ldq, acc, smem);
  const int tid_ = otid(); const int lane = tid_ & 63, wid = __builtin_amdgcn_readfirstlane(tid_ >> 6), wr = wid >> 2, wc = wid & 3, fr = lane & 15, fq = lane >> 4;
#pragma unroll
  for (int bj = 0; bj < 2; ++bj)
#pragma unroll
    for (int n = 0; n < 2; ++n) {
      const int row = m0 + bj * 128 + wc * 32 + n * 16 + fr;
      float* orow = p.out + (size_t)row * DM + n0 + wr * 64 + fq * 4;
      const bf16_t* prow = p.z + (size_t)row * DM + n0 + wr * 64 + fq * 4;
#pragma unroll
      for (int ai = 0; ai < 2; ++ai)
#pragma unroll
        for (int m = 0; m < 4; ++m) {
          const float4 ov = *(const float4*)(orow + ai * 128 + m * 16);
          const uint2 pu = *(const uint2*)(prow + ai * 128 + m * 16);
          const f32x4 a = acc[ai][bj][m][n];
          *(float4*)(orow + ai * 128 + m * 16) = make_float4(ov.x + sigm(a[0]) * bflo(pu.x), ov.y + sigm(a[1]) * bfhi(pu.x),
                                                            ov.z + sigm(a[2]) * bflo(pu.y), ov.w + sigm(a[3]) * bfhi(pu.y));
        }
    }
}

template <int MODE>
DI void attn_item(const Params& p, int layer, int v, char* smem) {
  constexpr int NMAPS = (MODE == 0) ? 2 : 1;
  constexpr int KS = (MODE == 0) ? 2 : ((MODE == 3) ? 6 : 4);
  constexpr int DK = (MODE == 3) ? 96 : 64;
  constexpr int KSTR = (DK + 8) * 2;
  constexpr int VSTR = 144;
  constexpr int KBUF = 64 * KSTR;
  constexpr int BUFB = KBUF + 64 * VSTR;
  constexpr bool LAZY = (MODE == 0 || MODE == 3);
  const int tid = otid(), lane = tid & 63, wave = __builtin_amdgcn_readfirstlane(tid >> 6), r = lane & 31, h = lane >> 5;
  int seq, head, qt, S, row0;
  if (v < 1024) {
    const int b = v & 255, k = v >> 8, x = b & 7, j = b >> 3, pr = x + 8 * k;
    seq = pr >> 2; head = pr & 3; qt = j; S = 8192; row0 = seq * 8192;
  } else {
    const int b = v - 1024, x = b & 7, j = b >> 3, pr = x + 8 * (j >> 4);
    seq = pr >> 2; head = pr & 3; qt = j & 15; S = 4096; row0 = NPROMPT + seq * 4096;
  }
  const int q0 = qt * 256, nkt = S >> 6;
  int kt_lo = 0, kt_hi = nkt, cR = 0, clo = 0;
  if (MODE == 1) { kt_lo = max(0, 4 * qt - 2); kt_hi = min(nkt, 4 * qt + 6); }
  if (MODE == 2) {
    const int R0 = 4 * qt;
    kt_lo = min(max(R0 - 4, 0), nkt - 8); kt_hi = min(max(R0 - 1, 0), nkt - 8) + 8;
    cR = R0 + (wave >> 1); clo = min(max(cR - 4, 0), nkt - 8);
  }
  const bf16_t *qp, *kp, *vp; int ldq, ldk, ldv;
  if (MODE == 0) { qp = p.z + Z_AQ + head * 64; kp = p.z + Z_AK + head * 64; vp = p.z + Z_AV + head * 64; ldq = ldk = ldv = ZLD; }
  else if (MODE == 1) { qp = p.z + Z_BQ + head * 64; kp = p.z + Z_BK + (head >> 1) * 64; vp = p.z + Z_BV + (head >> 1) * 64; ldq = ldk = ldv = ZLD; }
  else if (MODE == 2) { qp = p.z + Z_CQ + head * 64; kp = p.z + Z_CK + head * 64; vp = p.z + Z_CV + head * 64; ldq = ldk = ldv = ZLD; }
  else { qp = p.qd + head * 96; ldq = 384; kp = p.kvd + head * 128; vp = p.kvd + head * 128 + 64; ldk = ldv = 512; }

  float* bias = (float*)(smem + SM_BIAS);
  if (MODE == 2) {
    const float* rp = p.c_rpb + (size_t)(layer * 4 + head) * 465;
    for (int i = tid; i < 465; i += NTHR) bias[i] = rp[i] * LOG2E;
  }

  bf16x8 qf[NMAPS][KS];
  {
    const bf16_t* qrow = qp + (size_t)(row0 + q0 + wave * 32 + r) * ldq + 8 * h;
#pragma unroll
    for (int m = 0; m < NMAPS; ++m)
#pragma unroll
      for (int ks = 0; ks < KS; ++ks) qf[m][ks] = *(const bf16x8*)(qrow + (m * KS + ks) * 16);
  }
  float mrun[NMAPS], lrun[NMAPS];
  f32x16 o[NMAPS][2];
  f32x16 negm[NMAPS];
#pragma unroll
  for (int m = 0; m < NMAPS; ++m) { mrun[m] = LAZY ? 0.f : -1e30f; lrun[m] = 0.f; o[m][0] = f32x16{}; o[m][1] = f32x16{}; negm[m] = f32x16{}; }
  if (MODE == 1) { mrun[0] = p.b_sink[layer * 4 + head] * LOG2E; lrun[0] = (h == 0) ? 1.f : 0.f; }

  const int lrow = tid >> 3, lcc = tid & 7;
  const bf16_t* kg = kp + (size_t)(row0 + lrow) * ldk + lcc * 8;
  const bf16_t* vg = vp + (size_t)(row0 + lrow) * ldv + lcc * 8;
  const bf16_t* k2g = p.z + (size_t)(row0 + ((tid & 255) >> 2)) * ZLD + Z_DKR + (tid & 3) * 8;
  u32x4 kr0, vr0, k2r = u32x4{};
#define ATT_LOAD(kt_)                                                                              \
  {                                                                                                \
    const size_t ro_ = (size_t)(kt_) * 64;                                                         \
    kr0 = *(const u32x4*)(kg + ro_ * ldk);                                                         \
    vr0 = *(const u32x4*)(vg + ro_ * ldv);                                                         \
    if (MODE == 3) { if (tid < 256) k2r = *(const u32x4*)(k2g + ro_ * ZLD); }                      \
  }
#define ATT_STORE(buf_)                                                                            \
  {                                                                                                \
    char* kb_ = smem + (buf_) * BUFB;                                                              \
    *(u32x4*)(kb_ + lrow * KSTR + lcc * 16) = kr0;                                                 \
    *(u32x4*)(kb_ + KBUF + lrow * VSTR + lcc * 16) = vr0;                                          \
    if (MODE == 3) { if (tid < 256) *(u32x4*)(kb_ + (tid >> 2) * KSTR + 128 + (tid & 3) * 16) = k2r; } \
  }
  ATT_LOAD(kt_lo);
  ATT_STORE(0);
  __syncthreads();

  const int i16 = lane & 15;
  const int voff = (4 * h + (i16 >> 2)) * VSTR + (((lane >> 4) & 1) * 16 + (i16 & 3) * 4) * 2;
  const int qi = q0 + wave * 32 + r;
  const int cc = (wave & 1) * 32 + r;
  const int ccs = min(max(cc - 8, 0), 48);

  if (wave >= 4) __builtin_amdgcn_s_setprio(1);
#pragma unroll 1
  for (int kt = kt_lo; kt < kt_hi; ++kt) {
    const int cur = (kt - kt_lo) & 1;
    if (kt + 1 < kt_hi) ATT_LOAD(kt + 1);
    const bool active = (MODE == 2) ? (kt >= clo && kt < clo + 8)
                      : ((MODE == 1) ? (kt * 64 + 63 >= q0 + wave * 32 - 128 && kt * 64 <= q0 + wave * 32 + 31 + 128) : true);
    if (active) {
      const char* kb = smem + cur * BUFB;
      const char* vb = kb + KBUF;
      bf16x8 pf[NMAPS][2][2];
#pragma unroll
      for (int m = 0; m < NMAPS; ++m) {
        f32x16 st[2];
#pragma unroll
        for (int sub = 0; sub < 2; ++sub) {
          f32x16 s;
          if (LAZY) s = negm[m]; else s = f32x16{};
#pragma unroll
          for (int ks = 0; ks < KS; ++ks) {
            const bf16x8 kf = *(const bf16x8*)(kb + (sub * 32 + r) * KSTR + ((m * KS + ks) * 16 + 8 * h) * 2);
            s = MFMA(kf, qf[m][ks], s);
          }
          st[sub] = s;
        }
        if (MODE == 1) {
          int tb = kt * 64 + 4 * h - qi + 128;
          asm volatile("" : "+v"(tb));
#pragma unroll
          for (int sub = 0; sub < 2; ++sub)
#pragma unroll
            for (int i = 0; i < 16; ++i) {
              const int c0 = sub * 32 + (i & 3) + 8 * (i >> 2);
              if ((unsigned)(tb + c0) > 256u) st[sub][i] = -INFINITY;
            }
        }
        if (MODE == 2) {
          int tcc = 4 * h - cc + 15 + (kt - cR + 7) * 31, tcs = 4 * h - ccs;
          asm volatile("" : "+v"(tcc), "+v"(tcs));
#pragma unroll
          for (int sub = 0; sub < 2; ++sub)
#pragma unroll
            for (int i = 0; i < 16; ++i) {
              const int c0 = sub * 32 + (i & 3) + 8 * (i >> 2);
              const bool valid = (unsigned)(c0 + tcs) < 16u;
              const int idx = valid ? tcc + c0 : 0;
              const float bv = bias[idx];
              st[sub][i] = valid ? st[sub][i] + bv : -INFINITY;
            }
        }
        auto tile_max = [&]() {
          float mx_ = fmaxf(fmaxf(st[0][0], st[0][1]), st[1][0]);
          float mb_ = fmaxf(fmaxf(st[0][2], st[0][3]), st[1][1]);
          mx_ = fmaxf(fmaxf(mx_, st[1][2]), st[1][3]);
#pragma unroll
          for (int i = 4; i < 16; i += 4) {
            mx_ = fmaxf(fmaxf(mx_, st[0][i]), st[0][i + 1]); mb_ = fmaxf(fmaxf(mb_, st[0][i + 2]), st[0][i + 3]);
            mx_ = fmaxf(fmaxf(mx_, st[1][i]), st[1][i + 1]); mb_ = fmaxf(fmaxf(mb_, st[1][i + 2]), st[1][i + 3]);
          }
          return swap_max(fmaxf(mx_, mb_));
        };
        float mx = 0.f;
        if (!LAZY) mx = tile_max();
        if (LAZY) {
          int ia = max(max(__float_as_int(st[0][0]), __float_as_int(st[0][1])), __float_as_int(st[1][0]));
          int ib = max(max(__float_as_int(st[0][2]), __float_as_int(st[0][3])), __float_as_int(st[1][1]));
          ia = max(max(ia, __float_as_int(st[1][2])), __float_as_int(st[1][3]));
#pragma unroll
          for (int i = 4; i < 16; i += 4) {
            ia = max(max(ia, __float_as_int(st[0][i])), __float_as_int(st[0][i + 1])); ib = max(max(ib, __float_as_int(st[0][i + 2])), __float_as_int(st[0][i + 3]));
            ia = max(max(ia, __float_as_int(st[1][i])), __float_as_int(st[1][i + 1])); ib = max(max(ib, __float_as_int(st[1][i + 2])), __float_as_int(st[1][i + 3]));
          }
          ia = max(ia, ib);
          const bool first = (kt == kt_lo);
          if (first || __builtin_amdgcn_ballot_w64(ia > 0x41000000) != 0) {
            mx = tile_max();
            const float delta = first ? mx : fmaxf(mx, 0.f);
            const float alpha = first ? 1.f : ex2(-delta);
            mrun[m] += delta;
            lrun[m] *= alpha;
#pragma unroll
            for (int i = 0; i < 16; ++i) { o[m][0][i] *= alpha; o[m][1][i] *= alpha; st[0][i] -= delta; st[1][i] -= delta; }
            const float nm = -mrun[m];
#pragma unroll
            for (int i = 0; i < 16; ++i) negm[m][i] = nm;
          }
          f32x2 l2[4] = {{0.f, 0.f}, {0.f, 0.f}, {0.f, 0.f}, {0.f, 0.f}};
#pragma unroll
          for (int sub = 0; sub < 2; ++sub)
#pragma unroll
            for (int i = 0; i < 16; i += 2) {
              const float p0 = ex2(st[sub][i]), p1 = ex2(st[sub][i + 1]);
              st[sub][i] = p0; st[sub][i + 1] = p1;
              l2[(i >> 1) & 3] += f32x2{p0, p1};
            }
          const f32x2 lt = (l2[0] + l2[1]) + (l2[2] + l2[3]);
          lrun[m] += lt[0] + lt[1];
        } else {
          const float mnew = fmaxf(mrun[m], mx);
          const float alpha = ex2(mrun[m] - mnew);
          mrun[m] = mnew;
          float ls = 0.f;
#pragma unroll
          for (int sub = 0; sub < 2; ++sub)
#pragma unroll
            for (int i = 0; i < 16; ++i) { const float pv = ex2(st[sub][i] - mnew); ls += pv; st[sub][i] = pv; }
          lrun[m] = lrun[m] * alpha + ls;
#pragma unroll
          for (int i = 0; i < 16; ++i) { o[m][0][i] *= alpha; o[m][1][i] *= alpha; }
        }
#pragma unroll
        for (int sub = 0; sub < 2; ++sub)
#pragma unroll
          for (int kk = 0; kk < 2; ++kk) {
            const uint4 u = make_uint4(cvtpk(st[sub][8 * kk + 0], st[sub][8 * kk + 1]), cvtpk(st[sub][8 * kk + 2], st[sub][8 * kk + 3]),
                                       cvtpk(st[sub][8 * kk + 4], st[sub][8 * kk + 5]), cvtpk(st[sub][8 * kk + 6], st[sub][8 * kk + 7]));
            pf[m][sub][kk] = __builtin_bit_cast(bf16x8, u);
          }
      }
#pragma unroll
      for (int sub = 0; sub < 2; ++sub)
#pragma unroll
        for (int kk = 0; kk < 2; ++kk)
#pragma unroll
          for (int dvt = 0; dvt < 2; ++dvt) {
            const char* va = vb + voff + (sub * 32 + kk * 16) * VSTR + dvt * 64;
            const s16x4 lo = vtr(va), hi = vtr(va + 8 * VSTR);
            const bf16x8 vf = __builtin_shufflevector(lo, hi, 0, 1, 2, 3, 4, 5, 6, 7);
#pragma unroll
            for (int m = 0; m < NMAPS; ++m) o[m][dvt] = MFMA(vf, pf[m][sub][kk], o[m][dvt]);
          }
    }
    if (kt + 1 < kt_hi) ATT_STORE(cur ^ 1);
    __syncthreads();
  }
  if (wave >= 4) __builtin_amdgcn_s_setprio(0);
#undef ATT_LOAD
#undef ATT_STORE

  float inv[NMAPS];
#pragma unroll
  for (int m = 0; m < NMAPS; ++m) inv[m] = 1.f / swap_sum(lrun[m]);
  f32x16 res[2];
  if (MODE == 0) {
    const float lam = p.lam[layer];
    const float lam_init = 0.8f - 0.6f * __expf(-0.3f * (float)layer);
    float ss = 0.f;
#pragma unroll
    for (int dvt = 0; dvt < 2; ++dvt)
#pragma unroll
      for (int i = 0; i < 16; ++i) { const float t = o[0][dvt][i] * inv[0] - lam * (o[NMAPS - 1][dvt][i] * inv[NMAPS - 1]); res[dvt][i] = t; ss += t * t; }
    ss = swap_sum(ss);
    const float rs = rsqrtf(ss * (1.f / 64.f) + EPS) * (1.f - lam_init);
    const float* sg = p.a_subln_g + layer * 64;
#pragma unroll
    for (int dvt = 0; dvt < 2; ++dvt)
#pragma unroll
      for (int i = 0; i < 16; ++i) res[dvt][i] *= rs * sg[dvt * 32 + crow(i, h)];
  } else {
#pragma unroll
    for (int dvt = 0; dvt < 2; ++dvt)
#pragma unroll
      for (int i = 0; i < 16; ++i) res[dvt][i] = o[0][dvt][i] * inv[0];
  }
  {
    const size_t row = (size_t)(row0 + qi);
    const bf16_t* gp = p.z + row * ZLD + Z_GATE + MODE * 256 + head * 64;
    bf16_t* mp = p.hn + row * DM + MODE * 256 + head * 64;
#pragma unroll
    for (int dvt = 0; dvt < 2; ++dvt)
#pragma unroll
      for (int ig = 0; ig < 4; ++ig) {
        const int dv0 = dvt * 32 + ig * 8 + 4 * h;
        const uint2 gu = *(const uint2*)(gp + dv0);
        const float g0 = bflo(gu.x), g1 = bfhi(gu.x), g2 = bflo(gu.y), g3 = bfhi(gu.y);
        const float a0 = res[dvt][ig * 4 + 0] * g0 * sigm(g0), a1 = res[dvt][ig * 4 + 1] * g1 * sigm(g1);
        const float a2 = res[dvt][ig * 4 + 2] * g2 * sigm(g2), a3 = res[dvt][ig * 4 + 3] * g3 * sigm(g3);
        *(uint2*)(mp + dv0) = make_uint2(cvtpk(a0, a1), cvtpk(a2, a3));
      }
  }
}

__global__ void __launch_bounds__(512, 2) mega_fwd(Params p) {
  __shared__ __attribute__((aligned(16))) char smem[SMEM_BYTES];
  cg::grid_group grid = cg::this_grid();
  const int nb = gridDim.x;

  phase_prep(p, smem);
  grid.sync();
#pragma unroll 1
  for (int layer = 0; layer < 2; ++layer) {
    phase_norm(p, layer, 0);
    grid.sync();
    {
      bool staged = false;
      for (int v = blockIdx.x; v < 18 * 256; v += nb) {
        const int b = v & 255, k = v >> 8, x = b & 7, j = b >> 3, st = k * 8 + x;
        if (st >= 140) continue;
        const int tm = (st / 7) * 16 + (j >> 1), tn = (st % 7) * 2 + (j & 1);
        NextTile nx;
        {
          const int v2 = v + nb, b2 = v2 & 255, k2 = v2 >> 8, st2 = k2 * 8 + (b2 & 7), j2 = b2 >> 3;
          nx.has = (v2 < 18 * 256) && (st2 < 140);
          const int tm2 = (st2 / 7) * 16 + (j2 >> 1), tn2 = (st2 % 7) * 2 + (j2 & 1);
          nx.P = p.winT + ((size_t)layer * DINP + tn2 * 256) * DM; nx.Q = p.hn + (size_t)tm2 * 256 * DM; nx.ldp = DM; nx.ldq = DM;
        }
        inproj_tile(p, layer, tm, tn, smem, staged, nx);
        staged = nx.has;
      }
    }
    grid.sync();
    for (int v = blockIdx.x; v < 1280 + 1280 + 1280 + 1280; v += nb) {
      if (v < 1280) attn_item<0>(p, layer, v, smem);
      else if (v < 2560) { const int u = v - 1280; upproj_tile(p, layer, u >> 2, u & 3, smem); }
      else if (v < 3840) attn_item<1>(p, layer, v - 2560, smem);
      else attn_item<2>(p, layer, v - 3840, smem);
    }
    grid.sync();
    for (int v = blockIdx.x; v < 1280; v += nb) attn_item<3>(p, layer, v, smem);
    grid.sync();
    {
      bool staged = false;
      for (int v = blockIdx.x; v < 2560; v += nb) {
        const int vv = v < 1280 ? v : v - 1280;
        const int b = vv & 255, k = vv >> 8, x = b & 7, j = b >> 3, st = k * 8 + x;
        NextTile nx;
        {
          const int v2 = v + nb, vv2 = v2 < 1280 ? v2 : v2 - 1280;
          const int b2 = vv2 & 255, st2 = (vv2 >> 8) * 8 + (b2 & 7), j2 = b2 >> 3, tm2 = st2 * 8 + (j2 >> 2), tn2 = j2 & 3;
          nx.has = v2 < 2560;
          if (v2 < 1280) { nx.P = p.woutT + ((size_t)layer * DM + tn2 * 256) * DM; nx.Q = p.hn + (size_t)tm2 * 256 * DM; nx.ldp = DM; nx.ldq = DM; }
          else { nx.P = p.wppT + ((size_t)layer * DM + tn2 * 256) * 256; nx.Q = p.pb + (size_t)tm2 * 256 * 256; nx.ldp = 256; nx.ldq = 256; }
        }
        if (v < 1280) outproj_tile(p, layer, st * 8 + (j >> 2), j & 3, smem, staged, nx);
        else pproj_tile(p, layer, st * 8 + (j >> 2), j & 3, smem, staged, nx);
        staged = nx.has;
      }
    }
    grid.sync();
    phase_norm(p, layer, 1);
    grid.sync();
    {
      bool staged = false;
      for (int v = blockIdx.x; v < 1280; v += nb) {
        const int b = v & 255, k = v >> 8, x = b & 7, j = b >> 3, st = k * 8 + x;
        NextTile nx;
        {
          const int v2 = v + nb, b2 = v2 & 255, st2 = (v2 >> 8) * 8 + (b2 & 7), j2 = b2 >> 3, tm2 = st2 * 8 + (j2 >> 2), tn2 = j2 & 3;
          nx.has = v2 < 1280;
          nx.P = p.wpgT + ((size_t)layer * DM + tn2 * 256) * DM; nx.Q = p.hn + (size_t)tm2 * 256 * DM; nx.ldp = DM; nx.ldq = DM;
        }
        ple_tile(p, layer, st * 8 + (j >> 2), j & 3, smem, staged, nx);
        staged = nx.has;
      }
    }
    grid.sync();
  }
  phase_norm(p, 0, 2);
}

extern "C" void kernel_launch(void* const* d_in, const int* in_sizes, int n_in, void* d_out, int out_size, void* d_ws, size_t ws_size,
                              hipStream_t stream) {
  Params p{};
  p.x_prompt = (const float*)d_in[0]; p.x_sample = (const float*)d_in[1]; p.p_prompt = (const float*)d_in[2]; p.p_sample = (const float*)d_in[3];
  p.norm_g = (const float*)d_in[4]; p.w_in = (const float*)d_in[5]; p.a_lambda = (const float*)d_in[6]; p.a_subln_g = (const float*)d_in[7];
  p.b_sink = (const float*)d_in[8]; p.c_rpb = (const float*)d_in[9]; p.d_q_norm_g = (const float*)d_in[10]; p.d_kv_norm_g = (const float*)d_in[11];
  p.d_w_uq = (const float*)d_in[12]; p.d_w_ukv = (const float*)d_in[13]; p.w_out = (const float*)d_in[14]; p.ple_norm_g = (const float*)d_in[15];
  p.w_ple_gate = (const float*)d_in[16]; p.w_ple_proj = (const float*)d_in[17]; p.final_norm_g = (const float*)d_in[18];
  p.out = (float*)d_out;
  char* w = (char*)d_ws; size_t off = 0;
  auto carve = [&](size_t bytes) { char* r = w + off; off += (bytes + 255) & ~(size_t)255; return r; };
  p.hn = (bf16_t*)carve((size_t)NTOK * DM * 2);
  p.z = (bf16_t*)carve((size_t)NTOK * ZLD * 2);
  p.qd = (bf16_t*)carve((size_t)NTOK * 384 * 2);
  p.pb = (bf16_t*)carve((size_t)NTOK * 256 * 2);
  p.kvd = (bf16_t*)carve((size_t)NTOK * 512 * 2);
  p.winT = (bf16_t*)carve((size_t)2 * DINP * DM * 2);
  p.wuqT = (bf16_t*)carve((size_t)2 * 384 * 256 * 2);
  p.wukvT = (bf16_t*)carve((size_t)2 * 512 * 128 * 2);
  p.woutT = (bf16_t*)carve((size_t)2 * DM * DM * 2);
  p.wpgT = (bf16_t*)carve((size_t)2 * DM * DM * 2);
  p.wppT = (bf16_t*)carve((size_t)2 * DM * 256 * 2);
  p.cs32 = (float2*)carve((size_t)8192 * 16 * 8);
  p.cs64 = (float2*)carve((size_t)8192 * 32 * 8);
  p.lam = (float*)carve(256);
  if (off > ws_size) { fprintf(stderr, "workspace too small: need %zu have %zu\n", off, ws_size); return; }
  static int grid_blocks = 0;
  if (!grid_blocks) {
    int dev = 0, cus = 0, per_cu = 0;
    hipGetDevice(&dev);
    hipDeviceGetAttribute(&cus, hipDeviceAttributeMultiprocessorCount, dev);
    hipOccupancyMaxActiveBlocksPerMultiprocessor(&per_cu, mega_fwd, NTHR, 0);
    if (per_cu > 1) per_cu = 1;
    if (per_cu < 1) per_cu = 1;
    grid_blocks = cus * per_cu;
  }
  void* args[] = {&p};
  hipError_t e = hipLaunchCooperativeKernel((void*)mega_fwd, dim3(grid_blocks), dim3(NTHR), args, 0, stream);
  if (e != hipSuccess) fprintf(stderr, "cooperative launch failed: %s (grid %d)\n", hipGetErrorString(e), grid_blocks);
}
```

```cpp
#include <hip/hip_runtime.h>
#include <hip/hip_cooperative_groups.h>
#include <stdint.h>
#include <stdio.h>
namespace cg = cooperative_groups;

typedef __attribute__((ext_vector_type(8))) short bf16x8;
typedef __attribute__((ext_vector_type(4))) short s16x4;
typedef __attribute__((ext_vector_type(16))) float f32x16;
typedef short v4i16_t __attribute__((ext_vector_type(4)));
typedef __bf16 bf16v2 __attribute__((ext_vector_type(2)));
typedef unsigned short bf16_t;
typedef unsigned u32x4 __attribute__((ext_vector_type(4)));
typedef float f32x2 __attribute__((ext_vector_type(2)));
typedef float f32x4 __attribute__((ext_vector_type(4)));
typedef __attribute__((address_space(3))) unsigned* lds_uptr;
typedef __attribute__((address_space(3))) const char* lds_cptr;

#define DI __device__ __forceinline__
#define MFMA(a, b, c) __builtin_amdgcn_mfma_f32_32x32x16_bf16((a), (b), (c), 0, 0, 0)

constexpr int NTOK = 81920, NPROMPT = 65536, DM = 1024, DIN = 3488, DINP = 3584, ZLD = 3488;
constexpr int Z_AQ = 0, Z_AK = 256, Z_AV = 512, Z_BQ = 768, Z_BK = 1024, Z_BV = 1152, Z_CQ = 1280, Z_CK = 1536, Z_CV = 1792,
              Z_DCQ = 2048, Z_DCKV = 2304, Z_DKR = 2432, Z_GATE = 2464;
constexpr float LOG2E = 1.4426950408889634f;
constexpr float SCALE_A = 0.17677669529663687f * LOG2E;
constexpr float SCALE_B = 0.125f * LOG2E;
constexpr float SCALE_C = 0.125f * LOG2E;
constexpr float SCALE_D = 0.10206207261596575f * LOG2E;
constexpr float EPS = 1e-6f;

constexpr int G_ROWB = 144;
constexpr int G_TILEB = 256 * G_ROWB;
constexpr int SM_RS = 4 * G_TILEB;
constexpr int SM_BIAS = 46080;
constexpr int SM_XB = SM_RS + 1024;
constexpr int SMEM_BYTES = SM_XB + 16;
constexpr int NTHR = 512;
#define XCD_BAR_WORDS 3456

struct Params {
  const float* x_prompt; const float* x_sample; const float* p_prompt; const float* p_sample;
  const float* norm_g; const float* w_in; const float* a_lambda; const float* a_subln_g; const float* b_sink; const float* c_rpb;
  const float* d_q_norm_g; const float* d_kv_norm_g; const float* d_w_uq; const float* d_w_ukv; const float* w_out; const float* ple_norm_g;
  const float* w_ple_gate; const float* w_ple_proj; const float* final_norm_g;
  float* out;
  bf16_t* hn;
  bf16_t* z;
  bf16_t* qd;
  bf16_t* pb;
  bf16_t* kvd;
  bf16_t* winT; bf16_t* wuqT; bf16_t* wukvT; bf16_t* woutT; bf16_t* wpgT; bf16_t* wppT;
  float2* cs32; float2* cs64; float* lam;
  unsigned* bar;
};

DI unsigned cvtpk(float lo, float hi) { bf16v2 v = {(__bf16)lo, (__bf16)hi}; return __builtin_bit_cast(unsigned, v); }
DI bf16_t f2bf(float x) { __bf16 b = (__bf16)x; return __builtin_bit_cast(bf16_t, b); }
DI float bf2f(unsigned v16) { return __uint_as_float(v16 << 16); }
DI float bflo(unsigned u) { return __uint_as_float(u << 16); }
DI float bfhi(unsigned u) { return __uint_as_float(u & 0xffff0000u); }
DI int otid() { int t = threadIdx.x; asm volatile("" : "+v"(t)); return t; }
DI int crow(int i, int h) { return (i & 3) + 8 * (i >> 2) + 4 * h; }
DI float ex2(float x) { return __builtin_amdgcn_exp2f(x); }
DI float sigm(float x) { return 1.f / (1.f + __expf(-x)); }
DI const float* xrow(const Params& p, int row) { return row < NPROMPT ? p.x_prompt + (size_t)row * DM : p.x_sample + (size_t)(row - NPROMPT) * DM; }
DI int pos_of(int row) { return row < NPROMPT ? (row & 8191) : (row & 4095); }
DI int pos_mask(int m0) { return m0 < NPROMPT ? 8191 : 4095; }
DI float swap_max(float m) { auto rr = __builtin_amdgcn_permlane32_swap(__float_as_uint(m), __float_as_uint(m), false, false); return fmaxf(__uint_as_float(rr[0]), __uint_as_float(rr[1])); }
DI float swap_sum(float m) { auto rr = __builtin_amdgcn_permlane32_swap(__float_as_uint(m), __float_as_uint(m), false, false); return __uint_as_float(rr[0]) + __uint_as_float(rr[1]); }
DI s16x4 vtr(const char* p) { return __builtin_bit_cast(s16x4, __builtin_amdgcn_ds_read_tr16_b64_v4i16((__attribute__((address_space(3))) v4i16_t*)(lds_cptr)p)); }

DI void transpose_tile(const float* __restrict__ W, int K, int N, bf16_t* __restrict__ WT, const float* __restrict__ gfold, int tile, char* smem) {
  const int kt = K >> 6;
  const int n0 = (tile / kt) * 64, k0 = (tile % kt) * 64;
  float* t = (float*)smem;
  const int tid = otid();
  __syncthreads();
  if (tid < 256) {
    const int nn = tid & 63, kb = tid >> 6;
#pragma unroll
    for (int i = 0; i < 16; ++i) {
      const int kk = kb + 4 * i;
      float v = 0.f;
      if (n0 + nn < N) { v = W[(size_t)(k0 + kk) * N + n0 + nn]; if (gfold) v *= gfold[k0 + kk]; }
      t[kk * 65 + nn] = v;
    }
  }
  __syncthreads();
  if (tid < 256) {
    const int nl = tid >> 2, kq = (tid & 3) * 16;
    unsigned u[8];
#pragma unroll
    for (int j = 0; j < 8; ++j) u[j] = cvtpk(t[(kq + 2 * j) * 65 + nl], t[(kq + 2 * j + 1) * 65 + nl]);
    uint4* dst = (uint4*)(WT + (size_t)(n0 + nl) * K + k0 + kq);
    dst[0] = make_uint4(u[0], u[1], u[2], u[3]);
    dst[1] = make_uint4(u[4], u[5], u[6], u[7]);
  }
}

DI void phase_prep(const Params& p, char* smem) {
  for (int v = blockIdx.x; v < 2 * 1512; v += gridDim.x) {
    const int layer = v / 1512; int t = v % 1512;
    if (t < 896) { transpose_tile(p.w_in + (size_t)layer * DM * DIN, DM, DIN, p.winT + (size_t)layer * DINP * DM, nullptr, t, smem); continue; }
    t -= 896;
    if (t < 24) { transpose_tile(p.d_w_uq + (size_t)layer * 256 * 384, 256, 384, p.wuqT + (size_t)layer * 384 * 256, p.d_q_norm_g + layer * 256, t, smem); continue; }
    t -= 24;
    if (t < 16) { transpose_tile(p.d_w_ukv + (size_t)layer * 128 * 512, 128, 512, p.wukvT + (size_t)layer * 512 * 128, p.d_kv_norm_g + layer * 128, t, smem); continue; }
    t -= 16;
    if (t < 256) { transpose_tile(p.w_out + (size_t)layer * DM * DM, DM, DM, p.woutT + (size_t)layer * DM * DM, nullptr, t, smem); continue; }
    t -= 256;
    if (t < 256) { transpose_tile(p.w_ple_gate + (size_t)layer * DM * DM, DM, DM, p.wpgT + (size_t)layer * DM * DM, nullptr, t, smem); continue; }
    t -= 256;
    transpose_tile(p.w_ple_proj + (size_t)layer * 256 * DM, 256, DM, p.wppT + (size_t)layer * DM * 256, nullptr, t, smem);
  }
  const int gt = blockIdx.x * NTHR + otid(), nt = gridDim.x * NTHR;
  for (int i = gt; i < XCD_BAR_WORDS; i += nt) p.bar[i] = 0u;
  for (int i = gt; i < 8192 * 48; i += nt) {
    int pos, f, dim; float2* dst;
    if (i < 8192 * 16) { pos = i >> 4; f = i & 15; dim = 32; dst = p.cs32 + i; }
    else { const int j = i - 8192 * 16; pos = j >> 5; f = j & 31; dim = 64; dst = p.cs64 + j; }
    const float inv = exp2f(-(float)(2 * f) / (float)dim * 13.287712379549449f);
    const double ang = (double)pos * (double)inv;
    double rev = ang * 0.15915494309189535;
    rev = rev - __builtin_rint(rev);
    const float fr = (float)rev;
    *dst = make_float2(__builtin_amdgcn_cosf(fr), __builtin_amdgcn_sinf(fr));
  }
  if (blockIdx.x == 0 && threadIdx.x < 2) {
    const int layer = threadIdx.x;
    const float* lv = p.a_lambda + layer * 128;
    float s1 = 0.f, s2 = 0.f;
    for (int i = 0; i < 32; ++i) { s1 += lv[i] * lv[32 + i]; s2 += lv[64 + i] * lv[96 + i]; }
    const float lam_init = 0.8f - 0.6f * expf(-0.3f * (float)layer);
    p.lam[layer] = expf(s1) - expf(s2) + lam_init;
  }
}

DI void phase_norm(const Params& p, int layer, int kind) {
  const int tid_ = otid(); const int lane = tid_ & 63, wave = __builtin_amdgcn_readfirstlane(tid_ >> 6);
  const float* g = kind == 0 ? p.norm_g + layer * DM : (kind == 1 ? p.ple_norm_g + layer * DM : p.final_norm_g);
  float4 g4[4];
#pragma unroll
  for (int j = 0; j < 4; ++j) g4[j] = ((const float4*)g)[lane + 64 * j];
  for (int row = blockIdx.x * 8 + wave; row < NTOK; row += gridDim.x * 8) {
    const float* src = (kind == 0 && layer == 0) ? xrow(p, row) : p.out + (size_t)row * DM;
    float4 v[4];
#pragma unroll
    for (int j = 0; j < 4; ++j) v[j] = ((const float4*)src)[lane + 64 * j];
    float ss = 0.f;
#pragma unroll
    for (int j = 0; j < 4; ++j) ss += v[j].x * v[j].x + v[j].y * v[j].y + v[j].z * v[j].z + v[j].w * v[j].w;
#pragma unroll
    for (int o = 32; o >= 1; o >>= 1) ss += __shfl_xor(ss, o);
    const float rs = rsqrtf(ss * (1.f / 1024.f) + EPS);
    if (kind == 2) {
      float4* dst = (float4*)(p.out + (size_t)row * DM);
#pragma unroll
      for (int j = 0; j < 4; ++j) dst[lane + 64 * j] = make_float4(v[j].x * rs * g4[j].x, v[j].y * rs * g4[j].y, v[j].z * rs * g4[j].z, v[j].w * rs * g4[j].w);
    } else {
      uint2* dst = (uint2*)(p.hn + (size_t)row * DM);
#pragma unroll
      for (int j = 0; j < 4; ++j) dst[lane + 64 * j] = make_uint2(cvtpk(v[j].x * rs * g4[j].x, v[j].y * rs * g4[j].y), cvtpk(v[j].z * rs * g4[j].z, v[j].w * rs * g4[j].w));
      if (kind == 0) {
        const float* ps = row < NPROMPT ? p.p_prompt + ((size_t)layer * NPROMPT + row) * 256 : p.p_sample + ((size_t)layer * (NTOK - NPROMPT) + (row - NPROMPT)) * 256;
        const float4 pv = ((const float4*)ps)[lane];
        ((uint2*)(p.pb + (size_t)row * 256))[lane] = make_uint2(cvtpk(pv.x, pv.y), cvtpk(pv.z, pv.w));
      }
    }
  }
}

DI void gemm_core(const bf16_t* __restrict__ A, int lda, const bf16_t* __restrict__ W, int ldw, int K, f32x16 (&acc)[4][2], char* smem) {
  const int tid = otid(), lane = tid & 63, wave = __builtin_amdgcn_readfirstlane(tid >> 6), wm = wave >> 2, wn = wave & 3, r = lane & 31, h = lane >> 5;
  const int lrow = tid >> 3, lcc = tid & 7;
  const char* ag = (const char*)(A + (size_t)lrow * lda + lcc * 8);
  const char* wg = (const char*)(W + (size_t)lrow * ldw + lcc * 8);
  const size_t astep = (size_t)64 * lda * 2, wstep = (size_t)64 * ldw * 2;
  char* As = smem; char* Bs = smem + 2 * G_TILEB;
  const int soff = lrow * G_ROWB + lcc * 16;
  u32x4 ra[4], rb[4];
#pragma unroll
  for (int i = 0; i < 4; ++i) { ra[i] = *(const u32x4*)(ag + i * astep); rb[i] = *(const u32x4*)(wg + i * wstep); }
#pragma unroll
  for (int i = 0; i < 4; ++i) { *(u32x4*)(As + soff + i * 64 * G_ROWB) = ra[i]; *(u32x4*)(Bs + soff + i * 64 * G_ROWB) = rb[i]; }
  __syncthreads();
  const int nk = K >> 6;
  const int aoff = (wm * 128 + r) * G_ROWB + h * 16;
  const int boff = (wn * 64 + r) * G_ROWB + h * 16;
#pragma unroll 1
  for (int kt = 0; kt < nk; ++kt) {
    const int cur = kt & 1;
    if (kt + 1 < nk) {
#pragma unroll
      for (int i = 0; i < 4; ++i) { ra[i] = *(const u32x4*)(ag + i * astep + (size_t)(kt + 1) * 128); rb[i] = *(const u32x4*)(wg + i * wstep + (size_t)(kt + 1) * 128); }
    }
    const char* Ac = As + cur * G_TILEB + aoff; const char* Bc = Bs + cur * G_TILEB + boff;
#pragma unroll
    for (int ks = 0; ks < 4; ++ks) {
      const bf16x8 b0 = *(const bf16x8*)(Bc + ks * 32), b1 = *(const bf16x8*)(Bc + 32 * G_ROWB + ks * 32);
#pragma unroll
      for (int ti = 0; ti < 4; ++ti) {
        const bf16x8 a = *(const bf16x8*)(Ac + ti * 32 * G_ROWB + ks * 32);
        acc[ti][0] = MFMA(b0, a, acc[ti][0]); acc[ti][1] = MFMA(b1, a, acc[ti][1]);
      }
    }
    if (kt + 1 < nk) {
      const int nb = cur ^ 1;
#pragma unroll
      for (int i = 0; i < 4; ++i) { *(u32x4*)(As + nb * G_TILEB + soff + i * 64 * G_ROWB) = ra[i]; *(u32x4*)(Bs + nb * G_TILEB + soff + i * 64 * G_ROWB) = rb[i]; }
    }
    __syncthreads();
  }
}

DI void zero_acc(f32x16 (&acc)[4][2]) {
#pragma unroll
  for (int a = 0; a < 4; ++a)
#pragma unroll
    for (int b = 0; b < 2; ++b) acc[a][b] = f32x16{};
}

DI uint2 pack4(float a, float b, float c, float d) { return make_uint2(cvtpk(a, b), cvtpk(c, d)); }
DI void rope_quad(const float2* cs, const f32x16& t1, const f32x16& t2, int q1, int q2, float sc, bf16_t* d1, bf16_t* d2) {
  const float4 c01 = ((const float4*)cs)[0], c23 = ((const float4*)cs)[1];
  const float c[4] = {c01.x, c01.z, c23.x, c23.z}, sn[4] = {c01.y, c01.w, c23.y, c23.w};
  float o1[4], o2[4];
#pragma unroll
  for (int j = 0; j < 4; ++j) {
    const float x1 = t1[q1 * 4 + j], x2 = t2[q2 * 4 + j];
    o1[j] = (x1 * c[j] - x2 * sn[j]) * sc; o2[j] = (x2 * c[j] + x1 * sn[j]) * sc;
  }
  *(uint2*)d1 = pack4(o1[0], o1[1], o1[2], o1[3]);
  *(uint2*)d2 = pack4(o2[0], o2[1], o2[2], o2[3]);
}

DI void g8_stage_rc(int b, int& R, int& C) {
  const int st = b / 1024, sb = b % 1024, swz = sb ^ (((sb >> 9) & 1) << 5);
  R = (st >> 1) * 16 + swz / 64; C = (st & 1) * 32 + (swz % 64) / 2;
}
#define G8_MFMA(a, b, c) __builtin_amdgcn_mfma_f32_16x16x32_bf16((a), (b), (c), 0, 0, 0)
template <bool STAGE0_ONLY>
DI void gemm8_impl(const bf16_t* __restrict__ P, int ldp, const bf16_t* __restrict__ Q, int ldq, int K, f32x4 (&acc)[2][2][4][2], char* smem, bool staged) {
  const int tid = otid(), lane = tid & 63, wid = __builtin_amdgcn_readfirstlane(tid >> 6), wr = wid >> 2, wc = wid & 3, fr = lane & 15, fq = lane >> 4;
  int r0, c0;
  g8_stage_rc(tid * 16, r0, c0);
  const unsigned pof = (unsigned)(r0 * ldp + c0) * 2u, qof = (unsigned)(r0 * ldq + c0) * 2u;
  const char* const Pb = (const char*)P; const char* const Qb = (const char*)Q;
  char* const sdst = smem + tid * 16;
  const int ob = fr * 64 + fq * 16, obs = ob ^ (((ob >> 9) & 1) << 5);
  const char* const ard = smem + wr * 8192 + obs;
  const char* const brd = smem + wc * 4096 + obs;
#define G8_SA(b, hh) (((b) * 2 + (hh)) * 16384)
#define G8_SB(b, hh) ((4 + (b) * 2 + (hh)) * 16384)
#define G8_STAGE_P(b, hh, kt) { const char* u_ = Pb + ((size_t)((hh) * 128) * ldp + (size_t)(kt) * 64) * 2;                \
    __builtin_amdgcn_global_load_lds((const unsigned*)(u_ + pof), (lds_uptr)(sdst + G8_SA(b, hh)), 16, 0, 0);               \
    __builtin_amdgcn_global_load_lds((const unsigned*)(u_ + (size_t)ldp * 128 + pof), (lds_uptr)(sdst + G8_SA(b, hh) + 8192), 16, 0, 0); }
#define G8_STAGE_Q(b, hh, kt) { const char* u_ = Qb + ((size_t)((hh) * 128) * ldq + (size_t)(kt) * 64) * 2;                \
    __builtin_amdgcn_global_load_lds((const unsigned*)(u_ + qof), (lds_uptr)(sdst + G8_SB(b, hh)), 16, 0, 0);               \
    __builtin_amdgcn_global_load_lds((const unsigned*)(u_ + (size_t)ldq * 128 + qof), (lds_uptr)(sdst + G8_SB(b, hh) + 8192), 16, 0, 0); }
#define G8_LDA(dst, b, hh) _Pragma("unroll") for (int m = 0; m < 4; ++m) _Pragma("unroll") for (int k = 0; k < 2; ++k) \
    dst[m][k] = *(const bf16x8*)(ard + G8_SA(b, hh) + m * 2048 + k * 1024)
#define G8_LDB(dst, b, hh) _Pragma("unroll") for (int n = 0; n < 2; ++n) _Pragma("unroll") for (int k = 0; k < 2; ++k) \
    dst[n][k] = *(const bf16x8*)(brd + G8_SB(b, hh) + n * 2048 + k * 1024)
#define G8_MMA(ai, bj, At_, Bt_) do { __builtin_amdgcn_s_setprio(1);                                                      \
    _Pragma("unroll") for (int m = 0; m < 4; ++m) _Pragma("unroll") for (int n = 0; n < 2; ++n) _Pragma("unroll") for (int k = 0; k < 2; ++k) \
      acc[ai][bj][m][n] = G8_MFMA(At_[m][k], Bt_[n][k], acc[ai][bj][m][n]);                                                \
    __builtin_amdgcn_s_setprio(0); } while (0)
#define G8_WAIT_V(n) asm volatile("s_waitcnt vmcnt(" #n ")" ::: "memory")
#define G8_WAIT_L(n) asm volatile("s_waitcnt lgkmcnt(" #n ")" ::: "memory")
#define G8_BAR __builtin_amdgcn_s_barrier()
#define G8_SCHED __builtin_amdgcn_sched_barrier(0)
  bf16x8 At[4][2], B0[2][2], B1[2][2];
  const int nt = K >> 6;
  if (STAGE0_ONLY) {
    G8_STAGE_Q(0, 0, 0); G8_STAGE_P(0, 0, 0);
    G8_STAGE_Q(0, 1, 0); G8_STAGE_P(0, 1, 0);
    return;
  }
  if (!staged) {
    __syncthreads();
    G8_STAGE_Q(0, 0, 0); G8_STAGE_P(0, 0, 0);
    G8_STAGE_Q(0, 1, 0); G8_STAGE_P(0, 1, 0);
  }
  if (wr == 1) G8_BAR;
  G8_WAIT_V(4); G8_BAR;
  G8_STAGE_Q(1, 0, 1); G8_STAGE_P(1, 0, 1); G8_STAGE_Q(1, 1, 1);
  G8_WAIT_V(6); G8_BAR;
#pragma unroll 1
  for (int t = 0; t < nt - 2; t += 2) {
    G8_LDB(B0, 0, 0); G8_SCHED; G8_LDA(At, 0, 0); G8_STAGE_P(1, 1, t + 1);
    G8_WAIT_L(8); G8_BAR; G8_WAIT_L(0); G8_MMA(0, 0, At, B0); G8_BAR; G8_SCHED;
    G8_LDB(B1, 0, 1); G8_STAGE_Q(0, 0, t + 2);
    G8_BAR; G8_WAIT_L(0); G8_MMA(0, 1, At, B1); G8_BAR;
    G8_LDA(At, 0, 1); G8_STAGE_P(0, 0, t + 2);
    G8_BAR; G8_WAIT_L(0); G8_MMA(1, 0, At, B0); G8_BAR; G8_SCHED;
    G8_STAGE_Q(0, 1, t + 2);
    G8_WAIT_V(6); G8_BAR; G8_MMA(1, 1, At, B1); G8_BAR;
    G8_LDB(B0, 1, 0); G8_SCHED; G8_LDA(At, 1, 0); G8_STAGE_P(0, 1, t + 2);
    G8_WAIT_L(8); G8_BAR; G8_WAIT_L(0); G8_MMA(0, 0, At, B0); G8_BAR; G8_SCHED;
    G8_LDB(B1, 1, 1); G8_STAGE_Q(1, 0, t + 3);
    G8_BAR; G8_WAIT_L(0); G8_MMA(0, 1, At, B1); G8_BAR;
    G8_LDA(At, 1, 1); G8_STAGE_P(1, 0, t + 3);
    G8_BAR; G8_WAIT_L(0); G8_MMA(1, 0, At, B0); G8_BAR; G8_SCHED;
    G8_STAGE_Q(1, 1, t + 3);
    G8_WAIT_V(6); G8_BAR; G8_MMA(1, 1, At, B1); G8_BAR;
  }
  { G8_LDB(B0, 0, 0); G8_LDA(At, 0, 0); G8_STAGE_P(1, 1, nt - 1);
    G8_BAR; G8_WAIT_L(0); G8_MMA(0, 0, At, B0); G8_BAR;
    G8_LDB(B1, 0, 1); G8_BAR; G8_WAIT_L(0); G8_MMA(0, 1, At, B1); G8_BAR;
    G8_LDA(At, 0, 1); G8_WAIT_V(4); G8_BAR; G8_WAIT_L(0); G8_MMA(1, 0, At, B0); G8_MMA(1, 1, At, B1); G8_BAR; }
  { G8_LDB(B0, 1, 0); G8_LDA(At, 1, 0); G8_WAIT_V(2); G8_BAR; G8_WAIT_L(0); G8_MMA(0, 0, At, B0); G8_BAR;
    G8_LDB(B1, 1, 1); G8_WAIT_V(0); G8_BAR; G8_WAIT_L(0); G8_MMA(0, 1, At, B1); G8_BAR;
    G8_LDA(At, 1, 1); G8_BAR; G8_WAIT_L(0); G8_MMA(1, 0, At, B0); G8_MMA(1, 1, At, B1); G8_BAR; }
  if (wr == 0) G8_BAR;
#undef G8_SA
#undef G8_SB
#undef G8_STAGE_P
#undef G8_STAGE_Q
#undef G8_LDA
#undef G8_LDB
#undef G8_MMA
#undef G8_WAIT_V
#undef G8_WAIT_L
#undef G8_BAR
#undef G8_SCHED
}

DI void gemm8(const bf16_t* P, int ldp, const bf16_t* Q, int ldq, int K, f32x4 (&acc)[2][2][4][2], char* smem, bool staged) {
  gemm8_impl<false>(P, ldp, Q, ldq, K, acc, smem, staged);
}
DI void gemm8_stage0(const bf16_t* P, int ldp, const bf16_t* Q, int ldq, f32x4 (&acc)[2][2][4][2], char* smem) {
  gemm8_impl<true>(P, ldp, Q, ldq, 256, acc, smem, false);
}
struct NextTile { const bf16_t* P; const bf16_t* Q; int ldp; int ldq; bool has; };
DI void zero_acc8(f32x4 (&acc)[2][2][4][2]) {
#pragma unroll
  for (int a = 0; a < 2; ++a)
#pragma unroll
    for (int b = 0; b < 2; ++b)
#pragma unroll
      for (int m = 0; m < 4; ++m)
#pragma unroll
        for (int n = 0; n < 2; ++n) acc[a][b][m][n] = f32x4{0.f, 0.f, 0.f, 0.f};
}
DI uint2 pack4v(f32x4 v, float sc) { return make_uint2(cvtpk(v[0] * sc, v[1] * sc), cvtpk(v[2] * sc, v[3] * sc)); }
DI void rope_quad4(const float2* cs, f32x4 x1, f32x4 x2, float sc, bf16_t* d1, bf16_t* d2) {
  const float4 c01 = ((const float4*)cs)[0], c23 = ((const float4*)cs)[1];
  const float c[4] = {c01.x, c01.z, c23.x, c23.z}, sn[4] = {c01.y, c01.w, c23.y, c23.w};
  float o1[4], o2[4];
#pragma unroll
  for (int j = 0; j < 4; ++j) { o1[j] = (x1[j] * c[j] - x2[j] * sn[j]) * sc; o2[j] = (x2[j] * c[j] + x1[j] * sn[j]) * sc; }
  *(uint2*)d1 = pack4(o1[0], o1[1], o1[2], o1[3]);
  *(uint2*)d2 = pack4(o2[0], o2[1], o2[2], o2[3]);
}

DI void inproj_tile(const Params& p, int layer, int tm, int tn, char* smem, bool staged, const NextTile& nx) {
  f32x4 acc[2][2][4][2]; zero_acc8(acc);
  const int m0 = tm * 256, n0 = tn * 256;
  gemm8(p.winT + ((size_t)layer * DINP + n0) * DM, DM, p.hn + (size_t)m0 * DM, DM, DM, acc, smem, staged);
  if (nx.has) gemm8_stage0(nx.P, nx.ldp, nx.Q, nx.ldq, acc, smem);
  const int tid_ = otid(); const int lane = tid_ & 63, wid = __builtin_amdgcn_readfirstlane(tid_ >> 6), wr = wid >> 2, wc = wid & 3, fr = lane & 15, fq = lane >> 4;
  const int pmask = pos_mask(m0);
#pragma unroll
  for (int bj = 0; bj < 2; ++bj)
#pragma unroll
    for (int n = 0; n < 2; ++n) {
      const int row = m0 + bj * 128 + wc * 32 + n * 16 + fr;
      const int pos = row & pmask;
      bf16_t* zrow = p.z + (size_t)row * ZLD;
#pragma unroll
      for (int ai = 0; ai < 2; ++ai) {
        const int fb = n0 + ai * 128 + wr * 64;
        if (fb >= Z_BQ && fb < Z_BV) {
          const float sc = fb < Z_BK ? SCALE_B : 1.f;
#pragma unroll
          for (int m = 0; m < 2; ++m) {
            const int f0 = m * 16 + fq * 4;
            rope_quad4(p.cs64 + pos * 32 + f0, acc[ai][bj][m][n], acc[ai][bj][m + 2][n], sc, zrow + fb + f0, zrow + fb + 32 + f0);
          }
        } else {
#pragma unroll
          for (int tj = 0; tj < 2; ++tj) {
            const int n32 = fb + tj * 32;
            if (n32 >= DIN) continue;
            const bool rope = (n32 < Z_AV) || (n32 == Z_DKR);
            const float sc = (n32 < Z_AK) ? SCALE_A : ((n32 >= Z_CQ && n32 < Z_CK) ? SCALE_C : 1.f);
            if (rope) {
              rope_quad4(p.cs32 + pos * 16 + fq * 4, acc[ai][bj][2 * tj][n], acc[ai][bj][2 * tj + 1][n], sc, zrow + n32 + fq * 4, zrow + n32 + 16 + fq * 4);
            } else {
              *(uint2*)(zrow + n32 + fq * 4) = pack4v(acc[ai][bj][2 * tj][n], sc);
              *(uint2*)(zrow + n32 + 16 + fq * 4) = pack4v(acc[ai][bj][2 * tj + 1][n], sc);
            }
          }
        }
      }
    }
}

DI void tile_rs(const bf16_t* A, int lda, int K, float* rsv) {
  const int t = otid();
  const uint4* src = (const uint4*)(A + (size_t)(t >> 1) * lda + (t & 1) * (K >> 1));
  float ss = 0.f;
  for (int c = 0; c < (K >> 4); ++c) {
    const uint4 u = src[c];
    ss += bflo(u.x) * bflo(u.x) + bfhi(u.x) * bfhi(u.x) + bflo(u.y) * bflo(u.y) + bfhi(u.y) * bfhi(u.y)
        + bflo(u.z) * bflo(u.z) + bfhi(u.z) * bfhi(u.z) + bflo(u.w) * bflo(u.w) + bfhi(u.w) * bfhi(u.w);
  }
  ss += __shfl_xor(ss, 1);
  if ((t & 1) == 0) rsv[t >> 1] = rsqrtf(ss / (float)K + EPS);
}

DI void upproj_tile(const Params& p, int layer, int tm, int sel, char* smem) {
  const int m0 = tm * 256;
  const int pmask = pos_mask(m0);
  float* rsv = (float*)(smem + SM_RS);
  const int tid_ = otid(); const int lane = tid_ & 63, wave = __builtin_amdgcn_readfirstlane(tid_ >> 6), wm = wave >> 2, wn = wave & 3, r = lane & 31, h = lane >> 5;
  f32x16 acc[4][2]; zero_acc(acc);
  __syncthreads();
  if (sel < 2) {
    const int n0 = sel * 256;
    const bf16_t* A = p.z + (size_t)m0 * ZLD + Z_DCQ;
    tile_rs(A, ZLD, 256, rsv);
    gemm_core(A, ZLD, p.wuqT + ((size_t)layer * 384 + n0) * 256, 256, 256, acc, smem);
#pragma unroll
    for (int ti = 0; ti < 4; ++ti) {
      const int rl = wm * 128 + ti * 32 + r, row = m0 + rl;
      const float rsc = rsv[rl] * SCALE_D;
      bf16_t* qrow = p.qd + (size_t)row * 384;
#pragma unroll
      for (int tj = 0; tj < 2; ++tj) {
        const int n = n0 + wn * 64 + tj * 32;
        if (n >= 384) continue;
        if ((n % 96) == 64) {
#pragma unroll
          for (int g = 0; g < 2; ++g) {
            const int f0 = 8 * g + 4 * h;
            rope_quad(p.cs32 + (row & pmask) * 16 + f0, acc[ti][tj], acc[ti][tj], g, g + 2, rsc, qrow + n + f0, qrow + n + 16 + f0);
          }
        } else {
#pragma unroll
          for (int g = 0; g < 4; ++g)
            *(uint2*)(qrow + n + 8 * g + 4 * h) = pack4(acc[ti][tj][4 * g] * rsc, acc[ti][tj][4 * g + 1] * rsc, acc[ti][tj][4 * g + 2] * rsc, acc[ti][tj][4 * g + 3] * rsc);
        }
      }
    }
  } else {
    const int n0 = (sel - 2) * 256;
    const bf16_t* A = p.z + (size_t)m0 * ZLD + Z_DCKV;
    tile_rs(A, ZLD, 128, rsv);
    gemm_core(A, ZLD, p.wukvT + ((size_t)layer * 512 + n0) * 128, 128, 128, acc, smem);
#pragma unroll
    for (int ti = 0; ti < 4; ++ti) {
      const int rl = wm * 128 + ti * 32 + r, row = m0 + rl;
      const float rsc = rsv[rl];
      bf16_t* krow = p.kvd + (size_t)row * 512 + n0 + wn * 64;
#pragma unroll
      for (int tj = 0; tj < 2; ++tj)
#pragma unroll
        for (int g = 0; g < 4; ++g)
          *(uint2*)(krow + tj * 32 + 8 * g + 4 * h) = pack4(acc[ti][tj][4 * g] * rsc, acc[ti][tj][4 * g + 1] * rsc, acc[ti][tj][4 * g + 2] * rsc, acc[ti][tj][4 * g + 3] * rsc);
    }
  }
}

DI void outproj_tile(const Params& p, int layer, int tm, int tn, char* smem, bool staged, const NextTile& nx) {
  f32x4 acc[2][2][4][2]; zero_acc8(acc);
  const int m0 = tm * 256, n0 = tn * 256;
  gemm8(p.woutT + ((size_t)layer * DM + n0) * DM, DM, p.hn + (size_t)m0 * DM, DM, DM, acc, smem, staged);
  if (nx.has) gemm8_stage0(nx.P, nx.ldp, nx.Q, nx.ldq, acc, smem);
  const int tid_ = otid(); const int lane = tid_ & 63, wid = __builtin_amdgcn_readfirstlane(tid_ >> 6), wr = wid >> 2, wc = wid & 3, fr = lane & 15, fq = lane >> 4;
#pragma unroll
  for (int bj = 0; bj < 2; ++bj)
#pragma unroll
    for (int n = 0; n < 2; ++n) {
      const int row = m0 + bj * 128 + wc * 32 + n * 16 + fr;
      const float* hrow = (layer == 0 ? xrow(p, row) : p.out + (size_t)row * DM) + n0 + wr * 64 + fq * 4;
      float* orow = p.out + (size_t)row * DM + n0 + wr * 64 + fq * 4;
#pragma unroll
      for (int ai = 0; ai < 2; ++ai)
#pragma unroll
        for (int m = 0; m < 4; ++m) {
          const float4 hv = *(const float4*)(hrow + ai * 128 + m * 16);
          const f32x4 a = acc[ai][bj][m][n];
          *(float4*)(orow + ai * 128 + m * 16) = make_float4(hv.x + a[0], hv.y + a[1], hv.z + a[2], hv.w + a[3]);
        }
    }
}

DI void pproj_tile(const Params& p, int layer, int tm, int tn, char* smem, bool staged, const NextTile& nx) {
  f32x4 acc[2][2][4][2]; zero_acc8(acc);
  const int m0 = tm * 256, n0 = tn * 256;
  gemm8(p.wppT + ((size_t)layer * DM + n0) * 256, 256, p.pb + (size_t)m0 * 256, 256, 256, acc, smem, staged);
  if (nx.has) gemm8_stage0(nx.P, nx.ldp, nx.Q, nx.ldq, acc, smem);
  const int tid_ = otid(); const int lane = tid_ & 63, wid = __builtin_amdgcn_readfirstlane(tid_ >> 6), wr = wid >> 2, wc = wid & 3, fr = lane & 15, fq = lane >> 4;
#pragma unroll
  for (int bj = 0; bj < 2; ++bj)
#pragma unroll
    for (int n = 0; n < 2; ++n) {
      const int row = m0 + bj * 128 + wc * 32 + n * 16 + fr;
      bf16_t* prow = p.z + (size_t)row * DM + n0 + wr * 64 + fq * 4;
#pragma unroll
      for (int ai = 0; ai < 2; ++ai)
#pragma unroll
        for (int m = 0; m < 4; ++m) *(uint2*)(prow + ai * 128 + m * 16) = pack4v(acc[ai][bj][m][n], 1.f);
    }
}

DI void ple_tile(const Params& p, int layer, int tm, int tn, char* smem, bool staged, const NextTile& nx) {
  f32x4 acc[2][2][4][2]; zero_acc8(acc);
  const int m0 = tm * 256, n0 = tn * 256;
  gemm8(p.wpgT + ((size_t)layer * DM + n0) * DM, DM, p.hn + (size_t)m0 * DM, DM, DM, acc, smem, staged);
  if (nx.has) gemm8_stage0(nx.P, nx.ldp, nx.Q, nx.ldq, acc, smem);
  const int tid_ = otid(); const int lane = tid_ & 63, wid = __builtin_amdgcn_readfirstlane(tid_ >> 6), wr = wid >> 2, wc = wid & 3, fr = lane & 15, fq = lane >> 4;
#pragma unroll
  for (int bj = 0; bj < 2; ++bj)
#pragma unroll
    for (int n = 0; n < 2; ++n) {
      const int row = m0 + bj * 128 + wc * 32 + n * 16 + fr;
      float* orow = p.out + (size_t)row * DM + n0 + wr * 64 + fq * 4;
      const bf16_t* prow = p.z + (size_t)row * DM + n0 + wr * 64 + fq * 4;
#pragma unroll
      for (int ai = 0; ai < 2; ++ai)
#pragma unroll
        for (int m = 0; m < 4; ++m) {
          const float4 ov = *(const float4*)(orow + ai * 128 + m * 16);
          const uint2 pu = *(const uint2*)(prow + ai * 128 + m * 16);
          const f32x4 a = acc[ai][bj][m][n];
          *(float4*)(orow + ai * 128 + m * 16) = make_float4(ov.x + sigm(a[0]) * bflo(pu.x), ov.y + sigm(a[1]) * bfhi(pu.x),
                                                            ov.z + sigm(a[2]) * bflo(pu.y), ov.w + sigm(a[3]) * bfhi(pu.y));
        }
    }
}

template <int MODE>
DI void attn_item(const Params& p, int layer, int v, char* smem) {
  constexpr int NMAPS = (MODE == 0) ? 2 : 1;
  constexpr int KS = (MODE == 0) ? 2 : ((MODE == 3) ? 6 : 4);
  constexpr int DK = (MODE == 3) ? 96 : 64;
  constexpr int KSTR = (DK + 8) * 2;
  constexpr int VSTR = 144;
  constexpr int KBUF = 64 * KSTR;
  constexpr int BUFB = KBUF + 64 * VSTR;
  constexpr bool LAZY = (MODE == 0 || MODE == 3);
  const int tid = otid(), lane = tid & 63, wave = __builtin_amdgcn_readfirstlane(tid >> 6), r = lane & 31, h = lane >> 5;
  int seq, head, qt, S, row0;
  if (v < 1024) {
    const int b = v & 255, k = v >> 8, x = b & 7, j = b >> 3, pr = x + 8 * k;
    seq = pr >> 2; head = pr & 3; qt = j; S = 8192; row0 = seq * 8192;
  } else {
    const int b = v - 1024, x = b & 7, j = b >> 3, pr = x + 8 * (j >> 4);
    seq = pr >> 2; head = pr & 3; qt = j & 15; S = 4096; row0 = NPROMPT + seq * 4096;
  }
  const int q0 = qt * 256, nkt = S >> 6;
  int kt_lo = 0, kt_hi = nkt, cR = 0, clo = 0;
  if (MODE == 1) { kt_lo = max(0, 4 * qt - 2); kt_hi = min(nkt, 4 * qt + 6); }
  if (MODE == 2) {
    const int R0 = 4 * qt;
    kt_lo = min(max(R0 - 4, 0), nkt - 8); kt_hi = min(max(R0 - 1, 0), nkt - 8) + 8;
    cR = R0 + (wave >> 1); clo = min(max(cR - 4, 0), nkt - 8);
  }
  const bf16_t *qp, *kp, *vp; int ldq, ldk, ldv;
  if (MODE == 0) { qp = p.z + Z_AQ + head * 64; kp = p.z + Z_AK + head * 64; vp = p.z + Z_AV + head * 64; ldq = ldk = ldv = ZLD; }
  else if (MODE == 1) { qp = p.z + Z_BQ + head * 64; kp = p.z + Z_BK + (head >> 1) * 64; vp = p.z + Z_BV + (head >> 1) * 64; ldq = ldk = ldv = ZLD; }
  else if (MODE == 2) { qp = p.z + Z_CQ + head * 64; kp = p.z + Z_CK + head * 64; vp = p.z + Z_CV + head * 64; ldq = ldk = ldv = ZLD; }
  else { qp = p.qd + head * 96; ldq = 384; kp = p.kvd + head * 128; vp = p.kvd + head * 128 + 64; ldk = ldv = 512; }

  float* bias = (float*)(smem + SM_BIAS);
  if (MODE == 2) {
    const float* rp = p.c_rpb + (size_t)(layer * 4 + head) * 465;
    for (int i = tid; i < 465; i += NTHR) bias[i] = rp[i] * LOG2E;
  }

  bf16x8 qf[NMAPS][KS];
  {
    const bf16_t* qrow = qp + (size_t)(row0 + q0 + wave * 32 + r) * ldq + 8 * h;
#pragma unroll
    for (int m = 0; m < NMAPS; ++m)
#pragma unroll
      for (int ks = 0; ks < KS; ++ks) qf[m][ks] = *(const bf16x8*)(qrow + (m * KS + ks) * 16);
  }
  float mrun[NMAPS], lrun[NMAPS];
  f32x16 o[NMAPS][2];
  f32x16 negm[NMAPS];
#pragma unroll
  for (int m = 0; m < NMAPS; ++m) { mrun[m] = LAZY ? 0.f : -1e30f; lrun[m] = 0.f; o[m][0] = f32x16{}; o[m][1] = f32x16{}; negm[m] = f32x16{}; }
  if (MODE == 1) { mrun[0] = p.b_sink[layer * 4 + head] * LOG2E; lrun[0] = (h == 0) ? 1.f : 0.f; }

  const int lrow = tid >> 3, lcc = tid & 7;
  const bf16_t* kg = kp + (size_t)(row0 + lrow) * ldk + lcc * 8;
  const bf16_t* vg = vp + (size_t)(row0 + lrow) * ldv + lcc * 8;
  const bf16_t* k2g = p.z + (size_t)(row0 + ((tid & 255) >> 2)) * ZLD + Z_DKR + (tid & 3) * 8;
  u32x4 kr0, vr0, k2r = u32x4{};
#define ATT_LOAD(kt_)                                                                              \
  {                                                                                                \
    const size_t ro_ = (size_t)(kt_) * 64;                                                         \
    kr0 = *(const u32x4*)(kg + ro_ * ldk);                                                         \
    vr0 = *(const u32x4*)(vg + ro_ * ldv);                                                         \
    if (MODE == 3) { if (tid < 256) k2r = *(const u32x4*)(k2g + ro_ * ZLD); }                      \
  }
#define ATT_STORE(buf_)                                                                            \
  {                                                                                                \
    char* kb_ = smem + (buf_) * BUFB;                                                              \
    *(u32x4*)(kb_ + lrow * KSTR + lcc * 16) = kr0;                                                 \
    *(u32x4*)(kb_ + KBUF + lrow * VSTR + lcc * 16) = vr0;                                          \
    if (MODE == 3) { if (tid < 256) *(u32x4*)(kb_ + (tid >> 2) * KSTR + 128 + (tid & 3) * 16) = k2r; } \
  }
  ATT_LOAD(kt_lo);
  ATT_STORE(0);
  __syncthreads();

  const int i16 = lane & 15;
  const int voff = (4 * h + (i16 >> 2)) * VSTR + (((lane >> 4) & 1) * 16 + (i16 & 3) * 4) * 2;
  const int qi = q0 + wave * 32 + r;
  const int cc = (wave & 1) * 32 + r;
  const int ccs = min(max(cc - 8, 0), 48);

  if (wave >= 4) __builtin_amdgcn_s_setprio(1);
#pragma unroll 1
  for (int kt = kt_lo; kt < kt_hi; ++kt) {
    const int cur = (kt - kt_lo) & 1;
    if (kt + 1 < kt_hi) ATT_LOAD(kt + 1);
    const bool active = (MODE == 2) ? (kt >= clo && kt < clo + 8)
                      : ((MODE == 1) ? (kt * 64 + 63 >= q0 + wave * 32 - 128 && kt * 64 <= q0 + wave * 32 + 31 + 128) : true);
    if (active) {
      const char* kb = smem + cur * BUFB;
      const char* vb = kb + KBUF;
      bf16x8 pf[NMAPS][2][2];
#pragma unroll
      for (int m = 0; m < NMAPS; ++m) {
        f32x16 st[2];
#pragma unroll
        for (int sub = 0; sub < 2; ++sub) {
          f32x16 s;
          if (LAZY) s = negm[m]; else s = f32x16{};
#pragma unroll
          for (int ks = 0; ks < KS; ++ks) {
            const bf16x8 kf = *(const bf16x8*)(kb + (sub * 32 + r) * KSTR + ((m * KS + ks) * 16 + 8 * h) * 2);
            s = MFMA(kf, qf[m][ks], s);
          }
          st[sub] = s;
        }
        if (MODE == 1) {
          int tb = kt * 64 + 4 * h - qi + 128;
          asm volatile("" : "+v"(tb));
#pragma unroll
          for (int sub = 0; sub < 2; ++sub)
#pragma unroll
            for (int i = 0; i < 16; ++i) {
              const int c0 = sub * 32 + (i & 3) + 8 * (i >> 2);
              if ((unsigned)(tb + c0) > 256u) st[sub][i] = -INFINITY;
            }
        }
        if (MODE == 2) {
          int tcc = 4 * h - cc + 15 + (kt - cR + 7) * 31, tcs = 4 * h - ccs;
          asm volatile("" : "+v"(tcc), "+v"(tcs));
#pragma unroll
          for (int sub = 0; sub < 2; ++sub)
#pragma unroll
            for (int i = 0; i < 16; ++i) {
              const int c0 = sub * 32 + (i & 3) + 8 * (i >> 2);
              const bool valid = (unsigned)(c0 + tcs) < 16u;
              const int idx = valid ? tcc + c0 : 0;
              const float bv = bias[idx];
              st[sub][i] = valid ? st[sub][i] + bv : -INFINITY;
            }
        }
        auto tile_max = [&]() {
          float mx_ = fmaxf(fmaxf(st[0][0], st[0][1]), st[1][0]);
          float mb_ = fmaxf(fmaxf(st[0][2], st[0][3]), st[1][1]);
          mx_ = fmaxf(fmaxf(mx_, st[1][2]), st[1][3]);
#pragma unroll
          for (int i = 4; i < 16; i += 4) {
            mx_ = fmaxf(fmaxf(mx_, st[0][i]), st[0][i + 1]); mb_ = fmaxf(fmaxf(mb_, st[0][i + 2]), st[0][i + 3]);
            mx_ = fmaxf(fmaxf(mx_, st[1][i]), st[1][i + 1]); mb_ = fmaxf(fmaxf(mb_, st[1][i + 2]), st[1][i + 3]);
          }
          return swap_max(fmaxf(mx_, mb_));
        };
        float mx = 0.f;
        if (!LAZY) mx = tile_max();
        if (LAZY) {
          int ia = max(max(__float_as_int(st[0][0]), __float_as_int(st[0][1])), __float_as_int(st[1][0]));
          int ib = max(max(__float_as_int(st[0][2]), __float_as_int(st[0][3])), __float_as_int(st[1][1]));
          ia = max(max(ia, __float_as_int(st[1][2])), __float_as_int(st[1][3]));
#pragma unroll
          for (int i = 4; i < 16; i += 4) {
            ia = max(max(ia, __float_as_int(st[0][i])), __float_as_int(st[0][i + 1])); ib = max(max(ib, __float_as_int(st[0][i + 2])), __float_as_int(st[0][i + 3]));
            ia = max(max(ia, __float_as_int(st[1][i])), __float_as_int(st[1][i + 1])); ib = max(max(ib, __float_as_int(st[1][i + 2])), __float_as_int(st[1][i + 3]));
          }
          ia = max(ia, ib);
          const bool first = (kt == kt_lo);
          if (first || __builtin_amdgcn_ballot_w64(ia > 0x41000000) != 0) {
            mx = tile_max();
            const float delta = first ? mx : fmaxf(mx, 0.f);
            const float alpha = first ? 1.f : ex2(-delta);
            mrun[m] += delta;
            lrun[m] *= alpha;
#pragma unroll
            for (int i = 0; i < 16; ++i) { o[m][0][i] *= alpha; o[m][1][i] *= alpha; st[0][i] -= delta; st[1][i] -= delta; }
            const float nm = -mrun[m];
#pragma unroll
            for (int i = 0; i < 16; ++i) negm[m][i] = nm;
          }
          f32x2 l2[4] = {{0.f, 0.f}, {0.f, 0.f}, {0.f, 0.f}, {0.f, 0.f}};
#pragma unroll
          for (int sub = 0; sub < 2; ++sub)
#pragma unroll
            for (int i = 0; i < 16; i += 2) {
              const float p0 = ex2(st[sub][i]), p1 = ex2(st[sub][i + 1]);
              st[sub][i] = p0; st[sub][i + 1] = p1;
              l2[(i >> 1) & 3] += f32x2{p0, p1};
            }
          const f32x2 lt = (l2[0] + l2[1]) + (l2[2] + l2[3]);
          lrun[m] += lt[0] + lt[1];
        } else {
          const float mnew = fmaxf(mrun[m], mx);
          const float alpha = ex2(mrun[m] - mnew);
          mrun[m] = mnew;
          float ls = 0.f;
#pragma unroll
          for (int sub = 0; sub < 2; ++sub)
#pragma unroll
            for (int i = 0; i < 16; ++i) { const float pv = ex2(st[sub][i] - mnew); ls += pv; st[sub][i] = pv; }
          lrun[m] = lrun[m] * alpha + ls;
#pragma unroll
          for (int i = 0; i < 16; ++i) { o[m][0][i] *= alpha; o[m][1][i] *= alpha; }
        }
#pragma unroll
        for (int sub = 0; sub < 2; ++sub)
#pragma unroll
          for (int kk = 0; kk < 2; ++kk) {
            const uint4 u = make_uint4(cvtpk(st[sub][8 * kk + 0], st[sub][8 * kk + 1]), cvtpk(st[sub][8 * kk + 2], st[sub][8 * kk + 3]),
                                       cvtpk(st[sub][8 * kk + 4], st[sub][8 * kk + 5]), cvtpk(st[sub][8 * kk + 6], st[sub][8 * kk + 7]));
            pf[m][sub][kk] = __builtin_bit_cast(bf16x8, u);
          }
      }
#pragma unroll
      for (int sub = 0; sub < 2; ++sub)
#pragma unroll
        for (int kk = 0; kk < 2; ++kk)
#pragma unroll
          for (int dvt = 0; dvt < 2; ++dvt) {
            const char* va = vb + voff + (sub * 32 + kk * 16) * VSTR + dvt * 64;
            const s16x4 lo = vtr(va), hi = vtr(va + 8 * VSTR);
            const bf16x8 vf = __builtin_shufflevector(lo, hi, 0, 1, 2, 3, 4, 5, 6, 7);
#pragma unroll
            for (int m = 0; m < NMAPS; ++m) o[m][dvt] = MFMA(vf, pf[m][sub][kk], o[m][dvt]);
          }
    }
    if (kt + 1 < kt_hi) ATT_STORE(cur ^ 1);
    __syncthreads();
  }
  if (wave >= 4) __builtin_amdgcn_s_setprio(0);
#undef ATT_LOAD
#undef ATT_STORE

  float inv[NMAPS];
#pragma unroll
  for (int m = 0; m < NMAPS; ++m) inv[m] = 1.f / swap_sum(lrun[m]);
  f32x16 res[2];
  if (MODE == 0) {
    const float lam = p.lam[layer];
    const float lam_init = 0.8f - 0.6f * __expf(-0.3f * (float)layer);
    float ss = 0.f;
#pragma unroll
    for (int dvt = 0; dvt < 2; ++dvt)
#pragma unroll
      for (int i = 0; i < 16; ++i) { const float t = o[0][dvt][i] * inv[0] - lam * (o[NMAPS - 1][dvt][i] * inv[NMAPS - 1]); res[dvt][i] = t; ss += t * t; }
    ss = swap_sum(ss);
    const float rs = rsqrtf(ss * (1.f / 64.f) + EPS) * (1.f - lam_init);
    const float* sg = p.a_subln_g + layer * 64;
#pragma unroll
    for (int dvt = 0; dvt < 2; ++dvt)
#pragma unroll
      for (int i = 0; i < 16; ++i) res[dvt][i] *= rs * sg[dvt * 32 + crow(i, h)];
  } else {
#pragma unroll
    for (int dvt = 0; dvt < 2; ++dvt)
#pragma unroll
      for (int i = 0; i < 16; ++i) res[dvt][i] = o[0][dvt][i] * inv[0];
  }
  {
    const size_t row = (size_t)(row0 + qi);
    const bf16_t* gp = p.z + row * ZLD + Z_GATE + MODE * 256 + head * 64;
    bf16_t* mp = p.hn + row * DM + MODE * 256 + head * 64;
#pragma unroll
    for (int dvt = 0; dvt < 2; ++dvt)
#pragma unroll
      for (int ig = 0; ig < 4; ++ig) {
        const int dv0 = dvt * 32 + ig * 8 + 4 * h;
        const uint2 gu = *(const uint2*)(gp + dv0);
        const float g0 = bflo(gu.x), g1 = bfhi(gu.x), g2 = bflo(gu.y), g3 = bfhi(gu.y);
        const float a0 = res[dvt][ig * 4 + 0] * g0 * sigm(g0), a1 = res[dvt][ig * 4 + 1] * g1 * sigm(g1);
        const float a2 = res[dvt][ig * 4 + 2] * g2 * sigm(g2), a3 = res[dvt][ig * 4 + 3] * g3 * sigm(g3);
        *(uint2*)(mp + dv0) = make_uint2(cvtpk(a0, a1), cvtpk(a2, a3));
      }
  }
}

#define XB_TMO      128
#define XB_XCNT(j)  (256  + 64 * (j))
#define XB_XSUB(j)  (1280 + 64 * (j))
#define XB_XGEN(j)  (2304 + 64 * (j))
#define XB_TOP      3328
#define XB_TOPGEN   3392
#define XB_SPIN_CAP (1u << 18)
#define LAS __attribute__((address_space(3)))
DI unsigned xb_ld(unsigned* p) { return __hip_atomic_load(p, __ATOMIC_RELAXED, __HIP_MEMORY_SCOPE_AGENT); }
DI unsigned xb_add(unsigned* p, unsigned v) { return __hip_atomic_fetch_add(p, v, __ATOMIC_RELAXED, __HIP_MEMORY_SCOPE_AGENT); }
DI unsigned xb_xcc_id() { return (unsigned)__builtin_amdgcn_s_getreg((3 << 11) | 20) & 0xFu; }
#define XB_SPIN(cond, bar) do { unsigned _sp = 0; while (cond) { __builtin_amdgcn_s_sleep(1); \
    if ((++_sp & 255u) == 0u) { if (xb_ld(&(bar)[XB_TMO])) break; if (_sp > XB_SPIN_CAP) { atomicAdd(&(bar)[XB_TMO], 1u); break; } } } } while (0)
struct XcdBarrier { unsigned* bar; unsigned x; volatile LAS unsigned* st; };
DI XcdBarrier xcd_barrier_post(unsigned* bar, volatile LAS unsigned* st) {
  XcdBarrier b; b.bar = bar; b.x = xb_xcc_id(); b.st = st;
  if (threadIdx.x == 0) (void)xb_add(&bar[XB_XCNT(b.x)], 1u);
  return b;
}
DI void xcd_barrier_complete(unsigned* bar, unsigned x, unsigned& nloc, unsigned& nx) {
  const unsigned G = gridDim.x * gridDim.y * gridDim.z;
  unsigned sum, cnt, mine, sp = 0u;
  for (;;) {
    sum = 0u; cnt = 0u; mine = 0u;
#pragma unroll
    for (unsigned j = 0; j < 16; ++j) { const unsigned c = xb_ld(&bar[XB_XCNT(j)]); sum += c; cnt += (c > 0u) ? 1u : 0u; mine = (j == x) ? c : mine; }
    if (sum == G) break;
    __builtin_amdgcn_s_sleep(1);
    if ((++sp & 255u) == 0u) { if (xb_ld(&bar[XB_TMO])) break; if (sp > XB_SPIN_CAP) { atomicAdd(&bar[XB_TMO], 1u); break; } }
  }
  nloc = mine > 0u ? mine : 1u; nx = cnt > 0u ? cnt : 1u;
}
DI void xcd_barrier(const XcdBarrier& b) {
  asm volatile("s_waitcnt vmcnt(0)" ::: "memory");
  __syncthreads();
  if (threadIdx.x == 0) {
    unsigned* bar = b.bar;
    __builtin_amdgcn_s_waitcnt(0);
    unsigned nloc = b.st[0], nx = b.st[1];
    if (nloc == 0u) { xcd_barrier_complete(bar, b.x, nloc, nx); b.st[0] = nloc; b.st[1] = nx; }
    const unsigned old = xb_add(&bar[XB_XSUB(b.x)], 1u);
    const unsigned gen = old / nloc;
    if (old + 1u == (gen + 1u) * nloc) {
      __builtin_amdgcn_fence(__ATOMIC_RELEASE, "agent");
      asm volatile("s_waitcnt vmcnt(0)" ::: "memory");
      const unsigned og = xb_add(&bar[XB_TOP], 1u);
      const unsigned tg = og / nx;
      if (og + 1u == (tg + 1u) * nx) xb_add(&bar[XB_TOPGEN], 1u);
      else XB_SPIN(xb_ld(&bar[XB_TOPGEN]) == tg, bar);
      __builtin_amdgcn_fence(__ATOMIC_ACQUIRE, "agent");
      xb_add(&bar[XB_XGEN(b.x)], 1u);
      asm volatile("s_waitcnt vmcnt(0)" ::: "memory");
    } else {
      XB_SPIN(xb_ld(&bar[XB_XGEN(b.x)]) == gen, bar);
      __builtin_amdgcn_fence(__ATOMIC_ACQUIRE, "agent");
      asm volatile("s_waitcnt vmcnt(0)" ::: "memory");
    }
  }
  __syncthreads();
}

__global__ void __launch_bounds__(512, 2) mega_fwd(Params p) {
  __shared__ __attribute__((aligned(16))) char smem[SMEM_BYTES];
  cg::grid_group grid = cg::this_grid();
  const int nb = gridDim.x;

  if (threadIdx.x < 4) ((unsigned*)(smem + SM_XB))[threadIdx.x] = 0u;
  phase_prep(p, smem);
  grid.sync();
  const XcdBarrier xb = xcd_barrier_post(p.bar, (volatile LAS unsigned*)(lds_cptr)(smem + SM_XB));
#pragma unroll 1
  for (int layer = 0; layer < 2; ++layer) {
    phase_norm(p, layer, 0);
    xcd_barrier(xb);
    {
      bool staged = false;
      for (int v = blockIdx.x; v < 18 * 256; v += nb) {
        const int b = v & 255, k = v >> 8, x = b & 7, j = b >> 3, st = k * 8 + x;
        if (st >= 140) continue;
        const int tm = (st / 7) * 16 + (j >> 1), tn = (st % 7) * 2 + (j & 1);
        NextTile nx;
        {
          const int v2 = v + nb, b2 = v2 & 255, k2 = v2 >> 8, st2 = k2 * 8 + (b2 & 7), j2 = b2 >> 3;
          nx.has = (v2 < 18 * 256) && (st2 < 140);
          const int tm2 = (st2 / 7) * 16 + (j2 >> 1), tn2 = (st2 % 7) * 2 + (j2 & 1);
          nx.P = p.winT + ((size_t)layer * DINP + tn2 * 256) * DM; nx.Q = p.hn + (size_t)tm2 * 256 * DM; nx.ldp = DM; nx.ldq = DM;
        }
        inproj_tile(p, layer, tm, tn, smem, staged, nx);
        staged = nx.has;
      }
    }
    xcd_barrier(xb);
    for (int v = blockIdx.x; v < 1280 + 1280 + 1280 + 1280; v += nb) {
      if (v < 1280) attn_item<0>(p, layer, v, smem);
      else if (v < 2560) { const int u = v - 1280; upproj_tile(p, layer, u >> 2, u & 3, smem); }
      else if (v < 3840) attn_item<1>(p, layer, v - 2560, smem);
      else attn_item<2>(p, layer, v - 3840, smem);
    }
    xcd_barrier(xb);
    for (int v = blockIdx.x; v < 1280; v += nb) attn_item<3>(p, layer, v, smem);
    xcd_barrier(xb);
    {
      bool staged = false;
      for (int v = blockIdx.x; v < 2560; v += nb) {
        const int vv = v < 1280 ? v : v - 1280;
        const int b = vv & 255, k = vv >> 8, x = b & 7, j = b >> 3, st = k * 8 + x;
        NextTile nx;
        {
          const int v2 = v + nb, vv2 = v2 < 1280 ? v2 : v2 - 1280;
          const int b2 = vv2 & 255, st2 = (vv2 >> 8) * 8 + (b2 & 7), j2 = b2 >> 3, tm2 = st2 * 8 + (j2 >> 2), tn2 = j2 & 3;
          nx.has = v2 < 2560;
          if (v2 < 1280) { nx.P = p.woutT + ((size_t)layer * DM + tn2 * 256) * DM; nx.Q = p.hn + (size_t)tm2 * 256 * DM; nx.ldp = DM; nx.ldq = DM; }
          else { nx.P = p.wppT + ((size_t)layer * DM + tn2 * 256) * 256; nx.Q = p.pb + (size_t)tm2 * 256 * 256; nx.ldp = 256; nx.ldq = 256; }
        }
        if (v < 1280) outproj_tile(p, layer, st * 8 + (j >> 2), j & 3, smem, staged, nx);
        else pproj_tile(p, layer, st * 8 + (j >> 2), j & 3, smem, staged, nx);
        staged = nx.has;
      }
    }
    xcd_barrier(xb);
    phase_norm(p, layer, 1);
    xcd_barrier(xb);
    {
      bool staged = false;
      for (int v = blockIdx.x; v < 1280; v += nb) {
        const int b = v & 255, k = v >> 8, x = b & 7, j = b >> 3, st = k * 8 + x;
        NextTile nx;
        {
          const int v2 = v + nb, b2 = v2 & 255, st2 = (v2 >> 8) * 8 + (b2 & 7), j2 = b2 >> 3, tm2 = st2 * 8 + (j2 >> 2), tn2 = j2 & 3;
          nx.has = v2 < 1280;
          nx.P = p.wpgT + ((size_t)layer * DM + tn2 * 256) * DM; nx.Q = p.hn + (size_t)tm2 * 256 * DM; nx.ldp = DM; nx.ldq = DM;
        }
        ple_tile(p, layer, st * 8 + (j >> 2), j & 3, smem, staged, nx);
        staged = nx.has;
      }
    }
    xcd_barrier(xb);
  }
  phase_norm(p, 0, 2);
}

extern "C" void kernel_launch(void* const* d_in, const int* in_sizes, int n_in, void* d_out, int out_size, void* d_ws, size_t ws_size,
                              hipStream_t stream) {
  Params p{};
  p.x_prompt = (const float*)d_in[0]; p.x_sample = (const float*)d_in[1]; p.p_prompt = (const float*)d_in[2]; p.p_sample = (const float*)d_in[3];
  p.norm_g = (const float*)d_in[4]; p.w_in = (const float*)d_in[5]; p.a_lambda = (const float*)d_in[6]; p.a_subln_g = (const float*)d_in[7];
  p.b_sink = (const float*)d_in[8]; p.c_rpb = (const float*)d_in[9]; p.d_q_norm_g = (const float*)d_in[10]; p.d_kv_norm_g = (const float*)d_in[11];
  p.d_w_uq = (const float*)d_in[12]; p.d_w_ukv = (const float*)d_in[13]; p.w_out = (const float*)d_in[14]; p.ple_norm_g = (const float*)d_in[15];
  p.w_ple_gate = (const float*)d_in[16]; p.w_ple_proj = (const float*)d_in[17]; p.final_norm_g = (const float*)d_in[18];
  p.out = (float*)d_out;
  char* w = (char*)d_ws; size_t off = 0;
  auto carve = [&](size_t bytes) { char* r = w + off; off += (bytes + 255) & ~(size_t)255; return r; };
  p.hn = (bf16_t*)carve((size_t)NTOK * DM * 2);
  p.z = (bf16_t*)carve((size_t)NTOK * ZLD * 2);
  p.qd = (bf16_t*)carve((size_t)NTOK * 384 * 2);
  p.pb = (bf16_t*)carve((size_t)NTOK * 256 * 2);
  p.kvd = (bf16_t*)carve((size_t)NTOK * 512 * 2);
  p.winT = (bf16_t*)carve((size_t)2 * DINP * DM * 2);
  p.wuqT = (bf16_t*)carve((size_t)2 * 384 * 256 * 2);
  p.wukvT = (bf16_t*)carve((size_t)2 * 512 * 128 * 2);
  p.woutT = (bf16_t*)carve((size_t)2 * DM * DM * 2);
  p.wpgT = (bf16_t*)carve((size_t)2 * DM * DM * 2);
  p.wppT = (bf16_t*)carve((size_t)2 * DM * 256 * 2);
  p.cs32 = (float2*)carve((size_t)8192 * 16 * 8);
  p.cs64 = (float2*)carve((size_t)8192 * 32 * 8);
  p.lam = (float*)carve(256);
  p.bar = (unsigned*)carve((size_t)XCD_BAR_WORDS * 4);
  if (off > ws_size) { fprintf(stderr, "workspace too small: need %zu have %zu\n", off, ws_size); return; }
  static int grid_blocks = 0;
  if (!grid_blocks) {
    int dev = 0, cus = 0, per_cu = 0;
    hipGetDevice(&dev);
    hipDeviceGetAttribute(&cus, hipDeviceAttributeMultiprocessorCount, dev);
    hipOccupancyMaxActiveBlocksPerMultiprocessor(&per_cu, mega_fwd, NTHR, 0);
    if (per_cu > 1) per_cu = 1;
    if (per_cu < 1) per_cu = 1;
    grid_blocks = cus * per_cu;
  }
  void* args[] = {&p};
  hipError_t e = hipLaunchCooperativeKernel((void*)mega_fwd, dim3(grid_blocks), dim3(NTHR), args, 0, stream);
  if (e != hipSuccess) fprintf(stderr, "cooperative launch failed: %s (grid %d)\n", hipGetErrorString(e), grid_blocks);
}
```

```cpp
#include <hip/hip_runtime.h>
#include <hip/hip_cooperative_groups.h>
#include <stdint.h>
#include <stdio.h>
namespace cg = cooperative_groups;

typedef __attribute__((ext_vector_type(8))) short bf16x8;
typedef __attribute__((ext_vector_type(4))) short s16x4;
typedef __attribute__((ext_vector_type(16))) float f32x16;
typedef short v4i16_t __attribute__((ext_vector_type(4)));
typedef __bf16 bf16v2 __attribute__((ext_vector_type(2)));
typedef unsigned short bf16_t;
typedef unsigned u32x4 __attribute__((ext_vector_type(4)));
typedef float f32x2 __attribute__((ext_vector_type(2)));
typedef float f32x4 __attribute__((ext_vector_type(4)));
typedef __attribute__((address_space(3))) unsigned* lds_uptr;
typedef __attribute__((address_space(3))) const char* lds_cptr;

#define DI __device__ __forceinline__
#define MFMA(a, b, c) __builtin_amdgcn_mfma_f32_32x32x16_bf16((a), (b), (c), 0, 0, 0)

constexpr int NTOK = 81920, NPROMPT = 65536, DM = 1024, DIN = 3488, DINP = 3584, ZLD = 3488;
constexpr int Z_AQ = 0, Z_AK = 256, Z_AV = 512, Z_BQ = 768, Z_BK = 1024, Z_BV = 1152, Z_CQ = 1280, Z_CK = 1536, Z_CV = 1792,
              Z_DCQ = 2048, Z_DCKV = 2304, Z_DKR = 2432, Z_GATE = 2464;
constexpr float LOG2E = 1.4426950408889634f;
constexpr float SCALE_A = 0.17677669529663687f * LOG2E;
constexpr float SCALE_B = 0.125f * LOG2E;
constexpr float SCALE_C = 0.125f * LOG2E;
constexpr float SCALE_D = 0.10206207261596575f * LOG2E;
constexpr float EPS = 1e-6f;

constexpr int G_ROWB = 144;
constexpr int G_TILEB = 256 * G_ROWB;
constexpr int SM_RS = 4 * G_TILEB;
constexpr int SM_BIAS = 46080;
constexpr int SM_XB = SM_RS + 1024;
constexpr int SMEM_BYTES = SM_XB + 16;
constexpr int NTHR = 512;
#define XCD_BAR_WORDS 3456

struct Params {
  const float* x_prompt; const float* x_sample; const float* p_prompt; const float* p_sample;
  const float* norm_g; const float* w_in; const float* a_lambda; const float* a_subln_g; const float* b_sink; const float* c_rpb;
  const float* d_q_norm_g; const float* d_kv_norm_g; const float* d_w_uq; const float* d_w_ukv; const float* w_out; const float* ple_norm_g;
  const float* w_ple_gate; const float* w_ple_proj; const float* final_norm_g;
  float* out;
  bf16_t* hn;
  bf16_t* z;
  bf16_t* qd;
  bf16_t* pb;
  bf16_t* kvd;
  bf16_t* winT; bf16_t* wuqT; bf16_t* wukvT; bf16_t* woutT; bf16_t* wpgT; bf16_t* wppT;
  float2* cs32; float2* cs64; float* lam;
  unsigned* bar;
};

DI unsigned cvtpk(float lo, float hi) { bf16v2 v = {(__bf16)lo, (__bf16)hi}; return __builtin_bit_cast(unsigned, v); }
DI bf16_t f2bf(float x) { __bf16 b = (__bf16)x; return __builtin_bit_cast(bf16_t, b); }
DI float bf2f(unsigned v16) { return __uint_as_float(v16 << 16); }
DI float bflo(unsigned u) { return __uint_as_float(u << 16); }
DI float bfhi(unsigned u) { return __uint_as_float(u & 0xffff0000u); }
DI int otid() { int t = threadIdx.x; asm volatile("" : "+v"(t)); return t; }
DI int crow(int i, int h) { return (i & 3) + 8 * (i >> 2) + 4 * h; }
DI float ex2(float x) { return __builtin_amdgcn_exp2f(x); }
DI float sigm(float x) { return 1.f / (1.f + __expf(-x)); }
DI const float* xrow(const Params& p, int row) { return row < NPROMPT ? p.x_prompt + (size_t)row * DM : p.x_sample + (size_t)(row - NPROMPT) * DM; }
DI int pos_of(int row) { return row < NPROMPT ? (row & 8191) : (row & 4095); }
DI int pos_mask(int m0) { return m0 < NPROMPT ? 8191 : 4095; }
DI float swap_max(float m) { auto rr = __builtin_amdgcn_permlane32_swap(__float_as_uint(m), __float_as_uint(m), false, false); return fmaxf(__uint_as_float(rr[0]), __uint_as_float(rr[1])); }
DI float swap_sum(float m) { auto rr = __builtin_amdgcn_permlane32_swap(__float_as_uint(m), __float_as_uint(m), false, false); return __uint_as_float(rr[0]) + __uint_as_float(rr[1]); }
DI s16x4 vtr(const char* p) { return __builtin_bit_cast(s16x4, __builtin_amdgcn_ds_read_tr16_b64_v4i16((__attribute__((address_space(3))) v4i16_t*)(lds_cptr)p)); }

DI void transpose_tile(const float* __restrict__ W, int K, int N, bf16_t* __restrict__ WT, const float* __restrict__ gfold, int tile, char* smem) {
  const int kt = K >> 6;
  const int n0 = (tile / kt) * 64, k0 = (tile % kt) * 64;
  float* t = (float*)smem;
  const int tid = otid();
  __syncthreads();
  if (tid < 256) {
    const int nn = tid & 63, kb = tid >> 6;
#pragma unroll
    for (int i = 0; i < 16; ++i) {
      const int kk = kb + 4 * i;
      float v = 0.f;
      if (n0 + nn < N) { v = W[(size_t)(k0 + kk) * N + n0 + nn]; if (gfold) v *= gfold[k0 + kk]; }
      t[kk * 65 + nn] = v;
    }
  }
  __syncthreads();
  if (tid < 256) {
    const int nl = tid >> 2, kq = (tid & 3) * 16;
    unsigned u[8];
#pragma unroll
    for (int j = 0; j < 8; ++j) u[j] = cvtpk(t[(kq + 2 * j) * 65 + nl], t[(kq + 2 * j + 1) * 65 + nl]);
    uint4* dst = (uint4*)(WT + (size_t)(n0 + nl) * K + k0 + kq);
    dst[0] = make_uint4(u[0], u[1], u[2], u[3]);
    dst[1] = make_uint4(u[4], u[5], u[6], u[7]);
  }
}

DI void phase_prep(const Params& p, char* smem) {
  for (int v = blockIdx.x; v < 2 * 1512; v += gridDim.x) {
    const int layer = v / 1512; int t = v % 1512;
    if (t < 896) { transpose_tile(p.w_in + (size_t)layer * DM * DIN, DM, DIN, p.winT + (size_t)layer * DINP * DM, nullptr, t, smem); continue; }
    t -= 896;
    if (t < 24) { transpose_tile(p.d_w_uq + (size_t)layer * 256 * 384, 256, 384, p.wuqT + (size_t)layer * 384 * 256, p.d_q_norm_g + layer * 256, t, smem); continue; }
    t -= 24;
    if (t < 16) { transpose_tile(p.d_w_ukv + (size_t)layer * 128 * 512, 128, 512, p.wukvT + (size_t)layer * 512 * 128, p.d_kv_norm_g + layer * 128, t, smem); continue; }
    t -= 16;
    if (t < 256) { transpose_tile(p.w_out + (size_t)layer * DM * DM, DM, DM, p.woutT + (size_t)layer * DM * DM, nullptr, t, smem); continue; }
    t -= 256;
    if (t < 256) { transpose_tile(p.w_ple_gate + (size_t)layer * DM * DM, DM, DM, p.wpgT + (size_t)layer * DM * DM, nullptr, t, smem); continue; }
    t -= 256;
    transpose_tile(p.w_ple_proj + (size_t)layer * 256 * DM, 256, DM, p.wppT + (size_t)layer * DM * 256, nullptr, t, smem);
  }
  const int gt = blockIdx.x * NTHR + otid(), nt = gridDim.x * NTHR;
  for (int i = gt; i < XCD_BAR_WORDS; i += nt) p.bar[i] = 0u;
  for (int i = gt; i < 8192 * 48; i += nt) {
    int pos, f, dim; float2* dst;
    if (i < 8192 * 16) { pos = i >> 4; f = i & 15; dim = 32; dst = p.cs32 + i; }
    else { const int j = i - 8192 * 16; pos = j >> 5; f = j & 31; dim = 64; dst = p.cs64 + j; }
    const float inv = exp2f(-(float)(2 * f) / (float)dim * 13.287712379549449f);
    const double ang = (double)pos * (double)inv;
    double rev = ang * 0.15915494309189535;
    rev = rev - __builtin_rint(rev);
    const float fr = (float)rev;
    *dst = make_float2(__builtin_amdgcn_cosf(fr), __builtin_amdgcn_sinf(fr));
  }
  if (blockIdx.x == 0 && threadIdx.x < 2) {
    const int layer = threadIdx.x;
    const float* lv = p.a_lambda + layer * 128;
    float s1 = 0.f, s2 = 0.f;
    for (int i = 0; i < 32; ++i) { s1 += lv[i] * lv[32 + i]; s2 += lv[64 + i] * lv[96 + i]; }
    const float lam_init = 0.8f - 0.6f * expf(-0.3f * (float)layer);
    p.lam[layer] = expf(s1) - expf(s2) + lam_init;
  }
}

DI void phase_norm(const Params& p, int layer, int kind) {
  const int tid_ = otid(); const int lane = tid_ & 63, wave = __builtin_amdgcn_readfirstlane(tid_ >> 6);
  const float* g = kind == 0 ? p.norm_g + layer * DM : (kind == 1 ? p.ple_norm_g + layer * DM : p.final_norm_g);
  float4 g4[4];
#pragma unroll
  for (int j = 0; j < 4; ++j) g4[j] = ((const float4*)g)[lane + 64 * j];
  for (int row = blockIdx.x * 8 + wave; row < NTOK; row += gridDim.x * 8) {
    const float* src = (kind == 0 && layer == 0) ? xrow(p, row) : p.out + (size_t)row * DM;
    float4 v[4];
#pragma unroll
    for (int j = 0; j < 4; ++j) v[j] = ((const float4*)src)[lane + 64 * j];
    float ss = 0.f;
#pragma unroll
    for (int j = 0; j < 4; ++j) ss += v[j].x * v[j].x + v[j].y * v[j].y + v[j].z * v[j].z + v[j].w * v[j].w;
#pragma unroll
    for (int o = 32; o >= 1; o >>= 1) ss += __shfl_xor(ss, o);
    const float rs = rsqrtf(ss * (1.f / 1024.f) + EPS);
    if (kind == 2) {
      float4* dst = (float4*)(p.out + (size_t)row * DM);
#pragma unroll
      for (int j = 0; j < 4; ++j) dst[lane + 64 * j] = make_float4(v[j].x * rs * g4[j].x, v[j].y * rs * g4[j].y, v[j].z * rs * g4[j].z, v[j].w * rs * g4[j].w);
    } else {
      uint2* dst = (uint2*)(p.hn + (size_t)row * DM);
#pragma unroll
      for (int j = 0; j < 4; ++j) dst[lane + 64 * j] = make_uint2(cvtpk(v[j].x * rs * g4[j].x, v[j].y * rs * g4[j].y), cvtpk(v[j].z * rs * g4[j].z, v[j].w * rs * g4[j].w));
      if (kind == 0) {
        const float* ps = row < NPROMPT ? p.p_prompt + ((size_t)layer * NPROMPT + row) * 256 : p.p_sample + ((size_t)layer * (NTOK - NPROMPT) + (row - NPROMPT)) * 256;
        const float4 pv = ((const float4*)ps)[lane];
        ((uint2*)(p.pb + (size_t)row * 256))[lane] = make_uint2(cvtpk(pv.x, pv.y), cvtpk(pv.z, pv.w));
      }
    }
  }
}

DI void gemm_core(const bf16_t* __restrict__ A, int lda, const bf16_t* __restrict__ W, int ldw, int K, f32x16 (&acc)[4][2], char* smem) {
  const int tid = otid(), lane = tid & 63, wave = __builtin_amdgcn_readfirstlane(tid >> 6), wm = wave >> 2, wn = wave & 3, r = lane & 31, h = lane >> 5;
  const int lrow = tid >> 3, lcc = tid & 7;
  const char* ag = (const char*)(A + (size_t)lrow * lda + lcc * 8);
  const char* wg = (const char*)(W + (size_t)lrow * ldw + lcc * 8);
  const size_t astep = (size_t)64 * lda * 2, wstep = (size_t)64 * ldw * 2;
  char* As = smem; char* Bs = smem + 2 * G_TILEB;
  const int soff = lrow * G_ROWB + lcc * 16;
  u32x4 ra[4], rb[4];
#pragma unroll
  for (int i = 0; i < 4; ++i) { ra[i] = *(const u32x4*)(ag + i * astep); rb[i] = *(const u32x4*)(wg + i * wstep); }
#pragma unroll
  for (int i = 0; i < 4; ++i) { *(u32x4*)(As + soff + i * 64 * G_ROWB) = ra[i]; *(u32x4*)(Bs + soff + i * 64 * G_ROWB) = rb[i]; }
  __syncthreads();
  const int nk = K >> 6;
  const int aoff = (wm * 128 + r) * G_ROWB + h * 16;
  const int boff = (wn * 64 + r) * G_ROWB + h * 16;
#pragma unroll 1
  for (int kt = 0; kt < nk; ++kt) {
    const int cur = kt & 1;
    if (kt + 1 < nk) {
#pragma unroll
      for (int i = 0; i < 4; ++i) { ra[i] = *(const u32x4*)(ag + i * astep + (size_t)(kt + 1) * 128); rb[i] = *(const u32x4*)(wg + i * wstep + (size_t)(kt + 1) * 128); }
    }
    const char* Ac = As + cur * G_TILEB + aoff; const char* Bc = Bs + cur * G_TILEB + boff;
#pragma unroll
    for (int ks = 0; ks < 4; ++ks) {
      const bf16x8 b0 = *(const bf16x8*)(Bc + ks * 32), b1 = *(const bf16x8*)(Bc + 32 * G_ROWB + ks * 32);
#pragma unroll
      for (int ti = 0; ti < 4; ++ti) {
        const bf16x8 a = *(const bf16x8*)(Ac + ti * 32 * G_ROWB + ks * 32);
        acc[ti][0] = MFMA(b0, a, acc[ti][0]); acc[ti][1] = MFMA(b1, a, acc[ti][1]);
      }
    }
    if (kt + 1 < nk) {
      const int nb = cur ^ 1;
#pragma unroll
      for (int i = 0; i < 4; ++i) { *(u32x4*)(As + nb * G_TILEB + soff + i * 64 * G_ROWB) = ra[i]; *(u32x4*)(Bs + nb * G_TILEB + soff + i * 64 * G_ROWB) = rb[i]; }
    }
    __syncthreads();
  }
}

DI void zero_acc(f32x16 (&acc)[4][2]) {
#pragma unroll
  for (int a = 0; a < 4; ++a)
#pragma unroll
    for (int b = 0; b < 2; ++b) acc[a][b] = f32x16{};
}

DI uint2 pack4(float a, float b, float c, float d) { return make_uint2(cvtpk(a, b), cvtpk(c, d)); }
DI void rope_quad(const float2* cs, const f32x16& t1, const f32x16& t2, int q1, int q2, float sc, bf16_t* d1, bf16_t* d2) {
  const float4 c01 = ((const float4*)cs)[0], c23 = ((const float4*)cs)[1];
  const float c[4] = {c01.x, c01.z, c23.x, c23.z}, sn[4] = {c01.y, c01.w, c23.y, c23.w};
  float o1[4], o2[4];
#pragma unroll
  for (int j = 0; j < 4; ++j) {
    const float x1 = t1[q1 * 4 + j], x2 = t2[q2 * 4 + j];
    o1[j] = (x1 * c[j] - x2 * sn[j]) * sc; o2[j] = (x2 * c[j] + x1 * sn[j]) * sc;
  }
  *(uint2*)d1 = pack4(o1[0], o1[1], o1[2], o1[3]);
  *(uint2*)d2 = pack4(o2[0], o2[1], o2[2], o2[3]);
}

DI void g8_stage_rc(int b, int& R, int& C) {
  const int st = b / 1024, sb = b % 1024, swz = sb ^ (((sb >> 9) & 1) << 5);
  R = (st >> 1) * 16 + swz / 64; C = (st & 1) * 32 + (swz % 64) / 2;
}
#define G8_MFMA(a, b, c) __builtin_amdgcn_mfma_f32_16x16x32_bf16((a), (b), (c), 0, 0, 0)
template <bool STAGE0_ONLY>
DI void gemm8_impl(const bf16_t* __restrict__ P, int ldp, const bf16_t* __restrict__ Q, int ldq, int K, f32x4 (&acc)[2][2][4][2], char* smem, bool staged) {
  const int tid = otid(), lane = tid & 63, wid = __builtin_amdgcn_readfirstlane(tid >> 6), wr = wid >> 2, wc = wid & 3, fr = lane & 15, fq = lane >> 4;
  int r0, c0;
  g8_stage_rc(tid * 16, r0, c0);
  const unsigned pof = (unsigned)(r0 * ldp + c0) * 2u, qof = (unsigned)(r0 * ldq + c0) * 2u;
  const char* const Pb = (const char*)P; const char* const Qb = (const char*)Q;
  char* const sdst = smem + tid * 16;
  const int ob = fr * 64 + fq * 16, obs = ob ^ (((ob >> 9) & 1) << 5);
  const char* const ard = smem + wr * 8192 + obs;
  const char* const brd = smem + wc * 4096 + obs;
#define G8_SA(b, hh) (((b) * 2 + (hh)) * 16384)
#define G8_SB(b, hh) ((4 + (b) * 2 + (hh)) * 16384)
#define G8_STAGE_P(b, hh, kt) { const char* u_ = Pb + ((size_t)((hh) * 128) * ldp + (size_t)(kt) * 64) * 2;                \
    __builtin_amdgcn_global_load_lds((const unsigned*)(u_ + pof), (lds_uptr)(sdst + G8_SA(b, hh)), 16, 0, 0);               \
    __builtin_amdgcn_global_load_lds((const unsigned*)(u_ + (size_t)ldp * 128 + pof), (lds_uptr)(sdst + G8_SA(b, hh) + 8192), 16, 0, 0); }
#define G8_STAGE_Q(b, hh, kt) { const char* u_ = Qb + ((size_t)((hh) * 128) * ldq + (size_t)(kt) * 64) * 2;                \
    __builtin_amdgcn_global_load_lds((const unsigned*)(u_ + qof), (lds_uptr)(sdst + G8_SB(b, hh)), 16, 0, 0);               \
    __builtin_amdgcn_global_load_lds((const unsigned*)(u_ + (size_t)ldq * 128 + qof), (lds_uptr)(sdst + G8_SB(b, hh) + 8192), 16, 0, 0); }
#define G8_LDA(dst, b, hh) _Pragma("unroll") for (int m = 0; m < 4; ++m) _Pragma("unroll") for (int k = 0; k < 2; ++k) \
    dst[m][k] = *(const bf16x8*)(ard + G8_SA(b, hh) + m * 2048 + k * 1024)
#define G8_LDB(dst, b, hh) _Pragma("unroll") for (int n = 0; n < 2; ++n) _Pragma("unroll") for (int k = 0; k < 2; ++k) \
    dst[n][k] = *(const bf16x8*)(brd + G8_SB(b, hh) + n * 2048 + k * 1024)
#define G8_MMA(ai, bj, At_, Bt_) do { __builtin_amdgcn_s_setprio(1);                                                      \
    _Pragma("unroll") for (int m = 0; m < 4; ++m) _Pragma("unroll") for (int n = 0; n < 2; ++n) _Pragma("unroll") for (int k = 0; k < 2; ++k) \
      acc[ai][bj][m][n] = G8_MFMA(At_[m][k], Bt_[n][k], acc[ai][bj][m][n]);                                                \
    __builtin_amdgcn_s_setprio(0); } while (0)
#define G8_WAIT_V(n) asm volatile("s_waitcnt vmcnt(" #n ")" ::: "memory")
#define G8_WAIT_L(n) asm volatile("s_waitcnt lgkmcnt(" #n ")" ::: "memory")
#define G8_BAR __builtin_amdgcn_s_barrier()
#define G8_SCHED __builtin_amdgcn_sched_barrier(0)
  bf16x8 At[4][2], B0[2][2], B1[2][2];
  const int nt = K >> 6;
  if (STAGE0_ONLY) {
    G8_STAGE_Q(0, 0, 0); G8_STAGE_P(0, 0, 0);
    G8_STAGE_Q(0, 1, 0); G8_STAGE_P(0, 1, 0);
    return;
  }
  if (!staged) {
    __syncthreads();
    G8_STAGE_Q(0, 0, 0); G8_STAGE_P(0, 0, 0);
    G8_STAGE_Q(0, 1, 0); G8_STAGE_P(0, 1, 0);
  }
  if (wr == 1) G8_BAR;
  G8_WAIT_V(4); G8_BAR;
  G8_STAGE_Q(1, 0, 1); G8_STAGE_P(1, 0, 1); G8_STAGE_Q(1, 1, 1);
  G8_WAIT_V(6); G8_BAR;
#pragma unroll 1
  for (int t = 0; t < nt - 2; t += 2) {
    G8_LDB(B0, 0, 0); G8_SCHED; G8_LDA(At, 0, 0); G8_STAGE_P(1, 1, t + 1);
    G8_WAIT_L(8); G8_BAR; G8_WAIT_L(0); G8_MMA(0, 0, At, B0); G8_BAR; G8_SCHED;
    G8_LDB(B1, 0, 1); G8_STAGE_Q(0, 0, t + 2);
    G8_BAR; G8_WAIT_L(0); G8_MMA(0, 1, At, B1); G8_BAR;
    G8_LDA(At, 0, 1); G8_STAGE_P(0, 0, t + 2);
    G8_BAR; G8_WAIT_L(0); G8_MMA(1, 0, At, B0); G8_BAR; G8_SCHED;
    G8_STAGE_Q(0, 1, t + 2);
    G8_WAIT_V(6); G8_BAR; G8_MMA(1, 1, At, B1); G8_BAR;
    G8_LDB(B0, 1, 0); G8_SCHED; G8_LDA(At, 1, 0); G8_STAGE_P(0, 1, t + 2);
    G8_WAIT_L(8); G8_BAR; G8_WAIT_L(0); G8_MMA(0, 0, At, B0); G8_BAR; G8_SCHED;
    G8_LDB(B1, 1, 1); G8_STAGE_Q(1, 0, t + 3);
    G8_BAR; G8_WAIT_L(0); G8_MMA(0, 1, At, B1); G8_BAR;
    G8_LDA(At, 1, 1); G8_STAGE_P(1, 0, t + 3);
    G8_BAR; G8_WAIT_L(0); G8_MMA(1, 0, At, B0); G8_BAR; G8_SCHED;
    G8_STAGE_Q(1, 1, t + 3);
    G8_WAIT_V(6); G8_BAR; G8_MMA(1, 1, At, B1); G8_BAR;
  }
  { G8_LDB(B0, 0, 0); G8_LDA(At, 0, 0); G8_STAGE_P(1, 1, nt - 1);
    G8_BAR; G8_WAIT_L(0); G8_MMA(0, 0, At, B0); G8_BAR;
    G8_LDB(B1, 0, 1); G8_BAR; G8_WAIT_L(0); G8_MMA(0, 1, At, B1); G8_BAR;
    G8_LDA(At, 0, 1); G8_WAIT_V(4); G8_BAR; G8_WAIT_L(0); G8_MMA(1, 0, At, B0); G8_MMA(1, 1, At, B1); G8_BAR; }
  { G8_LDB(B0, 1, 0); G8_LDA(At, 1, 0); G8_WAIT_V(2); G8_BAR; G8_WAIT_L(0); G8_MMA(0, 0, At, B0); G8_BAR;
    G8_LDB(B1, 1, 1); G8_WAIT_V(0); G8_BAR; G8_WAIT_L(0); G8_MMA(0, 1, At, B1); G8_BAR;
    G8_LDA(At, 1, 1); G8_BAR; G8_WAIT_L(0); G8_MMA(1, 0, At, B0); G8_MMA(1, 1, At, B1); G8_BAR; }
  if (wr == 0) G8_BAR;
#undef G8_SA
#undef G8_SB
#undef G8_STAGE_P
#undef G8_STAGE_Q
#undef G8_LDA
#undef G8_LDB
#undef G8_MMA
#undef G8_WAIT_V
#undef G8_WAIT_L
#undef G8_BAR
#undef G8_SCHED
}

DI void gemm8(const bf16_t* P, int ldp, const bf16_t* Q, int ldq, int K, f32x4 (&acc)[2][2][4][2], char* smem, bool staged) {
  gemm8_impl<false>(P, ldp, Q, ldq, K, acc, smem, staged);
}
DI void gemm8_stage0(const bf16_t* P, int ldp, const bf16_t* Q, int ldq, f32x4 (&acc)[2][2][4][2], char* smem) {
  gemm8_impl<true>(P, ldp, Q, ldq, 256, acc, smem, false);
}
struct NextTile { const bf16_t* P; const bf16_t* Q; int ldp; int ldq; bool has; };
DI void zero_acc8(f32x4 (&acc)[2][2][4][2]) {
#pragma unroll
  for (int a = 0; a < 2; ++a)
#pragma unroll
    for (int b = 0; b < 2; ++b)
#pragma unroll
      for (int m = 0; m < 4; ++m)
#pragma unroll
        for (int n = 0; n < 2; ++n) acc[a][b][m][n] = f32x4{0.f, 0.f, 0.f, 0.f};
}
DI uint2 pack4v(f32x4 v, float sc) { return make_uint2(cvtpk(v[0] * sc, v[1] * sc), cvtpk(v[2] * sc, v[3] * sc)); }
DI void rope_quad4(const float2* cs, f32x4 x1, f32x4 x2, float sc, bf16_t* d1, bf16_t* d2) {
  const float4 c01 = ((const float4*)cs)[0], c23 = ((const float4*)cs)[1];
  const float c[4] = {c01.x, c01.z, c23.x, c23.z}, sn[4] = {c01.y, c01.w, c23.y, c23.w};
  float o1[4], o2[4];
#pragma unroll
  for (int j = 0; j < 4; ++j) { o1[j] = (x1[j] * c[j] - x2[j] * sn[j]) * sc; o2[j] = (x2[j] * c[j] + x1[j] * sn[j]) * sc; }
  *(uint2*)d1 = pack4(o1[0], o1[1], o1[2], o1[3]);
  *(uint2*)d2 = pack4(o2[0], o2[1], o2[2], o2[3]);
}

DI void inproj_tile(const Params& p, int layer, int tm, int tn, char* smem, bool staged, const NextTile& nx) {
  f32x4 acc[2][2][4][2]; zero_acc8(acc);
  const int m0 = tm * 256, n0 = tn * 256;
  gemm8(p.winT + ((size_t)layer * DINP + n0) * DM, DM, p.hn + (size_t)m0 * DM, DM, DM, acc, smem, staged);
  if (nx.has) gemm8_stage0(nx.P, nx.ldp, nx.Q, nx.ldq, acc, smem);
  const int tid_ = otid(); const int lane = tid_ & 63, wid = __builtin_amdgcn_readfirstlane(tid_ >> 6), wr = wid >> 2, wc = wid & 3, fr = lane & 15, fq = lane >> 4;
  const int pmask = pos_mask(m0);
#pragma unroll
  for (int bj = 0; bj < 2; ++bj)
#pragma unroll
    for (int n = 0; n < 2; ++n) {
      const int row = m0 + bj * 128 + wc * 32 + n * 16 + fr;
      const int pos = row & pmask;
      bf16_t* zrow = p.z + (size_t)row * ZLD;
#pragma unroll
      for (int ai = 0; ai < 2; ++ai) {
        const int fb = n0 + ai * 128 + wr * 64;
        if (fb >= Z_BQ && fb < Z_BV) {
          const float sc = fb < Z_BK ? SCALE_B : 1.f;
#pragma unroll
          for (int m = 0; m < 2; ++m) {
            const int f0 = m * 16 + fq * 4;
            rope_quad4(p.cs64 + pos * 32 + f0, acc[ai][bj][m][n], acc[ai][bj][m + 2][n], sc, zrow + fb + f0, zrow + fb + 32 + f0);
          }
        } else {
#pragma unroll
          for (int tj = 0; tj < 2; ++tj) {
            const int n32 = fb + tj * 32;
            if (n32 >= DIN) continue;
            const bool rope = (n32 < Z_AV) || (n32 == Z_DKR);
            const float sc = (n32 < Z_AK) ? SCALE_A : ((n32 >= Z_CQ && n32 < Z_CK) ? SCALE_C : 1.f);
            if (rope) {
              rope_quad4(p.cs32 + pos * 16 + fq * 4, acc[ai][bj][2 * tj][n], acc[ai][bj][2 * tj + 1][n], sc, zrow + n32 + fq * 4, zrow + n32 + 16 + fq * 4);
            } else {
              *(uint2*)(zrow + n32 + fq * 4) = pack4v(acc[ai][bj][2 * tj][n], sc);
              *(uint2*)(zrow + n32 + 16 + fq * 4) = pack4v(acc[ai][bj][2 * tj + 1][n], sc);
            }
          }
        }
      }
    }
}

DI void tile_rs(const bf16_t* A, int lda, int K, float* rsv) {
  const int t = otid();
  const uint4* src = (const uint4*)(A + (size_t)(t >> 1) * lda + (t & 1) * (K >> 1));
  float ss = 0.f;
  for (int c = 0; c < (K >> 4); ++c) {
    const uint4 u = src[c];
    ss += bflo(u.x) * bflo(u.x) + bfhi(u.x) * bfhi(u.x) + bflo(u.y) * bflo(u.y) + bfhi(u.y) * bfhi(u.y)
        + bflo(u.z) * bflo(u.z) + bfhi(u.z) * bfhi(u.z) + bflo(u.w) * bflo(u.w) + bfhi(u.w) * bfhi(u.w);
  }
  ss += __shfl_xor(ss, 1);
  if ((t & 1) == 0) rsv[t >> 1] = rsqrtf(ss / (float)K + EPS);
}

DI void upproj_tile(const Params& p, int layer, int tm, int sel, char* smem) {
  const int m0 = tm * 256;
  const int pmask = pos_mask(m0);
  float* rsv = (float*)(smem + SM_RS);
  const int tid_ = otid(); const int lane = tid_ & 63, wave = __builtin_amdgcn_readfirstlane(tid_ >> 6), wm = wave >> 2, wn = wave & 3, r = lane & 31, h = lane >> 5;
  f32x16 acc[4][2]; zero_acc(acc);
  __syncthreads();
  if (sel < 2) {
    const int n0 = sel * 256;
    const bf16_t* A = p.z + (size_t)m0 * ZLD + Z_DCQ;
    tile_rs(A, ZLD, 256, rsv);
    gemm_core(A, ZLD, p.wuqT + ((size_t)layer * 384 + n0) * 256, 256, 256, acc, smem);
#pragma unroll
    for (int ti = 0; ti < 4; ++ti) {
      const int rl = wm * 128 + ti * 32 + r, row = m0 + rl;
      const float rsc = rsv[rl] * SCALE_D;
      bf16_t* qrow = p.qd + (size_t)row * 384;
#pragma unroll
      for (int tj = 0; tj < 2; ++tj) {
        const int n = n0 + wn * 64 + tj * 32;
        if (n >= 384) continue;
        if ((n % 96) == 64) {
#pragma unroll
          for (int g = 0; g < 2; ++g) {
            const int f0 = 8 * g + 4 * h;
            rope_quad(p.cs32 + (row & pmask) * 16 + f0, acc[ti][tj], acc[ti][tj], g, g + 2, rsc, qrow + n + f0, qrow + n + 16 + f0);
          }
        } else {
#pragma unroll
          for (int g = 0; g < 4; ++g)
            *(uint2*)(qrow + n + 8 * g + 4 * h) = pack4(acc[ti][tj][4 * g] * rsc, acc[ti][tj][4 * g + 1] * rsc, acc[ti][tj][4 * g + 2] * rsc, acc[ti][tj][4 * g + 3] * rsc);
        }
      }
    }
  } else {
    const int n0 = (sel - 2) * 256;
    const bf16_t* A = p.z + (size_t)m0 * ZLD + Z_DCKV;
    tile_rs(A, ZLD, 128, rsv);
    gemm_core(A, ZLD, p.wukvT + ((size_t)layer * 512 + n0) * 128, 128, 128, acc, smem);
#pragma unroll
    for (int ti = 0; ti < 4; ++ti) {
      const int rl = wm * 128 + ti * 32 + r, row = m0 + rl;
      const float rsc = rsv[rl];
      bf16_t* krow = p.kvd + (size_t)row * 512 + n0 + wn * 64;
#pragma unroll
      for (int tj = 0; tj < 2; ++tj)
#pragma unroll
        for (int g = 0; g < 4; ++g)
          *(uint2*)(krow + tj * 32 + 8 * g + 4 * h) = pack4(acc[ti][tj][4 * g] * rsc, acc[ti][tj][4 * g + 1] * rsc, acc[ti][tj][4 * g + 2] * rsc, acc[ti][tj][4 * g + 3] * rsc);
    }
  }
}

DI void outproj_tile(const Params& p, int layer, int tm, int tn, char* smem, bool staged, const NextTile& nx) {
  f32x4 acc[2][2][4][2]; zero_acc8(acc);
  const int m0 = tm * 256, n0 = tn * 256;
  gemm8(p.woutT + ((size_t)layer * DM + n0) * DM, DM, p.hn + (size_t)m0 * DM, DM, DM, acc, smem, staged);
  if (nx.has) gemm8_stage0(nx.P, nx.ldp, nx.Q, nx.ldq, acc, smem);
  const int tid_ = otid(); const int lane = tid_ & 63, wid = __builtin_amdgcn_readfirstlane(tid_ >> 6), wr = wid >> 2, wc = wid & 3, fr = lane & 15, fq = lane >> 4;
#pragma unroll
  for (int bj = 0; bj < 2; ++bj)
#pragma unroll
    for (int n = 0; n < 2; ++n) {
      const int row = m0 + bj * 128 + wc * 32 + n * 16 + fr;
      const float* hrow = (layer == 0 ? xrow(p, row) : p.out + (size_t)row * DM) + n0 + wr * 64 + fq * 4;
      float* orow = p.out + (size_t)row * DM + n0 + wr * 64 + fq * 4;
#pragma unroll
      for (int ai = 0; ai < 2; ++ai)
#pragma unroll
        for (int m = 0; m < 4; ++m) {
          const float4 hv = *(const float4*)(hrow + ai * 128 + m * 16);
          const f32x4 a = acc[ai][bj][m][n];
          *(float4*)(orow + ai * 128 + m * 16) = make_float4(hv.x + a[0], hv.y + a[1], hv.z + a[2], hv.w + a[3]);
        }
    }
}

DI void pproj_tile(const Params& p, int layer, int tm, int tn, char* smem, bool staged, const NextTile& nx) {
  f32x4 acc[2][2][4][2]; zero_acc8(acc);
  const int m0 = tm * 256, n0 = tn * 256;
  gemm8(p.wppT + ((size_t)layer * DM + n0) * 256, 256, p.pb + (size_t)m0 * 256, 256, 256, acc, smem, staged);
  if (nx.has) gemm8_stage0(nx.P, nx.ldp, nx.Q, nx.ldq, acc, smem);
  const int tid_ = otid(); const int lane = tid_ & 63, wid = __builtin_amdgcn_readfirstlane(tid_ >> 6), wr = wid >> 2, wc = wid & 3, fr = lane & 15, fq = lane >> 4;
#pragma unroll
  for (int bj = 0; bj < 2; ++bj)
#pragma unroll
    for (int n = 0; n < 2; ++n) {
      const int row = m0 + bj * 128 + wc * 32 + n * 16 + fr;
      bf16_t* prow = p.z + (size_t)row * DM + n0 + wr * 64 + fq * 4;
#pragma unroll
      for (int ai = 0; ai < 2; ++ai)
#pragma unroll
        for (int m = 0; m < 4; ++m) *(uint2*)(prow + ai * 128 + m * 16) = pack4v(acc[ai][bj][m][n], 1.f);
    }
}

DI void ple_tile(const Params& p, int layer, int tm, int tn, char* smem, bool staged, const NextTile& nx) {
  f32x4 acc[2][2][4][2]; zero_acc8(acc);
  const int m0 = tm * 256, n0 = tn * 256;
  gemm8(p.wpgT + ((size_t)layer * DM + n0) * DM, DM, p.hn + (size_t)m0 * DM, DM, DM, acc, smem, staged);
  if (nx.has) gemm8_stage0(nx.P, nx.ldp, nx.Q, nx.ldq, acc, smem);
  const int tid_ = otid(); const int lane = tid_ & 63, wid = __builtin_amdgcn_readfirstlane(tid_ >> 6), wr = wid >> 2, wc = wid & 3, fr = lane & 15, fq = lane >> 4;
#pragma unroll
  for (int bj = 0; bj < 2; ++bj)
#pragma unroll
    for (int n = 0; n < 2; ++n) {
      const int row = m0 + bj * 128 + wc * 32 + n * 16 + fr;
      float* orow = p.out + (size_t)row * DM + n0 + wr * 64 + fq * 4;
      const bf16_t* prow = p.z + (size_t)row * DM + n0 + wr * 64 + fq * 4;
#pragma unroll
      for (int ai = 0; ai < 2; ++ai)
#pragma unroll
        for (int m = 0; m < 4; ++m) {
          const float4 ov = *(const float4*)(orow + ai * 128 + m * 16);
          const uint2 pu = *(const uint2*)(prow + ai * 128 + m * 16);
          const f32x4 a = acc[ai][bj][m][n];
          *(float4*)(orow + ai * 128 + m * 16) = make_float4(ov.x + sigm(a[0]) * bflo(pu.x), ov.y + sigm(a[1]) * bfhi(pu.x),
                                                            ov.z + sigm(a[2]) * bflo(pu.y), ov.w + sigm(a[3]) * bfhi(pu.y));
        }
    }
}

template <int MODE>
DI void attn_item(const Params& p, int layer, int v, char* smem) {
  constexpr int NMAPS = (MODE == 0) ? 2 : 1;
  constexpr int KS = (MODE == 0) ? 2 : ((MODE == 3) ? 6 : 4);
  constexpr int DK = (MODE == 3) ? 96 : 64;
  constexpr int KSTR = (DK + 8) * 2;
  constexpr int VSTR = 144;
  constexpr int KBUF = 64 * KSTR;
  constexpr int BUFB = KBUF + 64 * VSTR;
  constexpr bool LAZY = (MODE == 0 || MODE == 3);
  const int tid = otid(), lane = tid & 63, wave = __builtin_amdgcn_readfirstlane(tid >> 6), r = lane & 31, h = lane >> 5;
  int seq, head, qt, S, row0;
  if (v < 1024) {
    const int b = v & 255, k = v >> 8, x = b & 7, j = b >> 3, pr = x + 8 * k;
    seq = pr >> 2; head = pr & 3; qt = j; S = 8192; row0 = seq * 8192;
  } else {
    const int b = v - 1024, x = b & 7, j = b >> 3, pr = x + 8 * (j >> 4);
    seq = pr >> 2; head = pr & 3; qt = j & 15; S = 4096; row0 = NPROMPT + seq * 4096;
  }
  const int q0 = qt * 256, nkt = S >> 6;
  int kt_lo = 0, kt_hi = nkt, cR = 0, clo = 0;
  if (MODE == 1) { kt_lo = max(0, 4 * qt - 2); kt_hi = min(nkt, 4 * qt + 6); }
  if (MODE == 2) {
    const int R0 = 4 * qt;
    kt_lo = min(max(R0 - 4, 0), nkt - 8); kt_hi = min(max(R0 - 1, 0), nkt - 8) + 8;
    cR = R0 + (wave >> 1); clo = min(max(cR - 4, 0), nkt - 8);
  }
  const bf16_t *qp, *kp, *vp; int ldq, ldk, ldv;
  if (MODE == 0) { qp = p.z + Z_AQ + head * 64; kp = p.z + Z_AK + head * 64; vp = p.z + Z_AV + head * 64; ldq = ldk = ldv = ZLD; }
  else if (MODE == 1) { qp = p.z + Z_BQ + head * 64; kp = p.z + Z_BK + (head >> 1) * 64; vp = p.z + Z_BV + (head >> 1) * 64; ldq = ldk = ldv = ZLD; }
  else if (MODE == 2) { qp = p.z + Z_CQ + head * 64; kp = p.z + Z_CK + head * 64; vp = p.z + Z_CV + head * 64; ldq = ldk = ldv = ZLD; }
  else { qp = p.qd + head * 96; ldq = 384; kp = p.kvd + head * 128; vp = p.kvd + head * 128 + 64; ldk = ldv = 512; }

  float* bias = (float*)(smem + SM_BIAS);
  if (MODE == 2) {
    const float* rp = p.c_rpb + (size_t)(layer * 4 + head) * 465;
    for (int i = tid; i < 465; i += NTHR) bias[i] = rp[i] * LOG2E;
  }

  bf16x8 qf[NMAPS][KS];
  {
    const bf16_t* qrow = qp + (size_t)(row0 + q0 + wave * 32 + r) * ldq + 8 * h;
#pragma unroll
    for (int m = 0; m < NMAPS; ++m)
#pragma unroll
      for (int ks = 0; ks < KS; ++ks) qf[m][ks] = *(const bf16x8*)(qrow + (m * KS + ks) * 16);
  }
  float mrun[NMAPS], lrun[NMAPS];
  f32x16 o[NMAPS][2];
  f32x16 negm[NMAPS];
  bool zref[NMAPS];
#pragma unroll
  for (int m = 0; m < NMAPS; ++m) { mrun[m] = LAZY ? 0.f : -1e30f; lrun[m] = 0.f; o[m][0] = f32x16{}; o[m][1] = f32x16{}; negm[m] = f32x16{}; zref[m] = true; }
  if (MODE == 1) { mrun[0] = p.b_sink[layer * 4 + head] * LOG2E; lrun[0] = (h == 0) ? 1.f : 0.f; }

  const int lrow = tid >> 3, lcc = tid & 7;
  const bf16_t* kg = kp + (size_t)(row0 + lrow) * ldk + lcc * 8;
  const bf16_t* vg = vp + (size_t)(row0 + lrow) * ldv + lcc * 8;
  const bf16_t* k2g = p.z + (size_t)(row0 + ((tid & 255) >> 2)) * ZLD + Z_DKR + (tid & 3) * 8;
  u32x4 kr0, vr0, k2r = u32x4{};
#define ATT_LOAD(kt_)                                                                              \
  {                                                                                                \
    const size_t ro_ = (size_t)(kt_) * 64;                                                         \
    kr0 = *(const u32x4*)(kg + ro_ * ldk);                                                         \
    vr0 = *(const u32x4*)(vg + ro_ * ldv);                                                         \
    if (MODE == 3) { if (tid < 256) k2r = *(const u32x4*)(k2g + ro_ * ZLD); }                      \
  }
#define ATT_STORE(buf_)                                                                            \
  {                                                                                                \
    char* kb_ = smem + (buf_) * BUFB;                                                              \
    *(u32x4*)(kb_ + lrow * KSTR + lcc * 16) = kr0;                                                 \
    *(u32x4*)(kb_ + KBUF + lrow * VSTR + lcc * 16) = vr0;                                          \
    if (MODE == 3) { if (tid < 256) *(u32x4*)(kb_ + (tid >> 2) * KSTR + 128 + (tid & 3) * 16) = k2r; } \
  }
  ATT_LOAD(kt_lo);
  ATT_STORE(0);
  __syncthreads();

  const int i16 = lane & 15;
  const int voff = (4 * h + (i16 >> 2)) * VSTR + (((lane >> 4) & 1) * 16 + (i16 & 3) * 4) * 2;
  const int qi = q0 + wave * 32 + r;
  const int cc = (wave & 1) * 32 + r;
  const int ccs = min(max(cc - 8, 0), 48);

  if (wave >= 4) __builtin_amdgcn_s_setprio(1);
#pragma unroll 1
  for (int kt = kt_lo; kt < kt_hi; ++kt) {
    const int cur = (kt - kt_lo) & 1;
    if (kt + 1 < kt_hi) ATT_LOAD(kt + 1);
    const bool active = (MODE == 2) ? (kt >= clo && kt < clo + 8)
                      : ((MODE == 1) ? (kt * 64 + 63 >= q0 + wave * 32 - 128 && kt * 64 <= q0 + wave * 32 + 31 + 128) : true);
    if (active) {
      const char* kb = smem + cur * BUFB;
      const char* vb = kb + KBUF;
      bf16x8 pf[NMAPS][2][2];
#pragma unroll
      for (int m = 0; m < NMAPS; ++m) {
        f32x16 st[2];
        auto qk_chain = [&](const bool use_ref) {
#pragma unroll
          for (int sub = 0; sub < 2; ++sub) {
            f32x16 s;
            if (use_ref) s = negm[m]; else s = f32x16{};
#pragma unroll
            for (int ks = 0; ks < KS; ++ks) {
              const bf16x8 kf = *(const bf16x8*)(kb + (sub * 32 + r) * KSTR + ((m * KS + ks) * 16 + 8 * h) * 2);
              s = MFMA(kf, qf[m][ks], s);
            }
            st[sub] = s;
          }
        };
        if (LAZY && !zref[m]) qk_chain(true); else qk_chain(false);
        if (MODE == 1) {
          int tb = kt * 64 + 4 * h - qi + 128;
          asm volatile("" : "+v"(tb));
#pragma unroll
          for (int sub = 0; sub < 2; ++sub)
#pragma unroll
            for (int i = 0; i < 16; ++i) {
              const int c0 = sub * 32 + (i & 3) + 8 * (i >> 2);
              if ((unsigned)(tb + c0) > 256u) st[sub][i] = -INFINITY;
            }
        }
        if (MODE == 2) {
          int tcc = 4 * h - cc + 15 + (kt - cR + 7) * 31, tcs = 4 * h - ccs;
          asm volatile("" : "+v"(tcc), "+v"(tcs));
#pragma unroll
          for (int sub = 0; sub < 2; ++sub)
#pragma unroll
            for (int i = 0; i < 16; ++i) {
              const int c0 = sub * 32 + (i & 3) + 8 * (i >> 2);
              const bool valid = (unsigned)(c0 + tcs) < 16u;
              const int idx = valid ? tcc + c0 : 0;
              const float bv = bias[idx];
              st[sub][i] = valid ? st[sub][i] + bv : -INFINITY;
            }
        }
        auto tile_max = [&]() {
          float mx_ = fmaxf(fmaxf(st[0][0], st[0][1]), st[1][0]);
          float mb_ = fmaxf(fmaxf(st[0][2], st[0][3]), st[1][1]);
          mx_ = fmaxf(fmaxf(mx_, st[1][2]), st[1][3]);
#pragma unroll
          for (int i = 4; i < 16; i += 4) {
            mx_ = fmaxf(fmaxf(mx_, st[0][i]), st[0][i + 1]); mb_ = fmaxf(fmaxf(mb_, st[0][i + 2]), st[0][i + 3]);
            mx_ = fmaxf(fmaxf(mx_, st[1][i]), st[1][i + 1]); mb_ = fmaxf(fmaxf(mb_, st[1][i + 2]), st[1][i + 3]);
          }
          return swap_max(fmaxf(mx_, mb_));
        };
        float mx = 0.f;
        if (!LAZY) mx = tile_max();
        if (LAZY) {
          int ia = max(max(__float_as_int(st[0][0]), __float_as_int(st[0][1])), __float_as_int(st[1][0]));
          int ib = max(max(__float_as_int(st[0][2]), __float_as_int(st[0][3])), __float_as_int(st[1][1]));
          ia = max(max(ia, __float_as_int(st[1][2])), __float_as_int(st[1][3]));
#pragma unroll
          for (int i = 4; i < 16; i += 4) {
            ia = max(max(ia, __float_as_int(st[0][i])), __float_as_int(st[0][i + 1])); ib = max(max(ib, __float_as_int(st[0][i + 2])), __float_as_int(st[0][i + 3]));
            ia = max(max(ia, __float_as_int(st[1][i])), __float_as_int(st[1][i + 1])); ib = max(max(ib, __float_as_int(st[1][i + 2])), __float_as_int(st[1][i + 3]));
          }
          ia = max(ia, ib);
          const bool first = (kt == kt_lo);
          bool need = __builtin_amdgcn_ballot_w64(ia > 0x41000000) != 0;
          if (first) { mx = tile_max(); need = need || (__builtin_amdgcn_ballot_w64(mx < -8.f) != 0); }
          if (need) {
            if (!first) mx = tile_max();
            zref[m] = false;
            const float delta = first ? mx : fmaxf(mx, 0.f);
            const float alpha = first ? 1.f : ex2(-delta);
            mrun[m] += delta;
            lrun[m] *= alpha;
#pragma unroll
            for (int i = 0; i < 16; ++i) { o[m][0][i] *= alpha; o[m][1][i] *= alpha; st[0][i] -= delta; st[1][i] -= delta; }
            const float nm = -mrun[m];
#pragma unroll
            for (int i = 0; i < 16; ++i) negm[m][i] = nm;
          }
          f32x2 l2[4] = {{0.f, 0.f}, {0.f, 0.f}, {0.f, 0.f}, {0.f, 0.f}};
#pragma unroll
          for (int sub = 0; sub < 2; ++sub)
#pragma unroll
            for (int i = 0; i < 16; i += 2) {
              const float p0 = ex2(st[sub][i]), p1 = ex2(st[sub][i + 1]);
              st[sub][i] = p0; st[sub][i + 1] = p1;
              l2[(i >> 1) & 3] += f32x2{p0, p1};
            }
          const f32x2 lt = (l2[0] + l2[1]) + (l2[2] + l2[3]);
          lrun[m] += lt[0] + lt[1];
        } else {
          const float mnew = fmaxf(mrun[m], mx);
          const float alpha = ex2(mrun[m] - mnew);
          mrun[m] = mnew;
          float ls = 0.f;
#pragma unroll
          for (int sub = 0; sub < 2; ++sub)
#pragma unroll
            for (int i = 0; i < 16; ++i) { const float pv = ex2(st[sub][i] - mnew); ls += pv; st[sub][i] = pv; }
          lrun[m] = lrun[m] * alpha + ls;
#pragma unroll
          for (int i = 0; i < 16; ++i) { o[m][0][i] *= alpha; o[m][1][i] *= alpha; }
        }
#pragma unroll
        for (int sub = 0; sub < 2; ++sub)
#pragma unroll
          for (int kk = 0; kk < 2; ++kk) {
            const uint4 u = make_uint4(cvtpk(st[sub][8 * kk + 0], st[sub][8 * kk + 1]), cvtpk(st[sub][8 * kk + 2], st[sub][8 * kk + 3]),
                                       cvtpk(st[sub][8 * kk + 4], st[sub][8 * kk + 5]), cvtpk(st[sub][8 * kk + 6], st[sub][8 * kk + 7]));
            pf[m][sub][kk] = __builtin_bit_cast(bf16x8, u);
          }
      }
#pragma unroll
      for (int sub = 0; sub < 2; ++sub)
#pragma unroll
        for (int kk = 0; kk < 2; ++kk)
#pragma unroll
          for (int dvt = 0; dvt < 2; ++dvt) {
            const char* va = vb + voff + (sub * 32 + kk * 16) * VSTR + dvt * 64;
            const s16x4 lo = vtr(va), hi = vtr(va + 8 * VSTR);
            const bf16x8 vf = __builtin_shufflevector(lo, hi, 0, 1, 2, 3, 4, 5, 6, 7);
#pragma unroll
            for (int m = 0; m < NMAPS; ++m) o[m][dvt] = MFMA(vf, pf[m][sub][kk], o[m][dvt]);
          }
    }
    if (kt + 1 < kt_hi) ATT_STORE(cur ^ 1);
    __syncthreads();
  }
  if (wave >= 4) __builtin_amdgcn_s_setprio(0);
#undef ATT_LOAD
#undef ATT_STORE

  float inv[NMAPS];
#pragma unroll
  for (int m = 0; m < NMAPS; ++m) inv[m] = 1.f / swap_sum(lrun[m]);
  f32x16 res[2];
  if (MODE == 0) {
    const float lam = p.lam[layer];
    const float lam_init = 0.8f - 0.6f * __expf(-0.3f * (float)layer);
    float ss = 0.f;
#pragma unroll
    for (int dvt = 0; dvt < 2; ++dvt)
#pragma unroll
      for (int i = 0; i < 16; ++i) { const float t = o[0][dvt][i] * inv[0] - lam * (o[NMAPS - 1][dvt][i] * inv[NMAPS - 1]); res[dvt][i] = t; ss += t * t; }
    ss = swap_sum(ss);
    const float rs = rsqrtf(ss * (1.f / 64.f) + EPS) * (1.f - lam_init);
    const float* sg = p.a_subln_g + layer * 64;
#pragma unroll
    for (int dvt = 0; dvt < 2; ++dvt)
#pragma unroll
      for (int i = 0; i < 16; ++i) res[dvt][i] *= rs * sg[dvt * 32 + crow(i, h)];
  } else {
#pragma unroll
    for (int dvt = 0; dvt < 2; ++dvt)
#pragma unroll
      for (int i = 0; i < 16; ++i) res[dvt][i] = o[0][dvt][i] * inv[0];
  }
  {
    const size_t row = (size_t)(row0 + qi);
    const bf16_t* gp = p.z + row * ZLD + Z_GATE + MODE * 256 + head * 64;
    bf16_t* mp = p.hn + row * DM + MODE * 256 + head * 64;
#pragma unroll
    for (int dvt = 0; dvt < 2; ++dvt)
#pragma unroll
      for (int ig = 0; ig < 4; ++ig) {
        const int dv0 = dvt * 32 + ig * 8 + 4 * h;
        const uint2 gu = *(const uint2*)(gp + dv0);
        const float g0 = bflo(gu.x), g1 = bfhi(gu.x), g2 = bflo(gu.y), g3 = bfhi(gu.y);
        const float a0 = res[dvt][ig * 4 + 0] * g0 * sigm(g0), a1 = res[dvt][ig * 4 + 1] * g1 * sigm(g1);
        const float a2 = res[dvt][ig * 4 + 2] * g2 * sigm(g2), a3 = res[dvt][ig * 4 + 3] * g3 * sigm(g3);
        *(uint2*)(mp + dv0) = make_uint2(cvtpk(a0, a1), cvtpk(a2, a3));
      }
  }
}

#define XB_TMO      128
#define XB_XCNT(j)  (256  + 64 * (j))
#define XB_XSUB(j)  (1280 + 64 * (j))
#define XB_XGEN(j)  (2304 + 64 * (j))
#define XB_TOP      3328
#define XB_TOPGEN   3392
#define XB_SPIN_CAP (1u << 18)
#define LAS __attribute__((address_space(3)))
DI unsigned xb_ld(unsigned* p) { return __hip_atomic_load(p, __ATOMIC_RELAXED, __HIP_MEMORY_SCOPE_AGENT); }
DI unsigned xb_add(unsigned* p, unsigned v) { return __hip_atomic_fetch_add(p, v, __ATOMIC_RELAXED, __HIP_MEMORY_SCOPE_AGENT); }
DI unsigned xb_xcc_id() { return (unsigned)__builtin_amdgcn_s_getreg((3 << 11) | 20) & 0xFu; }
#define XB_SPIN(cond, bar) do { unsigned _sp = 0; while (cond) { __builtin_amdgcn_s_sleep(1); \
    if ((++_sp & 255u) == 0u) { if (xb_ld(&(bar)[XB_TMO])) break; if (_sp > XB_SPIN_CAP) { atomicAdd(&(bar)[XB_TMO], 1u); break; } } } } while (0)
struct XcdBarrier { unsigned* bar; unsigned x; volatile LAS unsigned* st; };
DI XcdBarrier xcd_barrier_post(unsigned* bar, volatile LAS unsigned* st) {
  XcdBarrier b; b.bar = bar; b.x = xb_xcc_id(); b.st = st;
  if (threadIdx.x == 0) (void)xb_add(&bar[XB_XCNT(b.x)], 1u);
  return b;
}
DI void xcd_barrier_complete(unsigned* bar, unsigned x, unsigned& nloc, unsigned& nx) {
  const unsigned G = gridDim.x * gridDim.y * gridDim.z;
  unsigned sum, cnt, mine, sp = 0u;
  for (;;) {
    sum = 0u; cnt = 0u; mine = 0u;
#pragma unroll
    for (unsigned j = 0; j < 16; ++j) { const unsigned c = xb_ld(&bar[XB_XCNT(j)]); sum += c; cnt += (c > 0u) ? 1u : 0u; mine = (j == x) ? c : mine; }
    if (sum == G) break;
    __builtin_amdgcn_s_sleep(1);
    if ((++sp & 255u) == 0u) { if (xb_ld(&bar[XB_TMO])) break; if (sp > XB_SPIN_CAP) { atomicAdd(&bar[XB_TMO], 1u); break; } }
  }
  nloc = mine > 0u ? mine : 1u; nx = cnt > 0u ? cnt : 1u;
}
DI void xcd_barrier(const XcdBarrier& b) {
  asm volatile("s_waitcnt vmcnt(0)" ::: "memory");
  __syncthreads();
  if (threadIdx.x == 0) {
    unsigned* bar = b.bar;
    __builtin_amdgcn_s_waitcnt(0);
    unsigned nloc = b.st[0], nx = b.st[1];
    if (nloc == 0u) { xcd_barrier_complete(bar, b.x, nloc, nx); b.st[0] = nloc; b.st[1] = nx; }
    const unsigned old = xb_add(&bar[XB_XSUB(b.x)], 1u);
    const unsigned gen = old / nloc;
    if (old + 1u == (gen + 1u) * nloc) {
      __builtin_amdgcn_fence(__ATOMIC_RELEASE, "agent");
      asm volatile("s_waitcnt vmcnt(0)" ::: "memory");
      const unsigned og = xb_add(&bar[XB_TOP], 1u);
      const unsigned tg = og / nx;
      if (og + 1u == (tg + 1u) * nx) xb_add(&bar[XB_TOPGEN], 1u);
      else XB_SPIN(xb_ld(&bar[XB_TOPGEN]) == tg, bar);
      __builtin_amdgcn_fence(__ATOMIC_ACQUIRE, "agent");
      xb_add(&bar[XB_XGEN(b.x)], 1u);
      asm volatile("s_waitcnt vmcnt(0)" ::: "memory");
    } else {
      XB_SPIN(xb_ld(&bar[XB_XGEN(b.x)]) == gen, bar);
      __builtin_amdgcn_fence(__ATOMIC_ACQUIRE, "agent");
      asm volatile("s_waitcnt vmcnt(0)" ::: "memory");
    }
  }
  __syncthreads();
}

__global__ void __launch_bounds__(512, 2) mega_fwd(Params p) {
  __shared__ __attribute__((aligned(16))) char smem[SMEM_BYTES];
  cg::grid_group grid = cg::this_grid();
  const int nb = gridDim.x;

  if (threadIdx.x < 4) ((unsigned*)(smem + SM_XB))[threadIdx.x] = 0u;
  phase_prep(p, smem);
  grid.sync();
  const XcdBarrier xb = xcd_barrier_post(p.bar, (volatile LAS unsigned*)(lds_cptr)(smem + SM_XB));
#pragma unroll 1
  for (int layer = 0; layer < 2; ++layer) {
    phase_norm(p, layer, 0);
    xcd_barrier(xb);
    {
      bool staged = false;
      for (int v = blockIdx.x; v < 18 * 256; v += nb) {
        const int b = v & 255, k = v >> 8, x = b & 7, j = b >> 3, st = k * 8 + x;
        if (st >= 140) continue;
        const int tm = (st / 7) * 16 + (j >> 1), tn = (st % 7) * 2 + (j & 1);
        NextTile nx;
        {
          const int v2 = v + nb, b2 = v2 & 255, k2 = v2 >> 8, st2 = k2 * 8 + (b2 & 7), j2 = b2 >> 3;
          nx.has = (v2 < 18 * 256) && (st2 < 140);
          const int tm2 = (st2 / 7) * 16 + (j2 >> 1), tn2 = (st2 % 7) * 2 + (j2 & 1);
          nx.P = p.winT + ((size_t)layer * DINP + tn2 * 256) * DM; nx.Q = p.hn + (size_t)tm2 * 256 * DM; nx.ldp = DM; nx.ldq = DM;
        }
        inproj_tile(p, layer, tm, tn, smem, staged, nx);
        staged = nx.has;
      }
    }
    xcd_barrier(xb);
    for (int v = blockIdx.x; v < 1280 + 1280 + 1280 + 1280; v += nb) {
      if (v < 1280) attn_item<0>(p, layer, v, smem);
      else if (v < 2560) { const int u = v - 1280; upproj_tile(p, layer, u >> 2, u & 3, smem); }
      else if (v < 3840) attn_item<1>(p, layer, v - 2560, smem);
      else attn_item<2>(p, layer, v - 3840, smem);
    }
    xcd_barrier(xb);
    for (int v = blockIdx.x; v < 1280; v += nb) attn_item<3>(p, layer, v, smem);
    xcd_barrier(xb);
    {
      bool staged = false;
      for (int v = blockIdx.x; v < 2560; v += nb) {
        const int vv = v < 1280 ? v : v - 1280;
        const int b = vv & 255, k = vv >> 8, x = b & 7, j = b >> 3, st = k * 8 + x;
        NextTile nx;
        {
          const int v2 = v + nb, vv2 = v2 < 1280 ? v2 : v2 - 1280;
          const int b2 = vv2 & 255, st2 = (vv2 >> 8) * 8 + (b2 & 7), j2 = b2 >> 3, tm2 = st2 * 8 + (j2 >> 2), tn2 = j2 & 3;
          nx.has = v2 < 2560;
          if (v2 < 1280) { nx.P = p.woutT + ((size_t)layer * DM + tn2 * 256) * DM; nx.Q = p.hn + (size_t)tm2 * 256 * DM; nx.ldp = DM; nx.ldq = DM; }
          else { nx.P = p.wppT + ((size_t)layer * DM + tn2 * 256) * 256; nx.Q = p.pb + (size_t)tm2 * 256 * 256; nx.ldp = 256; nx.ldq = 256; }
        }
        if (v < 1280) outproj_tile(p, layer, st * 8 + (j >> 2), j & 3, smem, staged, nx);
        else pproj_tile(p, layer, st * 8 + (j >> 2), j & 3, smem, staged, nx);
        staged = nx.has;
      }
    }
    xcd_barrier(xb);
    phase_norm(p, layer, 1);
    xcd_barrier(xb);
    {
      bool staged = false;
      for (int v = blockIdx.x; v < 1280; v += nb) {
        const int b = v & 255, k = v >> 8, x = b & 7, j = b >> 3, st = k * 8 + x;
        NextTile nx;
        {
          const int v2 = v + nb, b2 = v2 & 255, st2 = (v2 >> 8) * 8 + (b2 & 7), j2 = b2 >> 3, tm2 = st2 * 8 + (j2 >> 2), tn2 = j2 & 3;
          nx.has = v2 < 1280;
          nx.P = p.wpgT + ((size_t)layer * DM + tn2 * 256) * DM; nx.Q = p.hn + (size_t)tm2 * 256 * DM; nx.ldp = DM; nx.ldq = DM;
        }
        ple_tile(p, layer, st * 8 + (j >> 2), j & 3, smem, staged, nx);
        staged = nx.has;
      }
    }
    xcd_barrier(xb);
  }
  phase_norm(p, 0, 2);
}

extern "C" void kernel_launch(void* const* d_in, const int* in_sizes, int n_in, void* d_out, int out_size, void* d_ws, size_t ws_size,
                              hipStream_t stream) {
  Params p{};
  p.x_prompt = (const float*)d_in[0]; p.x_sample = (const float*)d_in[1]; p.p_prompt = (const float*)d_in[2]; p.p_sample = (const float*)d_in[3];
  p.norm_g = (const float*)d_in[4]; p.w_in = (const float*)d_in[5]; p.a_lambda = (const float*)d_in[6]; p.a_subln_g = (const float*)d_in[7];
  p.b_sink = (const float*)d_in[8]; p.c_rpb = (const float*)d_in[9]; p.d_q_norm_g = (const float*)d_in[10]; p.d_kv_norm_g = (const float*)d_in[11];
  p.d_w_uq = (const float*)d_in[12]; p.d_w_ukv = (const float*)d_in[13]; p.w_out = (const float*)d_in[14]; p.ple_norm_g = (const float*)d_in[15];
  p.w_ple_gate = (const float*)d_in[16]; p.w_ple_proj = (const float*)d_in[17]; p.final_norm_g = (const float*)d_in[18];
  p.out = (float*)d_out;
  char* w = (char*)d_ws; size_t off = 0;
  auto carve = [&](size_t bytes) { char* r = w + off; off += (bytes + 255) & ~(size_t)255; return r; };
  p.hn = (bf16_t*)carve((size_t)NTOK * DM * 2);
  p.z = (bf16_t*)carve((size_t)NTOK * ZLD * 2);
  p.qd = (bf16_t*)carve((size_t)NTOK * 384 * 2);
  p.pb = (bf16_t*)carve((size_t)NTOK * 256 * 2);
  p.kvd = (bf16_t*)carve((size_t)NTOK * 512 * 2);
  p.winT = (bf16_t*)carve((size_t)2 * DINP * DM * 2);
  p.wuqT = (bf16_t*)carve((size_t)2 * 384 * 256 * 2);
  p.wukvT = (bf16_t*)carve((size_t)2 * 512 * 128 * 2);
  p.woutT = (bf16_t*)carve((size_t)2 * DM * DM * 2);
  p.wpgT = (bf16_t*)carve((size_t)2 * DM * DM * 2);
  p.wppT = (bf16_t*)carve((size_t)2 * DM * 256 * 2);
  p.cs32 = (float2*)carve((size_t)8192 * 16 * 8);
  p.cs64 = (float2*)carve((size_t)8192 * 32 * 8);
  p.lam = (float*)carve(256);
  p.bar = (unsigned*)carve((size_t)XCD_BAR_WORDS * 4);
  if (off > ws_size) { fprintf(stderr, "workspace too small: need %zu have %zu\n", off, ws_size); return; }
  static int grid_blocks = 0;
  if (!grid_blocks) {
    int dev = 0, cus = 0, per_cu = 0;
    hipGetDevice(&dev);
    hipDeviceGetAttribute(&cus, hipDeviceAttributeMultiprocessorCount, dev);
    hipOccupancyMaxActiveBlocksPerMultiprocessor(&per_cu, mega_fwd, NTHR, 0);
    if (per_cu > 1) per_cu = 1;
    if (per_cu < 1) per_cu = 1;
    grid_blocks = cus * per_cu;
  }
  void* args[] = {&p};
  hipError_t e = hipLaunchCooperativeKernel((void*)mega_fwd, dim3(grid_blocks), dim3(NTHR), args, 0, stream);
  if (e != hipSuccess) fprintf(stderr, "cooperative launch failed: %s (grid %d)\n", hipGetErrorString(e), grid_blocks);
}
```

```cpp
#include <hip/hip_runtime.h>
#include <hip/hip_cooperative_groups.h>
#include <stdint.h>
#include <stdio.h>
namespace cg = cooperative_groups;

typedef __attribute__((ext_vector_type(8))) short bf16x8;
typedef __attribute__((ext_vector_type(4))) short s16x4;
typedef __attribute__((ext_vector_type(16))) float f32x16;
typedef short v4i16_t __attribute__((ext_vector_type(4)));
typedef __bf16 bf16v2 __attribute__((ext_vector_type(2)));
typedef unsigned short bf16_t;
typedef unsigned u32x4 __attribute__((ext_vector_type(4)));
typedef float f32x2 __attribute__((ext_vector_type(2)));
typedef float f32x4 __attribute__((ext_vector_type(4)));
typedef __attribute__((address_space(3))) unsigned* lds_uptr;
typedef __attribute__((address_space(3))) const char* lds_cptr;

#define DI __device__ __forceinline__
#define MFMA(a, b, c) __builtin_amdgcn_mfma_f32_32x32x16_bf16((a), (b), (c), 0, 0, 0)

constexpr int NTOK = 81920, NPROMPT = 65536, DM = 1024, DIN = 3488, DINP = 3584, ZLD = 3488;
constexpr int Z_AQ = 0, Z_AK = 256, Z_AV = 512, Z_BQ = 768, Z_BK = 1024, Z_BV = 1152, Z_CQ = 1280, Z_CK = 1536, Z_CV = 1792,
              Z_DCQ = 2048, Z_DCKV = 2304, Z_DKR = 2432, Z_GATE = 2464;
constexpr float LOG2E = 1.4426950408889634f;
constexpr float SCALE_A = 0.17677669529663687f * LOG2E;
constexpr float SCALE_B = 0.125f * LOG2E;
constexpr float SCALE_C = 0.125f * LOG2E;
constexpr float SCALE_D = 0.10206207261596575f * LOG2E;
constexpr float EPS = 1e-6f;

constexpr int G_ROWB = 144;
constexpr int G_TILEB = 256 * G_ROWB;
constexpr int SM_RS = 4 * G_TILEB;
constexpr int SM_BIAS = 46080;
constexpr int SM_XB = SM_RS + 1024;
constexpr int SMEM_BYTES = SM_XB + 16;
constexpr int NTHR = 512;
#define XCD_BAR_WORDS 3456

struct Params {
  const float* x_prompt; const float* x_sample; const float* p_prompt; const float* p_sample;
  const float* norm_g; const float* w_in; const float* a_lambda; const float* a_subln_g; const float* b_sink; const float* c_rpb;
  const float* d_q_norm_g; const float* d_kv_norm_g; const float* d_w_uq; const float* d_w_ukv; const float* w_out; const float* ple_norm_g;
  const float* w_ple_gate; const float* w_ple_proj; const float* final_norm_g;
  float* out;
  bf16_t* hn;
  bf16_t* z;
  bf16_t* qd;
  bf16_t* pb;
  bf16_t* kvd;
  bf16_t* winT; bf16_t* wuqT; bf16_t* wukvT; bf16_t* woutT; bf16_t* wpgT; bf16_t* wppT;
  float2* cs32; float2* cs64; float* lam;
  unsigned* bar;
};

DI unsigned cvtpk(float lo, float hi) { bf16v2 v = {(__bf16)lo, (__bf16)hi}; return __builtin_bit_cast(unsigned, v); }
DI bf16_t f2bf(float x) { __bf16 b = (__bf16)x; return __builtin_bit_cast(bf16_t, b); }
DI float bf2f(unsigned v16) { return __uint_as_float(v16 << 16); }
DI float bflo(unsigned u) { return __uint_as_float(u << 16); }
DI float bfhi(unsigned u) { return __uint_as_float(u & 0xffff0000u); }
DI int otid() { int t = threadIdx.x; asm volatile("" : "+v"(t)); return t; }
DI int crow(int i, int h) { return (i & 3) + 8 * (i >> 2) + 4 * h; }
DI float ex2(float x) { return __builtin_amdgcn_exp2f(x); }
DI float sigm(float x) { return 1.f / (1.f + __expf(-x)); }
DI const float* xrow(const Params& p, int row) { return row < NPROMPT ? p.x_prompt + (size_t)row * DM : p.x_sample + (size_t)(row - NPROMPT) * DM; }
DI int pos_of(int row) { return row < NPROMPT ? (row & 8191) : (row & 4095); }
DI int pos_mask(int m0) { return m0 < NPROMPT ? 8191 : 4095; }
DI float swap_max(float m) { auto rr = __builtin_amdgcn_permlane32_swap(__float_as_uint(m), __float_as_uint(m), false, false); return fmaxf(__uint_as_float(rr[0]), __uint_as_float(rr[1])); }
DI float swap_sum(float m) { auto rr = __builtin_amdgcn_permlane32_swap(__float_as_uint(m), __float_as_uint(m), false, false); return __uint_as_float(rr[0]) + __uint_as_float(rr[1]); }
DI s16x4 vtr(const char* p) { return __builtin_bit_cast(s16x4, __builtin_amdgcn_ds_read_tr16_b64_v4i16((__attribute__((address_space(3))) v4i16_t*)(lds_cptr)p)); }

DI void transpose_tile(const float* __restrict__ W, int K, int N, bf16_t* __restrict__ WT, const float* __restrict__ gfold, int tile, char* smem) {
  const int kt = K >> 6;
  const int n0 = (tile / kt) * 64, k0 = (tile % kt) * 64;
  float* t = (float*)smem;
  const int tid = otid();
  __syncthreads();
  if (tid < 256) {
    const int nn = tid & 63, kb = tid >> 6;
#pragma unroll
    for (int i = 0; i < 16; ++i) {
      const int kk = kb + 4 * i;
      float v = 0.f;
      if (n0 + nn < N) { v = W[(size_t)(k0 + kk) * N + n0 + nn]; if (gfold) v *= gfold[k0 + kk]; }
      t[kk * 65 + nn] = v;
    }
  }
  __syncthreads();
  if (tid < 256) {
    const int nl = tid >> 2, kq = (tid & 3) * 16;
    unsigned u[8];
#pragma unroll
    for (int j = 0; j < 8; ++j) u[j] = cvtpk(t[(kq + 2 * j) * 65 + nl], t[(kq + 2 * j + 1) * 65 + nl]);
    uint4* dst = (uint4*)(WT + (size_t)(n0 + nl) * K + k0 + kq);
    dst[0] = make_uint4(u[0], u[1], u[2], u[3]);
    dst[1] = make_uint4(u[4], u[5], u[6], u[7]);
  }
}

DI void phase_prep(const Params& p, char* smem) {
  for (int v = blockIdx.x; v < 2 * 1512; v += gridDim.x) {
    const int layer = v / 1512; int t = v % 1512;
    if (t < 896) { transpose_tile(p.w_in + (size_t)layer * DM * DIN, DM, DIN, p.winT + (size_t)layer * DINP * DM, nullptr, t, smem); continue; }
    t -= 896;
    if (t < 24) { transpose_tile(p.d_w_uq + (size_t)layer * 256 * 384, 256, 384, p.wuqT + (size_t)layer * 384 * 256, p.d_q_norm_g + layer * 256, t, smem); continue; }
    t -= 24;
    if (t < 16) { transpose_tile(p.d_w_ukv + (size_t)layer * 128 * 512, 128, 512, p.wukvT + (size_t)layer * 512 * 128, p.d_kv_norm_g + layer * 128, t, smem); continue; }
    t -= 16;
    if (t < 256) { transpose_tile(p.w_out + (size_t)layer * DM * DM, DM, DM, p.woutT + (size_t)layer * DM * DM, nullptr, t, smem); continue; }
    t -= 256;
    if (t < 256) { transpose_tile(p.w_ple_gate + (size_t)layer * DM * DM, DM, DM, p.wpgT + (size_t)layer * DM * DM, nullptr, t, smem); continue; }
    t -= 256;
    transpose_tile(p.w_ple_proj + (size_t)layer * 256 * DM, 256, DM, p.wppT + (size_t)layer * DM * 256, nullptr, t, smem);
  }
  const int gt = blockIdx.x * NTHR + otid(), nt = gridDim.x * NTHR;
  for (int i = gt; i < XCD_BAR_WORDS; i += nt) p.bar[i] = 0u;
  for (int i = gt; i < 8192 * 48; i += nt) {
    int pos, f, dim; float2* dst;
    if (i < 8192 * 16) { pos = i >> 4; f = i & 15; dim = 32; dst = p.cs32 + i; }
    else { const int j = i - 8192 * 16; pos = j >> 5; f = j & 31; dim = 64; dst = p.cs64 + j; }
    const float inv = exp2f(-(float)(2 * f) / (float)dim * 13.287712379549449f);
    const double ang = (double)pos * (double)inv;
    double rev = ang * 0.15915494309189535;
    rev = rev - __builtin_rint(rev);
    const float fr = (float)rev;
    *dst = make_float2(__builtin_amdgcn_cosf(fr), __builtin_amdgcn_sinf(fr));
  }
  if (blockIdx.x == 0 && threadIdx.x < 2) {
    const int layer = threadIdx.x;
    const float* lv = p.a_lambda + layer * 128;
    float s1 = 0.f, s2 = 0.f;
    for (int i = 0; i < 32; ++i) { s1 += lv[i] * lv[32 + i]; s2 += lv[64 + i] * lv[96 + i]; }
    const float lam_init = 0.8f - 0.6f * expf(-0.3f * (float)layer);
    p.lam[layer] = expf(s1) - expf(s2) + lam_init;
  }
}

DI void phase_norm(const Params& p, int layer, int kind) {
  const int tid_ = otid(); const int lane = tid_ & 63, wave = __builtin_amdgcn_readfirstlane(tid_ >> 6);
  const float* g = kind == 0 ? p.norm_g + layer * DM : (kind == 1 ? p.ple_norm_g + layer * DM : p.final_norm_g);
  float4 g4[4];
#pragma unroll
  for (int j = 0; j < 4; ++j) g4[j] = ((const float4*)g)[lane + 64 * j];
  for (int row = blockIdx.x * 8 + wave; row < NTOK; row += gridDim.x * 8) {
    const float* src = (kind == 0 && layer == 0) ? xrow(p, row) : p.out + (size_t)row * DM;
    float4 v[4];
#pragma unroll
    for (int j = 0; j < 4; ++j) v[j] = ((const float4*)src)[lane + 64 * j];
    float ss = 0.f;
#pragma unroll
    for (int j = 0; j < 4; ++j) ss += v[j].x * v[j].x + v[j].y * v[j].y + v[j].z * v[j].z + v[j].w * v[j].w;
#pragma unroll
    for (int o = 32; o >= 1; o >>= 1) ss += __shfl_xor(ss, o);
    const float rs = rsqrtf(ss * (1.f / 1024.f) + EPS);
    if (kind == 2) {
      float4* dst = (float4*)(p.out + (size_t)row * DM);
#pragma unroll
      for (int j = 0; j < 4; ++j) dst[lane + 64 * j] = make_float4(v[j].x * rs * g4[j].x, v[j].y * rs * g4[j].y, v[j].z * rs * g4[j].z, v[j].w * rs * g4[j].w);
    } else {
      uint2* dst = (uint2*)(p.hn + (size_t)row * DM);
#pragma unroll
      for (int j = 0; j < 4; ++j) dst[lane + 64 * j] = make_uint2(cvtpk(v[j].x * rs * g4[j].x, v[j].y * rs * g4[j].y), cvtpk(v[j].z * rs * g4[j].z, v[j].w * rs * g4[j].w));
      if (kind == 0) {
        const float* ps = row < NPROMPT ? p.p_prompt + ((size_t)layer * NPROMPT + row) * 256 : p.p_sample + ((size_t)layer * (NTOK - NPROMPT) + (row - NPROMPT)) * 256;
        const float4 pv = ((const float4*)ps)[lane];
        ((uint2*)(p.pb + (size_t)row * 256))[lane] = make_uint2(cvtpk(pv.x, pv.y), cvtpk(pv.z, pv.w));
      }
    }
  }
}

DI void gemm_core(const bf16_t* __restrict__ A, int lda, const bf16_t* __restrict__ W, int ldw, int K, f32x16 (&acc)[4][2], char* smem) {
  const int tid = otid(), lane = tid & 63, wave = __builtin_amdgcn_readfirstlane(tid >> 6), wm = wave >> 2, wn = wave & 3, r = lane & 31, h = lane >> 5;
  const int lrow = tid >> 3, lcc = tid & 7;
  const char* ag = (const char*)(A + (size_t)lrow * lda + lcc * 8);
  const char* wg = (const char*)(W + (size_t)lrow * ldw + lcc * 8);
  const size_t astep = (size_t)64 * lda * 2, wstep = (size_t)64 * ldw * 2;
  char* As = smem; char* Bs = smem + 2 * G_TILEB;
  const int soff = lrow * G_ROWB + lcc * 16;
  u32x4 ra[4], rb[4];
#pragma unroll
  for (int i = 0; i < 4; ++i) { ra[i] = *(const u32x4*)(ag + i * astep); rb[i] = *(const u32x4*)(wg + i * wstep); }
#pragma unroll
  for (int i = 0; i < 4; ++i) { *(u32x4*)(As + soff + i * 64 * G_ROWB) = ra[i]; *(u32x4*)(Bs + soff + i * 64 * G_ROWB) = rb[i]; }
  __syncthreads();
  const int nk = K >> 6;
  const int aoff = (wm * 128 + r) * G_ROWB + h * 16;
  const int boff = (wn * 64 + r) * G_ROWB + h * 16;
#pragma unroll 1
  for (int kt = 0; kt < nk; ++kt) {
    const int cur = kt & 1;
    if (kt + 1 < nk) {
#pragma unroll
      for (int i = 0; i < 4; ++i) { ra[i] = *(const u32x4*)(ag + i * astep + (size_t)(kt + 1) * 128); rb[i] = *(const u32x4*)(wg + i * wstep + (size_t)(kt + 1) * 128); }
    }
    const char* Ac = As + cur * G_TILEB + aoff; const char* Bc = Bs + cur * G_TILEB + boff;
#pragma unroll
    for (int ks = 0; ks < 4; ++ks) {
      const bf16x8 b0 = *(const bf16x8*)(Bc + ks * 32), b1 = *(const bf16x8*)(Bc + 32 * G_ROWB + ks * 32);
#pragma unroll
      for (int ti = 0; ti < 4; ++ti) {
        const bf16x8 a = *(const bf16x8*)(Ac + ti * 32 * G_ROWB + ks * 32);
        acc[ti][0] = MFMA(b0, a, acc[ti][0]); acc[ti][1] = MFMA(b1, a, acc[ti][1]);
      }
    }
    if (kt + 1 < nk) {
      const int nb = cur ^ 1;
#pragma unroll
      for (int i = 0; i < 4; ++i) { *(u32x4*)(As + nb * G_TILEB + soff + i * 64 * G_ROWB) = ra[i]; *(u32x4*)(Bs + nb * G_TILEB + soff + i * 64 * G_ROWB) = rb[i]; }
    }
    __syncthreads();
  }
}

DI void zero_acc(f32x16 (&acc)[4][2]) {
#pragma unroll
  for (int a = 0; a < 4; ++a)
#pragma unroll
    for (int b = 0; b < 2; ++b) acc[a][b] = f32x16{};
}

DI uint2 pack4(float a, float b, float c, float d) { return make_uint2(cvtpk(a, b), cvtpk(c, d)); }
DI void rope_quad(const float2* cs, const f32x16& t1, const f32x16& t2, int q1, int q2, float sc, bf16_t* d1, bf16_t* d2) {
  const float4 c01 = ((const float4*)cs)[0], c23 = ((const float4*)cs)[1];
  const float c[4] = {c01.x, c01.z, c23.x, c23.z}, sn[4] = {c01.y, c01.w, c23.y, c23.w};
  float o1[4], o2[4];
#pragma unroll
  for (int j = 0; j < 4; ++j) {
    const float x1 = t1[q1 * 4 + j], x2 = t2[q2 * 4 + j];
    o1[j] = (x1 * c[j] - x2 * sn[j]) * sc; o2[j] = (x2 * c[j] + x1 * sn[j]) * sc;
  }
  *(uint2*)d1 = pack4(o1[0], o1[1], o1[2], o1[3]);
  *(uint2*)d2 = pack4(o2[0], o2[1], o2[2], o2[3]);
}

DI void g8_stage_rc(int b, int& R, int& C) {
  const int st = b / 1024, sb = b % 1024, swz = sb ^ (((sb >> 9) & 1) << 5);
  R = (st >> 1) * 16 + swz / 64; C = (st & 1) * 32 + (swz % 64) / 2;
}
#define G8_MFMA(a, b, c) __builtin_amdgcn_mfma_f32_16x16x32_bf16((a), (b), (c), 0, 0, 0)
template <bool STAGE0_ONLY>
DI void gemm8_impl(const bf16_t* __restrict__ P, int ldp, const bf16_t* __restrict__ Q, int ldq, int K, f32x4 (&acc)[2][2][4][2], char* smem, bool staged) {
  const int tid = otid(), lane = tid & 63, wid = __builtin_amdgcn_readfirstlane(tid >> 6), wr = wid >> 2, wc = wid & 3, fr = lane & 15, fq = lane >> 4;
  int r0, c0;
  g8_stage_rc(tid * 16, r0, c0);
  const unsigned pof = (unsigned)(r0 * ldp + c0) * 2u, qof = (unsigned)(r0 * ldq + c0) * 2u;
  const char* const Pb = (const char*)P; const char* const Qb = (const char*)Q;
  char* const sdst = smem + tid * 16;
  const int ob = fr * 64 + fq * 16, obs = ob ^ (((ob >> 9) & 1) << 5);
  const char* const ard = smem + wr * 8192 + obs;
  const char* const brd = smem + wc * 4096 + obs;
#define G8_SA(b, hh) (((b) * 2 + (hh)) * 16384)
#define G8_SB(b, hh) ((4 + (b) * 2 + (hh)) * 16384)
#define G8_STAGE_P(b, hh, kt) { const char* u_ = Pb + ((size_t)((hh) * 128) * ldp + (size_t)(kt) * 64) * 2;                \
    __builtin_amdgcn_global_load_lds((const unsigned*)(u_ + pof), (lds_uptr)(sdst + G8_SA(b, hh)), 16, 0, 0);               \
    __builtin_amdgcn_global_load_lds((const unsigned*)(u_ + (size_t)ldp * 128 + pof), (lds_uptr)(sdst + G8_SA(b, hh) + 8192), 16, 0, 0); }
#define G8_STAGE_Q(b, hh, kt) { const char* u_ = Qb + ((size_t)((hh) * 128) * ldq + (size_t)(kt) * 64) * 2;                \
    __builtin_amdgcn_global_load_lds((const unsigned*)(u_ + qof), (lds_uptr)(sdst + G8_SB(b, hh)), 16, 0, 0);               \
    __builtin_amdgcn_global_load_lds((const unsigned*)(u_ + (size_t)ldq * 128 + qof), (lds_uptr)(sdst + G8_SB(b, hh) + 8192), 16, 0, 0); }
#define G8_LDA(dst, b, hh) _Pragma("unroll") for (int m = 0; m < 4; ++m) _Pragma("unroll") for (int k = 0; k < 2; ++k) \
    dst[m][k] = *(const bf16x8*)(ard + G8_SA(b, hh) + m * 2048 + k * 1024)
#define G8_LDB(dst, b, hh) _Pragma("unroll") for (int n = 0; n < 2; ++n) _Pragma("unroll") for (int k = 0; k < 2; ++k) \
    dst[n][k] = *(const bf16x8*)(brd + G8_SB(b, hh) + n * 2048 + k * 1024)
#define G8_MMA(ai, bj, At_, Bt_) do { __builtin_amdgcn_s_setprio(1);                                                      \
    _Pragma("unroll") for (int m = 0; m < 4; ++m) _Pragma("unroll") for (int n = 0; n < 2; ++n) _Pragma("unroll") for (int k = 0; k < 2; ++k) \
      acc[ai][bj][m][n] = G8_MFMA(At_[m][k], Bt_[n][k], acc[ai][bj][m][n]);                                                \
    __builtin_amdgcn_s_setprio(0); } while (0)
#define G8_WAIT_V(n) asm volatile("s_waitcnt vmcnt(" #n ")" ::: "memory")
#define G8_WAIT_L(n) asm volatile("s_waitcnt lgkmcnt(" #n ")" ::: "memory")
#define G8_BAR __builtin_amdgcn_s_barrier()
#define G8_SCHED __builtin_amdgcn_sched_barrier(0)
  bf16x8 At[4][2], B0[2][2], B1[2][2];
  const int nt = K >> 6;
  if (STAGE0_ONLY) {
    G8_STAGE_Q(0, 0, 0); G8_STAGE_P(0, 0, 0);
    G8_STAGE_Q(0, 1, 0); G8_STAGE_P(0, 1, 0);
    return;
  }
  if (!staged) {
    __syncthreads();
    G8_STAGE_Q(0, 0, 0); G8_STAGE_P(0, 0, 0);
    G8_STAGE_Q(0, 1, 0); G8_STAGE_P(0, 1, 0);
  }
  if (wr == 1) G8_BAR;
  G8_WAIT_V(4); G8_BAR;
  G8_STAGE_Q(1, 0, 1); G8_STAGE_P(1, 0, 1); G8_STAGE_Q(1, 1, 1);
  G8_WAIT_V(6); G8_BAR;
#pragma unroll 1
  for (int t = 0; t < nt - 2; t += 2) {
    G8_LDB(B0, 0, 0); G8_SCHED; G8_LDA(At, 0, 0); G8_STAGE_P(1, 1, t + 1);
    G8_WAIT_L(8); G8_BAR; G8_WAIT_L(0); G8_MMA(0, 0, At, B0); G8_BAR; G8_SCHED;
    G8_LDB(B1, 0, 1); G8_STAGE_Q(0, 0, t + 2);
    G8_BAR; G8_WAIT_L(0); G8_MMA(0, 1, At, B1); G8_BAR;
    G8_LDA(At, 0, 1); G8_STAGE_P(0, 0, t + 2);
    G8_BAR; G8_WAIT_L(0); G8_MMA(1, 0, At, B0); G8_BAR; G8_SCHED;
    G8_STAGE_Q(0, 1, t + 2);
    G8_WAIT_V(6); G8_BAR; G8_MMA(1, 1, At, B1); G8_BAR;
    G8_LDB(B0, 1, 0); G8_SCHED; G8_LDA(At, 1, 0); G8_STAGE_P(0, 1, t + 2);
    G8_WAIT_L(8); G8_BAR; G8_WAIT_L(0); G8_MMA(0, 0, At, B0); G8_BAR; G8_SCHED;
    G8_LDB(B1, 1, 1); G8_STAGE_Q(1, 0, t + 3);
    G8_BAR; G8_WAIT_L(0); G8_MMA(0, 1, At, B1); G8_BAR;
    G8_LDA(At, 1, 1); G8_STAGE_P(1, 0, t + 3);
    G8_BAR; G8_WAIT_L(0); G8_MMA(1, 0, At, B0); G8_BAR; G8_SCHED;
    G8_STAGE_Q(1, 1, t + 3);
    G8_WAIT_V(6); G8_BAR; G8_MMA(1, 1, At, B1); G8_BAR;
  }
  { G8_LDB(B0, 0, 0); G8_LDA(At, 0, 0); G8_STAGE_P(1, 1, nt - 1);
    G8_BAR; G8_WAIT_L(0); G8_MMA(0, 0, At, B0); G8_BAR;
    G8_LDB(B1, 0, 1); G8_BAR; G8_WAIT_L(0); G8_MMA(0, 1, At, B1); G8_BAR;
    G8_LDA(At, 0, 1); G8_WAIT_V(4); G8_BAR; G8_WAIT_L(0); G8_MMA(1, 0, At, B0); G8_MMA(1, 1, At, B1); G8_BAR; }
  { G8_LDB(B0, 1, 0); G8_LDA(At, 1, 0); G8_WAIT_V(2); G8_BAR; G8_WAIT_L(0); G8_MMA(0, 0, At, B0); G8_BAR;
    G8_LDB(B1, 1, 1); G8_WAIT_V(0); G8_BAR; G8_WAIT_L(0); G8_MMA(0, 1, At, B1); G8_BAR;
    G8_LDA(At, 1, 1); G8_BAR; G8_WAIT_L(0); G8_MMA(1, 0, At, B0); G8_MMA(1, 1, At, B1); G8_BAR; }
  if (wr == 0) G8_BAR;
#undef G8_SA
#undef G8_SB
#undef G8_STAGE_P
#undef G8_STAGE_Q
#undef G8_LDA
#undef G8_LDB
#undef G8_MMA
#undef G8_WAIT_V
#undef G8_WAIT_L
#undef G8_BAR
#undef G8_SCHED
}

DI void gemm8(const bf16_t* P, int ldp, const bf16_t* Q, int ldq, int K, f32x4 (&acc)[2][2][4][2], char* smem, bool staged) {
  gemm8_impl<false>(P, ldp, Q, ldq, K, acc, smem, staged);
}
DI void gemm8_stage0(const bf16_t* P, int ldp, const bf16_t* Q, int ldq, f32x4 (&acc)[2][2][4][2], char* smem) {
  gemm8_impl<true>(P, ldp, Q, ldq, 256, acc, smem, false);
}
struct NextTile { const bf16_t* P; const bf16_t* Q; int ldp; int ldq; bool has; };
DI void zero_acc8(f32x4 (&acc)[2][2][4][2]) {
#pragma unroll
  for (int a = 0; a < 2; ++a)
#pragma unroll
    for (int b = 0; b < 2; ++b)
#pragma unroll
      for (int m = 0; m < 4; ++m)
#pragma unroll
        for (int n = 0; n < 2; ++n) acc[a][b][m][n] = f32x4{0.f, 0.f, 0.f, 0.f};
}
DI uint2 pack4v(f32x4 v, float sc) { return make_uint2(cvtpk(v[0] * sc, v[1] * sc), cvtpk(v[2] * sc, v[3] * sc)); }
DI void rope_quad4(const float2* cs, f32x4 x1, f32x4 x2, float sc, bf16_t* d1, bf16_t* d2) {
  const float4 c01 = ((const float4*)cs)[0], c23 = ((const float4*)cs)[1];
  const float c[4] = {c01.x, c01.z, c23.x, c23.z}, sn[4] = {c01.y, c01.w, c23.y, c23.w};
  float o1[4], o2[4];
#pragma unroll
  for (int j = 0; j < 4; ++j) { o1[j] = (x1[j] * c[j] - x2[j] * sn[j]) * sc; o2[j] = (x2[j] * c[j] + x1[j] * sn[j]) * sc; }
  *(uint2*)d1 = pack4(o1[0], o1[1], o1[2], o1[3]);
  *(uint2*)d2 = pack4(o2[0], o2[1], o2[2], o2[3]);
}

DI void inproj_tile(const Params& p, int layer, int tm, int tn, char* smem, bool staged, const NextTile& nx) {
  f32x4 acc[2][2][4][2]; zero_acc8(acc);
  const int m0 = tm * 256, n0 = tn * 256;
  gemm8(p.winT + ((size_t)layer * DINP + n0) * DM, DM, p.hn + (size_t)m0 * DM, DM, DM, acc, smem, staged);
  if (nx.has) gemm8_stage0(nx.P, nx.ldp, nx.Q, nx.ldq, acc, smem);
  const int tid_ = otid(); const int lane = tid_ & 63, wid = __builtin_amdgcn_readfirstlane(tid_ >> 6), wr = wid >> 2, wc = wid & 3, fr = lane & 15, fq = lane >> 4;
  const int pmask = pos_mask(m0);
#pragma unroll
  for (int bj = 0; bj < 2; ++bj)
#pragma unroll
    for (int n = 0; n < 2; ++n) {
      const int row = m0 + bj * 128 + wc * 32 + n * 16 + fr;
      const int pos = row & pmask;
      bf16_t* zrow = p.z + (size_t)row * ZLD;
#pragma unroll
      for (int ai = 0; ai < 2; ++ai) {
        const int fb = n0 + ai * 128 + wr * 64;
        if (fb >= Z_BQ && fb < Z_BV) {
          const float sc = fb < Z_BK ? SCALE_B : 1.f;
#pragma unroll
          for (int m = 0; m < 2; ++m) {
            const int f0 = m * 16 + fq * 4;
            rope_quad4(p.cs64 + pos * 32 + f0, acc[ai][bj][m][n], acc[ai][bj][m + 2][n], sc, zrow + fb + f0, zrow + fb + 32 + f0);
          }
        } else {
#pragma unroll
          for (int tj = 0; tj < 2; ++tj) {
            const int n32 = fb + tj * 32;
            if (n32 >= DIN) continue;
            const bool rope = (n32 < Z_AV) || (n32 == Z_DKR);
            const float sc = (n32 < Z_AK) ? SCALE_A : ((n32 >= Z_CQ && n32 < Z_CK) ? SCALE_C : 1.f);
            if (rope) {
              rope_quad4(p.cs32 + pos * 16 + fq * 4, acc[ai][bj][2 * tj][n], acc[ai][bj][2 * tj + 1][n], sc, zrow + n32 + fq * 4, zrow + n32 + 16 + fq * 4);
            } else {
              *(uint2*)(zrow + n32 + fq * 4) = pack4v(acc[ai][bj][2 * tj][n], sc);
              *(uint2*)(zrow + n32 + 16 + fq * 4) = pack4v(acc[ai][bj][2 * tj + 1][n], sc);
            }
          }
        }
      }
    }
}

DI void tile_rs(const bf16_t* A, int lda, int K, float* rsv) {
  const int t = otid();
  const uint4* src = (const uint4*)(A + (size_t)(t >> 1) * lda + (t & 1) * (K >> 1));
  float ss = 0.f;
  for (int c = 0; c < (K >> 4); ++c) {
    const uint4 u = src[c];
    ss += bflo(u.x) * bflo(u.x) + bfhi(u.x) * bfhi(u.x) + bflo(u.y) * bflo(u.y) + bfhi(u.y) * bfhi(u.y)
        + bflo(u.z) * bflo(u.z) + bfhi(u.z) * bfhi(u.z) + bflo(u.w) * bflo(u.w) + bfhi(u.w) * bfhi(u.w);
  }
  ss += __shfl_xor(ss, 1);
  if ((t & 1) == 0) rsv[t >> 1] = rsqrtf(ss / (float)K + EPS);
}

DI void upproj_tile(const Params& p, int layer, int tm, int sel, char* smem) {
  const int m0 = tm * 256;
  const int pmask = pos_mask(m0);
  float* rsv = (float*)(smem + SM_RS);
  const int tid_ = otid(); const int lane = tid_ & 63, wave = __builtin_amdgcn_readfirstlane(tid_ >> 6), wm = wave >> 2, wn = wave & 3, r = lane & 31, h = lane >> 5;
  f32x16 acc[4][2]; zero_acc(acc);
  __syncthreads();
  if (sel < 2) {
    const int n0 = sel * 256;
    const bf16_t* A = p.z + (size_t)m0 * ZLD + Z_DCQ;
    tile_rs(A, ZLD, 256, rsv);
    gemm_core(A, ZLD, p.wuqT + ((size_t)layer * 384 + n0) * 256, 256, 256, acc, smem);
#pragma unroll
    for (int ti = 0; ti < 4; ++ti) {
      const int rl = wm * 128 + ti * 32 + r, row = m0 + rl;
      const float rsc = rsv[rl] * SCALE_D;
      bf16_t* qrow = p.qd + (size_t)row * 384;
#pragma unroll
      for (int tj = 0; tj < 2; ++tj) {
        const int n = n0 + wn * 64 + tj * 32;
        if (n >= 384) continue;
        if ((n % 96) == 64) {
#pragma unroll
          for (int g = 0; g < 2; ++g) {
            const int f0 = 8 * g + 4 * h;
            rope_quad(p.cs32 + (row & pmask) * 16 + f0, acc[ti][tj], acc[ti][tj], g, g + 2, rsc, qrow + n + f0, qrow + n + 16 + f0);
          }
        } else {
#pragma unroll
          for (int g = 0; g < 4; ++g)
            *(uint2*)(qrow + n + 8 * g + 4 * h) = pack4(acc[ti][tj][4 * g] * rsc, acc[ti][tj][4 * g + 1] * rsc, acc[ti][tj][4 * g + 2] * rsc, acc[ti][tj][4 * g + 3] * rsc);
        }
      }
    }
  } else {
    const int n0 = (sel - 2) * 256;
    const bf16_t* A = p.z + (size_t)m0 * ZLD + Z_DCKV;
    tile_rs(A, ZLD, 128, rsv);
    gemm_core(A, ZLD, p.wukvT + ((size_t)layer * 512 + n0) * 128, 128, 128, acc, smem);
#pragma unroll
    for (int ti = 0; ti < 4; ++ti) {
      const int rl = wm * 128 + ti * 32 + r, row = m0 + rl;
      const float rsc = rsv[rl];
      bf16_t* krow = p.kvd + (size_t)row * 512 + n0 + wn * 64;
#pragma unroll
      for (int tj = 0; tj < 2; ++tj)
#pragma unroll
        for (int g = 0; g < 4; ++g)
          *(uint2*)(krow + tj * 32 + 8 * g + 4 * h) = pack4(acc[ti][tj][4 * g] * rsc, acc[ti][tj][4 * g + 1] * rsc, acc[ti][tj][4 * g + 2] * rsc, acc[ti][tj][4 * g + 3] * rsc);
    }
  }
}

DI void outproj_tile(const Params& p, int layer, int tm, int tn, char* smem, bool staged, const NextTile& nx) {
  f32x4 acc[2][2][4][2]; zero_acc8(acc);
  const int m0 = tm * 256, n0 = tn * 256;
  gemm8(p.woutT + ((size_t)layer * DM + n0) * DM, DM, p.hn + (size_t)m0 * DM, DM, DM, acc, smem, staged);
  if (nx.has) gemm8_stage0(nx.P, nx.ldp, nx.Q, nx.ldq, acc, smem);
  const int tid_ = otid(); const int lane = tid_ & 63, wid = __builtin_amdgcn_readfirstlane(tid_ >> 6), wr = wid >> 2, wc = wid & 3, fr = lane & 15, fq = lane >> 4;
#pragma unroll
  for (int bj = 0; bj < 2; ++bj)
#pragma unroll
    for (int n = 0; n < 2; ++n) {
      const int row = m0 + bj * 128 + wc * 32 + n * 16 + fr;
      const float* hrow = (layer == 0 ? xrow(p, row) : p.out + (size_t)row * DM) + n0 + wr * 64 + fq * 4;
      float* orow = p.out + (size_t)row * DM + n0 + wr * 64 + fq * 4;
#pragma unroll
      for (int ai = 0; ai < 2; ++ai)
#pragma unroll
        for (int m = 0; m < 4; ++m) {
          const float4 hv = *(const float4*)(hrow + ai * 128 + m * 16);
          const f32x4 a = acc[ai][bj][m][n];
          *(float4*)(orow + ai * 128 + m * 16) = make_float4(hv.x + a[0], hv.y + a[1], hv.z + a[2], hv.w + a[3]);
        }
    }
}

DI void pproj_tile(const Params& p, int layer, int tm, int tn, char* smem, bool staged, const NextTile& nx) {
  f32x4 acc[2][2][4][2]; zero_acc8(acc);
  const int m0 = tm * 256, n0 = tn * 256;
  gemm8(p.wppT + ((size_t)layer * DM + n0) * 256, 256, p.pb + (size_t)m0 * 256, 256, 256, acc, smem, staged);
  if (nx.has) gemm8_stage0(nx.P, nx.ldp, nx.Q, nx.ldq, acc, smem);
  const int tid_ = otid(); const int lane = tid_ & 63, wid = __builtin_amdgcn_readfirstlane(tid_ >> 6), wr = wid >> 2, wc = wid & 3, fr = lane & 15, fq = lane >> 4;
#pragma unroll
  for (int bj = 0; bj < 2; ++bj)
#pragma unroll
    for (int n = 0; n < 2; ++n) {
      const int row = m0 + bj * 128 + wc * 32 + n * 16 + fr;
      bf16_t* prow = p.z + (size_t)row * DM + n0 + wr * 64 + fq * 4;
#pragma unroll
      for (int ai = 0; ai < 2; ++ai)
#pragma unroll
        for (int m = 0; m < 4; ++m) *(uint2*)(prow + ai * 128 + m * 16) = pack4v(acc[ai][bj][m][n], 1.f);
    }
}

DI void ple_tile(const Params& p, int layer, int tm, int tn, char* smem, bool staged, const NextTile& nx) {
  f32x4 acc[2][2][4][2]; zero_acc8(acc);
  const int m0 = tm * 256, n0 = tn * 256;
  gemm8(p.wpgT + ((size_t)layer * DM + n0) * DM, DM, p.hn + (size_t)m0 * DM, DM, DM, acc, smem, staged);
  if (nx.has) gemm8_stage0(nx.P, nx.ldp, nx.Q, nx.ldq, acc, smem);
  const int tid_ = otid(); const int lane = tid_ & 63, wid = __builtin_amdgcn_readfirstlane(tid_ >> 6), wr = wid >> 2, wc = wid & 3, fr = lane & 15, fq = lane >> 4;
#pragma unroll
  for (int bj = 0; bj < 2; ++bj)
#pragma unroll
    for (int n = 0; n < 2; ++n) {
      const int row = m0 + bj * 128 + wc * 32 + n * 16 + fr;
      float* orow = p.out + (size_t)row * DM + n0 + wr * 64 + fq * 4;
      const bf16_t* prow = p.z + (size_t)row * DM + n0 + wr * 64 + fq * 4;
#pragma unroll
      for (int ai = 0; ai < 2; ++ai)
#pragma unroll
        for (int m = 0; m < 4; ++m) {
          const float4 ov = *(const float4*)(orow + ai * 128 + m * 16);
          const uint2 pu = *(const uint2*)(prow + ai * 128 + m * 16);
          const f32x4 a = acc[ai][bj][m][n];
          *(float4*)(orow + ai * 128 + m * 16) = make_float4(ov.x + sigm(a[0]) * bflo(pu.x), ov.y + sigm(a[1]) * bfhi(pu.x),
                                                            ov.z + sigm(a[2]) * bflo(pu.y), ov.w + sigm(a[3]) * bfhi(pu.y));
        }
    }
}

template <int MODE>
DI void attn_item(const Params& p, int layer, int v, char* smem) {
  constexpr int NMAPS = (MODE == 0) ? 2 : 1;
  constexpr int KS = (MODE == 0) ? 2 : ((MODE == 3) ? 6 : 4);
  constexpr int DK = (MODE == 3) ? 96 : 64;
  constexpr int KSTR = (DK + 8) * 2;
  constexpr int VSTR = 144;
  constexpr int KBUF = 64 * KSTR;
  constexpr int BUFB = KBUF + 64 * VSTR;
  constexpr bool LAZY = (MODE == 0 || MODE == 3);
  const int tid = otid(), lane = tid & 63, wave = __builtin_amdgcn_readfirstlane(tid >> 6), r = lane & 31, h = lane >> 5;
  int seq, head, qt, S, row0;
  if (v < 1024) {
    const int b = v & 255, k = v >> 8, x = b & 7, j = b >> 3, pr = x + 8 * k;
    seq = pr >> 2; head = pr & 3; qt = j; S = 8192; row0 = seq * 8192;
  } else {
    const int b = v - 1024, x = b & 7, j = b >> 3, pr = x + 8 * (j >> 4);
    seq = pr >> 2; head = pr & 3; qt = j & 15; S = 4096; row0 = NPROMPT + seq * 4096;
  }
  const int q0 = qt * 256, nkt = S >> 6;
  int kt_lo = 0, kt_hi = nkt, cR = 0, clo = 0;
  if (MODE == 1) { kt_lo = max(0, 4 * qt - 2); kt_hi = min(nkt, 4 * qt + 6); }
  if (MODE == 2) {
    const int R0 = 4 * qt;
    kt_lo = min(max(R0 - 4, 0), nkt - 8); kt_hi = min(max(R0 - 1, 0), nkt - 8) + 8;
    cR = R0 + (wave >> 1); clo = min(max(cR - 4, 0), nkt - 8);
  }
  const bf16_t *qp, *kp, *vp; int ldq, ldk, ldv;
  if (MODE == 0) { qp = p.z + Z_AQ + head * 64; kp = p.z + Z_AK + head * 64; vp = p.z + Z_AV + head * 64; ldq = ldk = ldv = ZLD; }
  else if (MODE == 1) { qp = p.z + Z_BQ + head * 64; kp = p.z + Z_BK + (head >> 1) * 64; vp = p.z + Z_BV + (head >> 1) * 64; ldq = ldk = ldv = ZLD; }
  else if (MODE == 2) { qp = p.z + Z_CQ + head * 64; kp = p.z + Z_CK + head * 64; vp = p.z + Z_CV + head * 64; ldq = ldk = ldv = ZLD; }
  else { qp = p.qd + head * 96; ldq = 384; kp = p.kvd + head * 128; vp = p.kvd + head * 128 + 64; ldk = ldv = 512; }

  float* bias = (float*)(smem + SM_BIAS);
  if (MODE == 2) {
    const float* rp = p.c_rpb + (size_t)(layer * 4 + head) * 465;
    for (int i = tid; i < 465; i += NTHR) bias[i] = rp[i] * LOG2E;
  }

  bf16x8 qf[NMAPS][KS];
  {
    const bf16_t* qrow = qp + (size_t)(row0 + q0 + wave * 32 + r) * ldq + 8 * h;
#pragma unroll
    for (int m = 0; m < NMAPS; ++m)
#pragma unroll
      for (int ks = 0; ks < KS; ++ks) qf[m][ks] = *(const bf16x8*)(qrow + (m * KS + ks) * 16);
  }
  float mrun[NMAPS], lrun[NMAPS];
  f32x16 o[NMAPS][2];
  f32x16 negm[NMAPS];
  bool zref[NMAPS];
#pragma unroll
  for (int m = 0; m < NMAPS; ++m) { mrun[m] = LAZY ? 0.f : -1e30f; lrun[m] = 0.f; o[m][0] = f32x16{}; o[m][1] = f32x16{}; negm[m] = f32x16{}; zref[m] = true; }
  if (MODE == 1) { mrun[0] = p.b_sink[layer * 4 + head] * LOG2E; lrun[0] = (h == 0) ? 1.f : 0.f; }

  const int lrow = tid >> 3, lcc = tid & 7;
  const bf16_t* kg = kp + (size_t)(row0 + lrow) * ldk + lcc * 8;
  const bf16_t* vg = vp + (size_t)(row0 + lrow) * ldv + lcc * 8;
  const bf16_t* k2g = p.z + (size_t)(row0 + ((tid & 255) >> 2)) * ZLD + Z_DKR + (tid & 3) * 8;
  u32x4 kr0, vr0, k2r = u32x4{};
#define ATT_LOAD(kt_)                                                                              \
  {                                                                                                \
    const size_t ro_ = (size_t)(kt_) * 64;                                                         \
    kr0 = *(const u32x4*)(kg + ro_ * ldk);                                                         \
    vr0 = *(const u32x4*)(vg + ro_ * ldv);                                                         \
    if (MODE == 3) { if (tid < 256) k2r = *(const u32x4*)(k2g + ro_ * ZLD); }                      \
  }
#define ATT_STORE(buf_)                                                                            \
  {                                                                                                \
    char* kb_ = smem + (buf_) * BUFB;                                                              \
    *(u32x4*)(kb_ + lrow * KSTR + lcc * 16) = kr0;                                                 \
    *(u32x4*)(kb_ + KBUF + lrow * VSTR + lcc * 16) = vr0;                                          \
    if (MODE == 3) { if (tid < 256) *(u32x4*)(kb_ + (tid >> 2) * KSTR + 128 + (tid & 3) * 16) = k2r; } \
  }
  ATT_LOAD(kt_lo);
  ATT_STORE(0);
  __syncthreads();

  const int i16 = lane & 15;
  const int voff = (4 * h + (i16 >> 2)) * VSTR + (((lane >> 4) & 1) * 16 + (i16 & 3) * 4) * 2;
  const int qi = q0 + wave * 32 + r;
  const int cc = (wave & 1) * 32 + r;
  const int ccs = min(max(cc - 8, 0), 48);

  if (wave >= 4) __builtin_amdgcn_s_setprio(1);
#pragma unroll 1
  for (int kt = kt_lo; kt < kt_hi; ++kt) {
    const int cur = (kt - kt_lo) & 1;
    if (kt + 1 < kt_hi) ATT_LOAD(kt + 1);
    const bool active = (MODE == 2) ? (kt >= clo && kt < clo + 8)
                      : ((MODE == 1) ? (kt * 64 + 63 >= q0 + wave * 32 - 128 && kt * 64 <= q0 + wave * 32 + 31 + 128) : true);
    if (active) {
      const char* kb = smem + cur * BUFB;
      const char* vb = kb + KBUF;
      bf16x8 pf[NMAPS][2][2];
#pragma unroll
      for (int m = 0; m < NMAPS; ++m) {
        f32x16 st[2];
        auto qk_chain = [&](const bool use_ref) {
#pragma unroll
          for (int sub = 0; sub < 2; ++sub) {
            f32x16 s;
            if (use_ref) s = negm[m]; else s = f32x16{};
#pragma unroll
            for (int ks = 0; ks < KS; ++ks) {
              const bf16x8 kf = *(const bf16x8*)(kb + (sub * 32 + r) * KSTR + ((m * KS + ks) * 16 + 8 * h) * 2);
              s = MFMA(kf, qf[m][ks], s);
            }
            st[sub] = s;
          }
        };
        if (LAZY && !zref[m]) qk_chain(true); else qk_chain(false);
        if (MODE == 1) {
          int tb = kt * 64 + 4 * h - qi + 128;
          asm volatile("" : "+v"(tb));
#pragma unroll
          for (int sub = 0; sub < 2; ++sub)
#pragma unroll
            for (int i = 0; i < 16; ++i) {
              const int c0 = sub * 32 + (i & 3) + 8 * (i >> 2);
              if ((unsigned)(tb + c0) > 256u) st[sub][i] = -INFINITY;
            }
        }
        if (MODE == 2) {
          int tcc = 4 * h - cc + 15 + (kt - cR + 7) * 31, tcs = 4 * h - ccs;
          asm volatile("" : "+v"(tcc), "+v"(tcs));
#pragma unroll
          for (int sub = 0; sub < 2; ++sub)
#pragma unroll
            for (int i = 0; i < 16; ++i) {
              const int c0 = sub * 32 + (i & 3) + 8 * (i >> 2);
              const bool valid = (unsigned)(c0 + tcs) < 16u;
              const int idx = valid ? tcc + c0 : 0;
              const float bv = bias[idx];
              st[sub][i] = valid ? st[sub][i] + bv : -INFINITY;
            }
        }
        auto tile_max = [&]() {
          float mx_ = fmaxf(fmaxf(st[0][0], st[0][1]), st[1][0]);
          float mb_ = fmaxf(fmaxf(st[0][2], st[0][3]), st[1][1]);
          mx_ = fmaxf(fmaxf(mx_, st[1][2]), st[1][3]);
#pragma unroll
          for (int i = 4; i < 16; i += 4) {
            mx_ = fmaxf(fmaxf(mx_, st[0][i]), st[0][i + 1]); mb_ = fmaxf(fmaxf(mb_, st[0][i + 2]), st[0][i + 3]);
            mx_ = fmaxf(fmaxf(mx_, st[1][i]), st[1][i + 1]); mb_ = fmaxf(fmaxf(mb_, st[1][i + 2]), st[1][i + 3]);
          }
          return swap_max(fmaxf(mx_, mb_));
        };
        float mx = 0.f;
        if (!LAZY) mx = tile_max();
        if (LAZY) {
          int ia = max(max(__float_as_int(st[0][0]), __float_as_int(st[0][1])), __float_as_int(st[1][0]));
          int ib = max(max(__float_as_int(st[0][2]), __float_as_int(st[0][3])), __float_as_int(st[1][1]));
          ia = max(max(ia, __float_as_int(st[1][2])), __float_as_int(st[1][3]));
#pragma unroll
          for (int i = 4; i < 16; i += 4) {
            ia = max(max(ia, __float_as_int(st[0][i])), __float_as_int(st[0][i + 1])); ib = max(max(ib, __float_as_int(st[0][i + 2])), __float_as_int(st[0][i + 3]));
            ia = max(max(ia, __float_as_int(st[1][i])), __float_as_int(st[1][i + 1])); ib = max(max(ib, __float_as_int(st[1][i + 2])), __float_as_int(st[1][i + 3]));
          }
          ia = max(ia, ib);
          const bool first = (kt == kt_lo);
          bool need = __builtin_amdgcn_ballot_w64(ia > 0x41000000) != 0;
          if (first) { mx = tile_max(); need = need || (__builtin_amdgcn_ballot_w64(mx < -8.f) != 0); }
          if (need) {
            if (!first) mx = tile_max();
            zref[m] = false;
            const float delta = first ? mx : fmaxf(mx, 0.f);
            const float alpha = first ? 1.f : ex2(-delta);
            mrun[m] += delta;
            lrun[m] *= alpha;
#pragma unroll
            for (int i = 0; i < 16; ++i) { o[m][0][i] *= alpha; o[m][1][i] *= alpha; st[0][i] -= delta; st[1][i] -= delta; }
            const float nm = -mrun[m];
#pragma unroll
            for (int i = 0; i < 16; ++i) negm[m][i] = nm;
          }
          f32x2 l2[4] = {{0.f, 0.f}, {0.f, 0.f}, {0.f, 0.f}, {0.f, 0.f}};
#pragma unroll
          for (int sub = 0; sub < 2; ++sub)
#pragma unroll
            for (int i = 0; i < 16; i += 2) {
              const float p0 = ex2(st[sub][i]), p1 = ex2(st[sub][i + 1]);
              st[sub][i] = p0; st[sub][i + 1] = p1;
              l2[(i >> 1) & 3] += f32x2{p0, p1};
            }
          const f32x2 lt = (l2[0] + l2[1]) + (l2[2] + l2[3]);
          lrun[m] += lt[0] + lt[1];
        } else {
          const float mnew = fmaxf(mrun[m], mx);
          const float alpha = ex2(mrun[m] - mnew);
          mrun[m] = mnew;
          float ls = 0.f;
#pragma unroll
          for (int sub = 0; sub < 2; ++sub)
#pragma unroll
            for (int i = 0; i < 16; ++i) { const float pv = ex2(st[sub][i] - mnew); ls += pv; st[sub][i] = pv; }
          lrun[m] = lrun[m] * alpha + ls;
#pragma unroll
          for (int i = 0; i < 16; ++i) { o[m][0][i] *= alpha; o[m][1][i] *= alpha; }
        }
#pragma unroll
        for (int sub = 0; sub < 2; ++sub)
#pragma unroll
          for (int kk = 0; kk < 2; ++kk) {
            const uint4 u = make_uint4(cvtpk(st[sub][8 * kk + 0], st[sub][8 * kk + 1]), cvtpk(st[sub][8 * kk + 2], st[sub][8 * kk + 3]),
                                       cvtpk(st[sub][8 * kk + 4], st[sub][8 * kk + 5]), cvtpk(st[sub][8 * kk + 6], st[sub][8 * kk + 7]));
            pf[m][sub][kk] = __builtin_bit_cast(bf16x8, u);
          }
      }
#pragma unroll
      for (int sub = 0; sub < 2; ++sub)
#pragma unroll
        for (int kk = 0; kk < 2; ++kk)
#pragma unroll
          for (int dvt = 0; dvt < 2; ++dvt) {
            const char* va = vb + voff + (sub * 32 + kk * 16) * VSTR + dvt * 64;
            const s16x4 lo = vtr(va), hi = vtr(va + 8 * VSTR);
            const bf16x8 vf = __builtin_shufflevector(lo, hi, 0, 1, 2, 3, 4, 5, 6, 7);
#pragma unroll
            for (int m = 0; m < NMAPS; ++m) o[m][dvt] = MFMA(vf, pf[m][sub][kk], o[m][dvt]);
          }
    }
    if (kt + 1 < kt_hi) ATT_STORE(cur ^ 1);
    __syncthreads();
  }
  if (wave >= 4) __builtin_amdgcn_s_setprio(0);
#undef ATT_LOAD
#undef ATT_STORE

  float inv[NMAPS];
#pragma unroll
  for (int m = 0; m < NMAPS; ++m) inv[m] = 1.f / swap_sum(lrun[m]);
  f32x16 res[2];
  if (MODE == 0) {
    const float lam = p.lam[layer];
    const float lam_init = 0.8f - 0.6f * __expf(-0.3f * (float)layer);
    float ss = 0.f;
#pragma unroll
    for (int dvt = 0; dvt < 2; ++dvt)
#pragma unroll
      for (int i = 0; i < 16; ++i) { const float t = o[0][dvt][i] * inv[0] - lam * (o[NMAPS - 1][dvt][i] * inv[NMAPS - 1]); res[dvt][i] = t; ss += t * t; }
    ss = swap_sum(ss);
    const float rs = rsqrtf(ss * (1.f / 64.f) + EPS) * (1.f - lam_init);
    const float* sg = p.a_subln_g + layer * 64;
#pragma unroll
    for (int dvt = 0; dvt < 2; ++dvt)
#pragma unroll
      for (int i = 0; i < 16; ++i) res[dvt][i] *= rs * sg[dvt * 32 + crow(i, h)];
  } else {
#pragma unroll
    for (int dvt = 0; dvt < 2; ++dvt)
#pragma unroll
      for (int i = 0; i < 16; ++i) res[dvt][i] = o[0][dvt][i] * inv[0];
  }
  {
    const size_t row = (size_t)(row0 + qi);
    const bf16_t* gp = p.z + row * ZLD + Z_GATE + MODE * 256 + head * 64;
    bf16_t* mp = p.hn + row * DM + MODE * 256 + head * 64;
#pragma unroll
    for (int dvt = 0; dvt < 2; ++dvt)
#pragma unroll
      for (int ig = 0; ig < 4; ++ig) {
        const int dv0 = dvt * 32 + ig * 8 + 4 * h;
        const uint2 gu = *(const uint2*)(gp + dv0);
        const float g0 = bflo(gu.x), g1 = bfhi(gu.x), g2 = bflo(gu.y), g3 = bfhi(gu.y);
        const float a0 = res[dvt][ig * 4 + 0] * g0 * sigm(g0), a1 = res[dvt][ig * 4 + 1] * g1 * sigm(g1);
        const float a2 = res[dvt][ig * 4 + 2] * g2 * sigm(g2), a3 = res[dvt][ig * 4 + 3] * g3 * sigm(g3);
        *(uint2*)(mp + dv0) = make_uint2(cvtpk(a0, a1), cvtpk(a2, a3));
      }
  }
}

#define XB_TMO      128
#define XB_XCNT(j)  (256  + 64 * (j))
#define XB_XSUB(j)  (1280 + 64 * (j))
#define XB_XGEN(j)  (2304 + 64 * (j))
#define XB_TOP      3328
#define XB_TOPGEN   3392
#define XB_SPIN_CAP (1u << 18)
#define LAS __attribute__((address_space(3)))
DI unsigned xb_ld(unsigned* p) { return __hip_atomic_load(p, __ATOMIC_RELAXED, __HIP_MEMORY_SCOPE_AGENT); }
DI unsigned xb_add(unsigned* p, unsigned v) { return __hip_atomic_fetch_add(p, v, __ATOMIC_RELAXED, __HIP_MEMORY_SCOPE_AGENT); }
DI unsigned xb_xcc_id() { return (unsigned)__builtin_amdgcn_s_getreg((3 << 11) | 20) & 0xFu; }
#define XB_SPIN(cond, bar) do { unsigned _sp = 0; while (cond) { __builtin_amdgcn_s_sleep(1); \
    if ((++_sp & 255u) == 0u) { if (xb_ld(&(bar)[XB_TMO])) break; if (_sp > XB_SPIN_CAP) { atomicAdd(&(bar)[XB_TMO], 1u); break; } } } } while (0)
struct XcdBarrier { unsigned* bar; unsigned x; volatile LAS unsigned* st; };
DI XcdBarrier xcd_barrier_post(unsigned* bar, volatile LAS unsigned* st) {
  XcdBarrier b; b.bar = bar; b.x = xb_xcc_id(); b.st = st;
  if (threadIdx.x == 0) (void)xb_add(&bar[XB_XCNT(b.x)], 1u);
  return b;
}
DI void xcd_barrier_complete(unsigned* bar, unsigned x, unsigned& nloc, unsigned& nx) {
  const unsigned G = gridDim.x * gridDim.y * gridDim.z;
  unsigned sum, cnt, mine, sp = 0u;
  for (;;) {
    sum = 0u; cnt = 0u; mine = 0u;
#pragma unroll
    for (unsigned j = 0; j < 16; ++j) { const unsigned c = xb_ld(&bar[XB_XCNT(j)]); sum += c; cnt += (c > 0u) ? 1u : 0u; mine = (j == x) ? c : mine; }
    if (sum == G) break;
    __builtin_amdgcn_s_sleep(1);
    if ((++sp & 255u) == 0u) { if (xb_ld(&bar[XB_TMO])) break; if (sp > XB_SPIN_CAP) { atomicAdd(&bar[XB_TMO], 1u); break; } }
  }
  nloc = mine > 0u ? mine : 1u; nx = cnt > 0u ? cnt : 1u;
}
DI void xcd_barrier(const XcdBarrier& b) {
  asm volatile("s_waitcnt vmcnt(0)" ::: "memory");
  __syncthreads();
  if (threadIdx.x == 0) {
    unsigned* bar = b.bar;
    __builtin_amdgcn_s_waitcnt(0);
    unsigned nloc = b.st[0], nx = b.st[1];
    if (nloc == 0u) { xcd_barrier_complete(bar, b.x, nloc, nx); b.st[0] = nloc; b.st[1] = nx; }
    const unsigned old = xb_add(&bar[XB_XSUB(b.x)], 1u);
    const unsigned gen = old / nloc;
    if (old + 1u == (gen + 1u) * nloc) {
      __builtin_amdgcn_fence(__ATOMIC_RELEASE, "agent");
      asm volatile("s_waitcnt vmcnt(0)" ::: "memory");
      const unsigned og = xb_add(&bar[XB_TOP], 1u);
      const unsigned tg = og / nx;
      if (og + 1u == (tg + 1u) * nx) xb_add(&bar[XB_TOPGEN], 1u);
      else XB_SPIN(xb_ld(&bar[XB_TOPGEN]) == tg, bar);
      __builtin_amdgcn_fence(__ATOMIC_ACQUIRE, "agent");
      xb_add(&bar[XB_XGEN(b.x)], 1u);
      asm volatile("s_waitcnt vmcnt(0)" ::: "memory");
    } else {
      XB_SPIN(xb_ld(&bar[XB_XGEN(b.x)]) == gen, bar);
      __builtin_amdgcn_fence(__ATOMIC_ACQUIRE, "agent");
      asm volatile("s_waitcnt vmcnt(0)" ::: "memory");
    }
  }
  __syncthreads();
}

__global__ void __launch_bounds__(512, 2) mega_fwd(Params p) {
  __shared__ __attribute__((aligned(16))) char smem[SMEM_BYTES];
  cg::grid_group grid = cg::this_grid();
  const int nb = gridDim.x;

  if (threadIdx.x < 4) ((unsigned*)(smem + SM_XB))[threadIdx.x] = 0u;
  phase_prep(p, smem);
  phase_norm(p, 0, 0);
  grid.sync();
  const XcdBarrier xb = xcd_barrier_post(p.bar, (volatile LAS unsigned*)(lds_cptr)(smem + SM_XB));
#pragma unroll 1
  for (int layer = 0; layer < 2; ++layer) {
    if (layer > 0) { phase_norm(p, layer, 0); xcd_barrier(xb); }
    {
      bool staged = false;
      for (int v = blockIdx.x; v < 18 * 256; v += nb) {
        const int b = v & 255, k = v >> 8, x = b & 7, j = b >> 3, st = k * 8 + x;
        if (st >= 140) continue;
        const int tm = (st / 7) * 16 + (j >> 1), tn = (st % 7) * 2 + (j & 1);
        NextTile nx;
        {
          const int v2 = v + nb, b2 = v2 & 255, k2 = v2 >> 8, st2 = k2 * 8 + (b2 & 7), j2 = b2 >> 3;
          nx.has = (v2 < 18 * 256) && (st2 < 140);
          const int tm2 = (st2 / 7) * 16 + (j2 >> 1), tn2 = (st2 % 7) * 2 + (j2 & 1);
          nx.P = p.winT + ((size_t)layer * DINP + tn2 * 256) * DM; nx.Q = p.hn + (size_t)tm2 * 256 * DM; nx.ldp = DM; nx.ldq = DM;
        }
        inproj_tile(p, layer, tm, tn, smem, staged, nx);
        staged = nx.has;
      }
    }
    xcd_barrier(xb);
    for (int v = blockIdx.x; v < 1280 + 1280 + 1280 + 1280; v += nb) {
      if (v < 1280) attn_item<0>(p, layer, v, smem);
      else if (v < 2560) { const int u = v - 1280; upproj_tile(p, layer, u >> 2, u & 3, smem); }
      else if (v < 3840) attn_item<1>(p, layer, v - 2560, smem);
      else attn_item<2>(p, layer, v - 3840, smem);
    }
    xcd_barrier(xb);
    for (int v = blockIdx.x; v < 1280; v += nb) attn_item<3>(p, layer, v, smem);
    xcd_barrier(xb);
    {
      bool staged = false;
      for (int v = blockIdx.x; v < 2560; v += nb) {
        const int vv = v < 1280 ? v : v - 1280;
        const int b = vv & 255, k = vv >> 8, x = b & 7, j = b >> 3, st = k * 8 + x;
        NextTile nx;
        {
          const int v2 = v + nb, vv2 = v2 < 1280 ? v2 : v2 - 1280;
          const int b2 = vv2 & 255, st2 = (vv2 >> 8) * 8 + (b2 & 7), j2 = b2 >> 3, tm2 = st2 * 8 + (j2 >> 2), tn2 = j2 & 3;
          nx.has = v2 < 2560;
          if (v2 < 1280) { nx.P = p.woutT + ((size_t)layer * DM + tn2 * 256) * DM; nx.Q = p.hn + (size_t)tm2 * 256 * DM; nx.ldp = DM; nx.ldq = DM; }
          else { nx.P = p.wppT + ((size_t)layer * DM + tn2 * 256) * 256; nx.Q = p.pb + (size_t)tm2 * 256 * 256; nx.ldp = 256; nx.ldq = 256; }
        }
        if (v < 1280) outproj_tile(p, layer, st * 8 + (j >> 2), j & 3, smem, staged, nx);
        else pproj_tile(p, layer, st * 8 + (j >> 2), j & 3, smem, staged, nx);
        staged = nx.has;
      }
    }
    xcd_barrier(xb);
    phase_norm(p, layer, 1);
    xcd_barrier(xb);
    {
      bool staged = false;
      for (int v = blockIdx.x; v < 1280; v += nb) {
        const int b = v & 255, k = v >> 8, x = b & 7, j = b >> 3, st = k * 8 + x;
        NextTile nx;
        {
          const int v2 = v + nb, b2 = v2 & 255, st2 = (v2 >> 8) * 8 + (b2 & 7), j2 = b2 >> 3, tm2 = st2 * 8 + (j2 >> 2), tn2 = j2 & 3;
          nx.has = v2 < 1280;
          nx.P = p.wpgT + ((size_t)layer * DM + tn2 * 256) * DM; nx.Q = p.hn + (size_t)tm2 * 256 * DM; nx.ldp = DM; nx.ldq = DM;
        }
        ple_tile(p, layer, st * 8 + (j >> 2), j & 3, smem, staged, nx);
        staged = nx.has;
      }
    }
    xcd_barrier(xb);
  }
  phase_norm(p, 0, 2);
}

extern "C" void kernel_launch(void* const* d_in, const int* in_sizes, int n_in, void* d_out, int out_size, void* d_ws, size_t ws_size,
                              hipStream_t stream) {
  Params p{};
  p.x_prompt = (const float*)d_in[0]; p.x_sample = (const float*)d_in[1]; p.p_prompt = (const float*)d_in[2]; p.p_sample = (const float*)d_in[3];
  p.norm_g = (const float*)d_in[4]; p.w_in = (const float*)d_in[5]; p.a_lambda = (const float*)d_in[6]; p.a_subln_g = (const float*)d_in[7];
  p.b_sink = (const float*)d_in[8]; p.c_rpb = (const float*)d_in[9]; p.d_q_norm_g = (const float*)d_in[10]; p.d_kv_norm_g = (const float*)d_in[11];
  p.d_w_uq = (const float*)d_in[12]; p.d_w_ukv = (const float*)d_in[13]; p.w_out = (const float*)d_in[14]; p.ple_norm_g = (const float*)d_in[15];
  p.w_ple_gate = (const float*)d_in[16]; p.w_ple_proj = (const float*)d_in[17]; p.final_norm_g = (const float*)d_in[18];
  p.out = (float*)d_out;
  char* w = (char*)d_ws; size_t off = 0;
  auto carve = [&](size_t bytes) { char* r = w + off; off += (bytes + 255) & ~(size_t)255; return r; };
  p.hn = (bf16_t*)carve((size_t)NTOK * DM * 2);
  p.z = (bf16_t*)carve((size_t)NTOK * ZLD * 2);
  p.qd = (bf16_t*)carve((size_t)NTOK * 384 * 2);
  p.pb = (bf16_t*)carve((size_t)NTOK * 256 * 2);
  p.kvd = (bf16_t*)carve((size_t)NTOK * 512 * 2);
  p.winT = (bf16_t*)carve((size_t)2 * DINP * DM * 2);
  p.wuqT = (bf16_t*)carve((size_t)2 * 384 * 256 * 2);
  p.wukvT = (bf16_t*)carve((size_t)2 * 512 * 128 * 2);
  p.woutT = (bf16_t*)carve((size_t)2 * DM * DM * 2);
  p.wpgT = (bf16_t*)carve((size_t)2 * DM * DM * 2);
  p.wppT = (bf16_t*)carve((size_t)2 * DM * 256 * 2);
  p.cs32 = (float2*)carve((size_t)8192 * 16 * 8);
  p.cs64 = (float2*)carve((size_t)8192 * 32 * 8);
  p.lam = (float*)carve(256);
  p.bar = (unsigned*)carve((size_t)XCD_BAR_WORDS * 4);
  if (off > ws_size) { fprintf(stderr, "workspace too small: need %zu have %zu\n", off, ws_size); return; }
  static int grid_blocks = 0;
  if (!grid_blocks) {
    int dev = 0, cus = 0, per_cu = 0;
    hipGetDevice(&dev);
    hipDeviceGetAttribute(&cus, hipDeviceAttributeMultiprocessorCount, dev);
    hipOccupancyMaxActiveBlocksPerMultiprocessor(&per_cu, mega_fwd, NTHR, 0);
    if (per_cu > 1) per_cu = 1;
    if (per_cu < 1) per_cu = 1;
    grid_blocks = cus * per_cu;
  }
  void* args[] = {&p};
  hipError_t e = hipLaunchCooperativeKernel((void*)mega_fwd, dim3(grid_blocks), dim3(NTHR), args, 0, stream);
  if (e != hipSuccess) fprintf(stderr, "cooperative launch failed: %s (grid %d)\n", hipGetErrorString(e), grid_blocks);
}
```

```cpp
#include <hip/hip_runtime.h>
#include <hip/hip_cooperative_groups.h>
#include <stdint.h>
#include <stdio.h>
namespace cg = cooperative_groups;

typedef __attribute__((ext_vector_type(8))) short bf16x8;
typedef __attribute__((ext_vector_type(4))) short s16x4;
typedef __attribute__((ext_vector_type(16))) float f32x16;
typedef short v4i16_t __attribute__((ext_vector_type(4)));
typedef __bf16 bf16v2 __attribute__((ext_vector_type(2)));
typedef unsigned short bf16_t;
typedef unsigned u32x4 __attribute__((ext_vector_type(4)));
typedef float f32x2 __attribute__((ext_vector_type(2)));
typedef float f32x4 __attribute__((ext_vector_type(4)));
typedef __attribute__((address_space(3))) unsigned* lds_uptr;
typedef __attribute__((address_space(3))) const char* lds_cptr;

#define DI __device__ __forceinline__
#define MFMA(a, b, c) __builtin_amdgcn_mfma_f32_32x32x16_bf16((a), (b), (c), 0, 0, 0)

constexpr int NTOK = 81920, NPROMPT = 65536, DM = 1024, DIN = 3488, DINP = 3584, ZLD = 3488;
constexpr int Z_AQ = 0, Z_AK = 256, Z_AV = 512, Z_BQ = 768, Z_BK = 1024, Z_BV = 1152, Z_CQ = 1280, Z_CK = 1536, Z_CV = 1792,
              Z_DCQ = 2048, Z_DCKV = 2304, Z_DKR = 2432, Z_GATE = 2464;
constexpr float LOG2E = 1.4426950408889634f;
constexpr float SCALE_A = 0.17677669529663687f * LOG2E;
constexpr float SCALE_B = 0.125f * LOG2E;
constexpr float SCALE_C = 0.125f * LOG2E;
constexpr float SCALE_D = 0.10206207261596575f * LOG2E;
constexpr float EPS = 1e-6f;

constexpr int G_ROWB = 144;
constexpr int G_TILEB = 256 * G_ROWB;
constexpr int SM_RS = 4 * G_TILEB;
constexpr int SM_BIAS = 46080;
constexpr int SM_XB = SM_RS + 1024;
constexpr int SMEM_BYTES = SM_XB + 16;
constexpr int NTHR = 512;
#define XCD_BAR_WORDS 3456

struct Params {
  const float* x_prompt; const float* x_sample; const float* p_prompt; const float* p_sample;
  const float* norm_g; const float* w_in; const float* a_lambda; const float* a_subln_g; const float* b_sink; const float* c_rpb;
  const float* d_q_norm_g; const float* d_kv_norm_g; const float* d_w_uq; const float* d_w_ukv; const float* w_out; const float* ple_norm_g;
  const float* w_ple_gate; const float* w_ple_proj; const float* final_norm_g;
  float* out;
  bf16_t* hn;
  bf16_t* z;
  bf16_t* qd;
  bf16_t* pb;
  bf16_t* kvd;
  bf16_t* winT; bf16_t* wuqT; bf16_t* wukvT; bf16_t* woutT; bf16_t* wpgT; bf16_t* wppT;
  float2* cs32; float2* cs64; float* lam;
  unsigned* xpart;
  unsigned* xcnt;
  unsigned* bar;
};

DI unsigned cvtpk(float lo, float hi) { bf16v2 v = {(__bf16)lo, (__bf16)hi}; return __builtin_bit_cast(unsigned, v); }
DI bf16_t f2bf(float x) { __bf16 b = (__bf16)x; return __builtin_bit_cast(bf16_t, b); }
DI float bf2f(unsigned v16) { return __uint_as_float(v16 << 16); }
DI float bflo(unsigned u) { return __uint_as_float(u << 16); }
DI float bfhi(unsigned u) { return __uint_as_float(u & 0xffff0000u); }
DI int otid() { int t = threadIdx.x; asm volatile("" : "+v"(t)); return t; }
DI int crow(int i, int h) { return (i & 3) + 8 * (i >> 2) + 4 * h; }
DI float ex2(float x) { return __builtin_amdgcn_exp2f(x); }
DI float sigm(float x) { return 1.f / (1.f + __expf(-x)); }
DI const float* xrow(const Params& p, int row) { return row < NPROMPT ? p.x_prompt + (size_t)row * DM : p.x_sample + (size_t)(row - NPROMPT) * DM; }
DI int pos_of(int row) { return row < NPROMPT ? (row & 8191) : (row & 4095); }
DI int pos_mask(int m0) { return m0 < NPROMPT ? 8191 : 4095; }
DI float swap_max(float m) { auto rr = __builtin_amdgcn_permlane32_swap(__float_as_uint(m), __float_as_uint(m), false, false); return fmaxf(__uint_as_float(rr[0]), __uint_as_float(rr[1])); }
DI float swap_sum(float m) { auto rr = __builtin_amdgcn_permlane32_swap(__float_as_uint(m), __float_as_uint(m), false, false); return __uint_as_float(rr[0]) + __uint_as_float(rr[1]); }
DI s16x4 vtr(const char* p) { return __builtin_bit_cast(s16x4, __builtin_amdgcn_ds_read_tr16_b64_v4i16((__attribute__((address_space(3))) v4i16_t*)(lds_cptr)p)); }

DI void transpose_tile(const float* __restrict__ W, int K, int N, bf16_t* __restrict__ WT, const float* __restrict__ gfold, int tile, char* smem) {
  const int kt = K >> 6;
  const int n0 = (tile / kt) * 64, k0 = (tile % kt) * 64;
  float* t = (float*)smem;
  const int tid = otid();
  __syncthreads();
  if (tid < 256) {
    const int nn = tid & 63, kb = tid >> 6;
#pragma unroll
    for (int i = 0; i < 16; ++i) {
      const int kk = kb + 4 * i;
      float v = 0.f;
      if (n0 + nn < N) { v = W[(size_t)(k0 + kk) * N + n0 + nn]; if (gfold) v *= gfold[k0 + kk]; }
      t[kk * 65 + nn] = v;
    }
  }
  __syncthreads();
  if (tid < 256) {
    const int nl = tid >> 2, kq = (tid & 3) * 16;
    unsigned u[8];
#pragma unroll
    for (int j = 0; j < 8; ++j) u[j] = cvtpk(t[(kq + 2 * j) * 65 + nl], t[(kq + 2 * j + 1) * 65 + nl]);
    uint4* dst = (uint4*)(WT + (size_t)(n0 + nl) * K + k0 + kq);
    dst[0] = make_uint4(u[0], u[1], u[2], u[3]);
    dst[1] = make_uint4(u[4], u[5], u[6], u[7]);
  }
}

DI void phase_prep(const Params& p, char* smem) {
  for (int v = blockIdx.x; v < 2 * 1512; v += gridDim.x) {
    const int layer = v / 1512; int t = v % 1512;
    if (t < 896) { transpose_tile(p.w_in + (size_t)layer * DM * DIN, DM, DIN, p.winT + (size_t)layer * DINP * DM, nullptr, t, smem); continue; }
    t -= 896;
    if (t < 24) { transpose_tile(p.d_w_uq + (size_t)layer * 256 * 384, 256, 384, p.wuqT + (size_t)layer * 384 * 256, p.d_q_norm_g + layer * 256, t, smem); continue; }
    t -= 24;
    if (t < 16) { transpose_tile(p.d_w_ukv + (size_t)layer * 128 * 512, 128, 512, p.wukvT + (size_t)layer * 512 * 128, p.d_kv_norm_g + layer * 128, t, smem); continue; }
    t -= 16;
    if (t < 256) { transpose_tile(p.w_out + (size_t)layer * DM * DM, DM, DM, p.woutT + (size_t)layer * DM * DM, nullptr, t, smem); continue; }
    t -= 256;
    if (t < 256) { transpose_tile(p.w_ple_gate + (size_t)layer * DM * DM, DM, DM, p.wpgT + (size_t)layer * DM * DM, nullptr, t, smem); continue; }
    t -= 256;
    transpose_tile(p.w_ple_proj + (size_t)layer * 256 * DM, 256, DM, p.wppT + (size_t)layer * DM * 256, nullptr, t, smem);
  }
  const int gt = blockIdx.x * NTHR + otid(), nt = gridDim.x * NTHR;
  for (int i = gt; i < XCD_BAR_WORDS; i += nt) p.bar[i] = 0u;
  for (int i = gt; i < 4 * 320; i += nt) p.xcnt[i] = 0u;
  for (int i = gt; i < 8192 * 48; i += nt) {
    int pos, f, dim; float2* dst;
    if (i < 8192 * 16) { pos = i >> 4; f = i & 15; dim = 32; dst = p.cs32 + i; }
    else { const int j = i - 8192 * 16; pos = j >> 5; f = j & 31; dim = 64; dst = p.cs64 + j; }
    const float inv = exp2f(-(float)(2 * f) / (float)dim * 13.287712379549449f);
    const double ang = (double)pos * (double)inv;
    double rev = ang * 0.15915494309189535;
    rev = rev - __builtin_rint(rev);
    const float fr = (float)rev;
    *dst = make_float2(__builtin_amdgcn_cosf(fr), __builtin_amdgcn_sinf(fr));
  }
  if (blockIdx.x == 0 && threadIdx.x < 2) {
    const int layer = threadIdx.x;
    const float* lv = p.a_lambda + layer * 128;
    float s1 = 0.f, s2 = 0.f;
    for (int i = 0; i < 32; ++i) { s1 += lv[i] * lv[32 + i]; s2 += lv[64 + i] * lv[96 + i]; }
    const float lam_init = 0.8f - 0.6f * expf(-0.3f * (float)layer);
    p.lam[layer] = expf(s1) - expf(s2) + lam_init;
  }
}

DI void phase_norm(const Params& p, int layer, int kind) {
  const int tid_ = otid(); const int lane = tid_ & 63, wave = __builtin_amdgcn_readfirstlane(tid_ >> 6);
  const float* g = kind == 0 ? p.norm_g + layer * DM : (kind == 1 ? p.ple_norm_g + layer * DM : p.final_norm_g);
  float4 g4[4];
#pragma unroll
  for (int j = 0; j < 4; ++j) g4[j] = ((const float4*)g)[lane + 64 * j];
  for (int row = blockIdx.x * 8 + wave; row < NTOK; row += gridDim.x * 8) {
    const float* src = (kind == 0 && layer == 0) ? xrow(p, row) : p.out + (size_t)row * DM;
    float4 v[4];
#pragma unroll
    for (int j = 0; j < 4; ++j) v[j] = ((const float4*)src)[lane + 64 * j];
    float ss = 0.f;
#pragma unroll
    for (int j = 0; j < 4; ++j) ss += v[j].x * v[j].x + v[j].y * v[j].y + v[j].z * v[j].z + v[j].w * v[j].w;
#pragma unroll
    for (int o = 32; o >= 1; o >>= 1) ss += __shfl_xor(ss, o);
    const float rs = rsqrtf(ss * (1.f / 1024.f) + EPS);
    if (kind == 2) {
      float4* dst = (float4*)(p.out + (size_t)row * DM);
#pragma unroll
      for (int j = 0; j < 4; ++j) dst[lane + 64 * j] = make_float4(v[j].x * rs * g4[j].x, v[j].y * rs * g4[j].y, v[j].z * rs * g4[j].z, v[j].w * rs * g4[j].w);
    } else {
      uint2* dst = (uint2*)(p.hn + (size_t)row * DM);
#pragma unroll
      for (int j = 0; j < 4; ++j) dst[lane + 64 * j] = make_uint2(cvtpk(v[j].x * rs * g4[j].x, v[j].y * rs * g4[j].y), cvtpk(v[j].z * rs * g4[j].z, v[j].w * rs * g4[j].w));
      if (kind == 0) {
#pragma unroll
        for (int l = 0; l < 2; ++l) {
          const float* ps = row < NPROMPT ? p.p_prompt + ((size_t)l * NPROMPT + row) * 256 : p.p_sample + ((size_t)l * (NTOK - NPROMPT) + (row - NPROMPT)) * 256;
          const float4 pv = ((const float4*)ps)[lane];
          ((uint2*)(p.pb + ((size_t)l * NTOK + row) * 256))[lane] = make_uint2(cvtpk(pv.x, pv.y), cvtpk(pv.z, pv.w));
        }
      }
    }
  }
}

DI void gemm_core(const bf16_t* __restrict__ A, int lda, const bf16_t* __restrict__ W, int ldw, int K, f32x16 (&acc)[4][2], char* smem) {
  const int tid = otid(), lane = tid & 63, wave = __builtin_amdgcn_readfirstlane(tid >> 6), wm = wave >> 2, wn = wave & 3, r = lane & 31, h = lane >> 5;
  const int lrow = tid >> 3, lcc = tid & 7;
  const char* ag = (const char*)(A + (size_t)lrow * lda + lcc * 8);
  const char* wg = (const char*)(W + (size_t)lrow * ldw + lcc * 8);
  const size_t astep = (size_t)64 * lda * 2, wstep = (size_t)64 * ldw * 2;
  char* As = smem; char* Bs = smem + 2 * G_TILEB;
  const int soff = lrow * G_ROWB + lcc * 16;
  u32x4 ra[4], rb[4];
#pragma unroll
  for (int i = 0; i < 4; ++i) { ra[i] = *(const u32x4*)(ag + i * astep); rb[i] = *(const u32x4*)(wg + i * wstep); }
#pragma unroll
  for (int i = 0; i < 4; ++i) { *(u32x4*)(As + soff + i * 64 * G_ROWB) = ra[i]; *(u32x4*)(Bs + soff + i * 64 * G_ROWB) = rb[i]; }
  __syncthreads();
  const int nk = K >> 6;
  const int aoff = (wm * 128 + r) * G_ROWB + h * 16;
  const int boff = (wn * 64 + r) * G_ROWB + h * 16;
#pragma unroll 1
  for (int kt = 0; kt < nk; ++kt) {
    const int cur = kt & 1;
    if (kt + 1 < nk) {
#pragma unroll
      for (int i = 0; i < 4; ++i) { ra[i] = *(const u32x4*)(ag + i * astep + (size_t)(kt + 1) * 128); rb[i] = *(const u32x4*)(wg + i * wstep + (size_t)(kt + 1) * 128); }
    }
    const char* Ac = As + cur * G_TILEB + aoff; const char* Bc = Bs + cur * G_TILEB + boff;
#pragma unroll
    for (int ks = 0; ks < 4; ++ks) {
      const bf16x8 b0 = *(const bf16x8*)(Bc + ks * 32), b1 = *(const bf16x8*)(Bc + 32 * G_ROWB + ks * 32);
#pragma unroll
      for (int ti = 0; ti < 4; ++ti) {
        const bf16x8 a = *(const bf16x8*)(Ac + ti * 32 * G_ROWB + ks * 32);
        acc[ti][0] = MFMA(b0, a, acc[ti][0]); acc[ti][1] = MFMA(b1, a, acc[ti][1]);
      }
    }
    if (kt + 1 < nk) {
      const int nb = cur ^ 1;
#pragma unroll
      for (int i = 0; i < 4; ++i) { *(u32x4*)(As + nb * G_TILEB + soff + i * 64 * G_ROWB) = ra[i]; *(u32x4*)(Bs + nb * G_TILEB + soff + i * 64 * G_ROWB) = rb[i]; }
    }
    __syncthreads();
  }
}

DI void zero_acc(f32x16 (&acc)[4][2]) {
#pragma unroll
  for (int a = 0; a < 4; ++a)
#pragma unroll
    for (int b = 0; b < 2; ++b) acc[a][b] = f32x16{};
}

DI uint2 pack4(float a, float b, float c, float d) { return make_uint2(cvtpk(a, b), cvtpk(c, d)); }
DI void rope_quad(const float2* cs, const f32x16& t1, const f32x16& t2, int q1, int q2, float sc, bf16_t* d1, bf16_t* d2) {
  const float4 c01 = ((const float4*)cs)[0], c23 = ((const float4*)cs)[1];
  const float c[4] = {c01.x, c01.z, c23.x, c23.z}, sn[4] = {c01.y, c01.w, c23.y, c23.w};
  float o1[4], o2[4];
#pragma unroll
  for (int j = 0; j < 4; ++j) {
    const float x1 = t1[q1 * 4 + j], x2 = t2[q2 * 4 + j];
    o1[j] = (x1 * c[j] - x2 * sn[j]) * sc; o2[j] = (x2 * c[j] + x1 * sn[j]) * sc;
  }
  *(uint2*)d1 = pack4(o1[0], o1[1], o1[2], o1[3]);
  *(uint2*)d2 = pack4(o2[0], o2[1], o2[2], o2[3]);
}

DI void g8_stage_rc(int b, int& R, int& C) {
  const int st = b / 1024, sb = b % 1024, swz = sb ^ (((sb >> 9) & 1) << 5);
  R = (st >> 1) * 16 + swz / 64; C = (st & 1) * 32 + (swz % 64) / 2;
}
#define G8_MFMA(a, b, c) __builtin_amdgcn_mfma_f32_16x16x32_bf16((a), (b), (c), 0, 0, 0)
template <bool STAGE0_ONLY>
DI void gemm8_impl(const bf16_t* __restrict__ P, int ldp, const bf16_t* __restrict__ Q, int ldq, int K, f32x4 (&acc)[2][2][4][2], char* smem, bool staged) {
  const int tid = otid(), lane = tid & 63, wid = __builtin_amdgcn_readfirstlane(tid >> 6), wr = wid >> 2, wc = wid & 3, fr = lane & 15, fq = lane >> 4;
  int r0, c0;
  g8_stage_rc(tid * 16, r0, c0);
  const unsigned pof = (unsigned)(r0 * ldp + c0) * 2u, qof = (unsigned)(r0 * ldq + c0) * 2u;
  const char* const Pb = (const char*)P; const char* const Qb = (const char*)Q;
  char* const sdst = smem + tid * 16;
  const int ob = fr * 64 + fq * 16, obs = ob ^ (((ob >> 9) & 1) << 5);
  const char* const ard = smem + wr * 8192 + obs;
  const char* const brd = smem + wc * 4096 + obs;
#define G8_SA(b, hh) (((b) * 2 + (hh)) * 16384)
#define G8_SB(b, hh) ((4 + (b) * 2 + (hh)) * 16384)
#define G8_STAGE_P(b, hh, kt) { const char* u_ = Pb + ((size_t)((hh) * 128) * ldp + (size_t)(kt) * 64) * 2;                \
    __builtin_amdgcn_global_load_lds((const unsigned*)(u_ + pof), (lds_uptr)(sdst + G8_SA(b, hh)), 16, 0, 0);               \
    __builtin_amdgcn_global_load_lds((const unsigned*)(u_ + (size_t)ldp * 128 + pof), (lds_uptr)(sdst + G8_SA(b, hh) + 8192), 16, 0, 0); }
#define G8_STAGE_Q(b, hh, kt) { const char* u_ = Qb + ((size_t)((hh) * 128) * ldq + (size_t)(kt) * 64) * 2;                \
    __builtin_amdgcn_global_load_lds((const unsigned*)(u_ + qof), (lds_uptr)(sdst + G8_SB(b, hh)), 16, 0, 0);               \
    __builtin_amdgcn_global_load_lds((const unsigned*)(u_ + (size_t)ldq * 128 + qof), (lds_uptr)(sdst + G8_SB(b, hh) + 8192), 16, 0, 0); }
#define G8_LDA(dst, b, hh) _Pragma("unroll") for (int m = 0; m < 4; ++m) _Pragma("unroll") for (int k = 0; k < 2; ++k) \
    dst[m][k] = *(const bf16x8*)(ard + G8_SA(b, hh) + m * 2048 + k * 1024)
#define G8_LDB(dst, b, hh) _Pragma("unroll") for (int n = 0; n < 2; ++n) _Pragma("unroll") for (int k = 0; k < 2; ++k) \
    dst[n][k] = *(const bf16x8*)(brd + G8_SB(b, hh) + n * 2048 + k * 1024)
#define G8_MMA(ai, bj, At_, Bt_) do { __builtin_amdgcn_s_setprio(1);                                                      \
    _Pragma("unroll") for (int m = 0; m < 4; ++m) _Pragma("unroll") for (int n = 0; n < 2; ++n) _Pragma("unroll") for (int k = 0; k < 2; ++k) \
      acc[ai][bj][m][n] = G8_MFMA(At_[m][k], Bt_[n][k], acc[ai][bj][m][n]);                                                \
    __builtin_amdgcn_s_setprio(0); } while (0)
#define G8_WAIT_V(n) asm volatile("s_waitcnt vmcnt(" #n ")" ::: "memory")
#define G8_WAIT_L(n) asm volatile("s_waitcnt lgkmcnt(" #n ")" ::: "memory")
#define G8_BAR __builtin_amdgcn_s_barrier()
#define G8_SCHED __builtin_amdgcn_sched_barrier(0)
  bf16x8 At[4][2], B0[2][2], B1[2][2];
  const int nt = K >> 6;
  if (STAGE0_ONLY) {
    G8_STAGE_Q(0, 0, 0); G8_STAGE_P(0, 0, 0);
    G8_STAGE_Q(0, 1, 0); G8_STAGE_P(0, 1, 0);
    return;
  }
  if (!staged) {
    __syncthreads();
    G8_STAGE_Q(0, 0, 0); G8_STAGE_P(0, 0, 0);
    G8_STAGE_Q(0, 1, 0); G8_STAGE_P(0, 1, 0);
  }
  if (wr == 1) G8_BAR;
  G8_WAIT_V(4); G8_BAR;
  G8_STAGE_Q(1, 0, 1); G8_STAGE_P(1, 0, 1); G8_STAGE_Q(1, 1, 1);
  G8_WAIT_V(6); G8_BAR;
#pragma unroll 1
  for (int t = 0; t < nt - 2; t += 2) {
    G8_LDB(B0, 0, 0); G8_SCHED; G8_LDA(At, 0, 0); G8_STAGE_P(1, 1, t + 1);
    G8_WAIT_L(8); G8_BAR; G8_WAIT_L(0); G8_MMA(0, 0, At, B0); G8_BAR; G8_SCHED;
    G8_LDB(B1, 0, 1); G8_STAGE_Q(0, 0, t + 2);
    G8_BAR; G8_WAIT_L(0); G8_MMA(0, 1, At, B1); G8_BAR;
    G8_LDA(At, 0, 1); G8_STAGE_P(0, 0, t + 2);
    G8_BAR; G8_WAIT_L(0); G8_MMA(1, 0, At, B0); G8_BAR; G8_SCHED;
    G8_STAGE_Q(0, 1, t + 2);
    G8_WAIT_V(6); G8_BAR; G8_MMA(1, 1, At, B1); G8_BAR;
    G8_LDB(B0, 1, 0); G8_SCHED; G8_LDA(At, 1, 0); G8_STAGE_P(0, 1, t + 2);
    G8_WAIT_L(8); G8_BAR; G8_WAIT_L(0); G8_MMA(0, 0, At, B0); G8_BAR; G8_SCHED;
    G8_LDB(B1, 1, 1); G8_STAGE_Q(1, 0, t + 3);
    G8_BAR; G8_WAIT_L(0); G8_MMA(0, 1, At, B1); G8_BAR;
    G8_LDA(At, 1, 1); G8_STAGE_P(1, 0, t + 3);
    G8_BAR; G8_WAIT_L(0); G8_MMA(1, 0, At, B0); G8_BAR; G8_SCHED;
    G8_STAGE_Q(1, 1, t + 3);
    G8_WAIT_V(6); G8_BAR; G8_MMA(1, 1, At, B1); G8_BAR;
  }
  { G8_LDB(B0, 0, 0); G8_LDA(At, 0, 0); G8_STAGE_P(1, 1, nt - 1);
    G8_BAR; G8_WAIT_L(0); G8_MMA(0, 0, At, B0); G8_BAR;
    G8_LDB(B1, 0, 1); G8_BAR; G8_WAIT_L(0); G8_MMA(0, 1, At, B1); G8_BAR;
    G8_LDA(At, 0, 1); G8_WAIT_V(4); G8_BAR; G8_WAIT_L(0); G8_MMA(1, 0, At, B0); G8_MMA(1, 1, At, B1); G8_BAR; }
  { G8_LDB(B0, 1, 0); G8_LDA(At, 1, 0); G8_WAIT_V(2); G8_BAR; G8_WAIT_L(0); G8_MMA(0, 0, At, B0); G8_BAR;
    G8_LDB(B1, 1, 1); G8_WAIT_V(0); G8_BAR; G8_WAIT_L(0); G8_MMA(0, 1, At, B1); G8_BAR;
    G8_LDA(At, 1, 1); G8_BAR; G8_WAIT_L(0); G8_MMA(1, 0, At, B0); G8_MMA(1, 1, At, B1); G8_BAR; }
  if (wr == 0) G8_BAR;
#undef G8_SA
#undef G8_SB
#undef G8_STAGE_P
#undef G8_STAGE_Q
#undef G8_LDA
#undef G8_LDB
#undef G8_MMA
#undef G8_WAIT_V
#undef G8_WAIT_L
#undef G8_BAR
#undef G8_SCHED
}

DI void gemm8(const bf16_t* P, int ldp, const bf16_t* Q, int ldq, int K, f32x4 (&acc)[2][2][4][2], char* smem, bool staged) {
  gemm8_impl<false>(P, ldp, Q, ldq, K, acc, smem, staged);
}
DI void gemm8_stage0(const bf16_t* P, int ldp, const bf16_t* Q, int ldq, f32x4 (&acc)[2][2][4][2], char* smem) {
  gemm8_impl<true>(P, ldp, Q, ldq, 256, acc, smem, false);
}
struct NextTile { const bf16_t* P; const bf16_t* Q; int ldp; int ldq; bool has; };
DI void zero_acc8(f32x4 (&acc)[2][2][4][2]) {
#pragma unroll
  for (int a = 0; a < 2; ++a)
#pragma unroll
    for (int b = 0; b < 2; ++b)
#pragma unroll
      for (int m = 0; m < 4; ++m)
#pragma unroll
        for (int n = 0; n < 2; ++n) acc[a][b][m][n] = f32x4{0.f, 0.f, 0.f, 0.f};
}
DI uint2 pack4v(f32x4 v, float sc) { return make_uint2(cvtpk(v[0] * sc, v[1] * sc), cvtpk(v[2] * sc, v[3] * sc)); }
DI void rope_quad4(const float2* cs, f32x4 x1, f32x4 x2, float sc, bf16_t* d1, bf16_t* d2) {
  const float4 c01 = ((const float4*)cs)[0], c23 = ((const float4*)cs)[1];
  const float c[4] = {c01.x, c01.z, c23.x, c23.z}, sn[4] = {c01.y, c01.w, c23.y, c23.w};
  float o1[4], o2[4];
#pragma unroll
  for (int j = 0; j < 4; ++j) { o1[j] = (x1[j] * c[j] - x2[j] * sn[j]) * sc; o2[j] = (x2[j] * c[j] + x1[j] * sn[j]) * sc; }
  *(uint2*)d1 = pack4(o1[0], o1[1], o1[2], o1[3]);
  *(uint2*)d2 = pack4(o2[0], o2[1], o2[2], o2[3]);
}

DI void inproj_tile(const Params& p, int layer, int tm, int tn, char* smem, bool staged, const NextTile& nx) {
  f32x4 acc[2][2][4][2]; zero_acc8(acc);
  const int m0 = tm * 256, n0 = tn * 256;
  gemm8(p.winT + ((size_t)layer * DINP + n0) * DM, DM, p.hn + (size_t)m0 * DM, DM, DM, acc, smem, staged);
  if (nx.has) gemm8_stage0(nx.P, nx.ldp, nx.Q, nx.ldq, acc, smem);
  const int tid_ = otid(); const int lane = tid_ & 63, wid = __builtin_amdgcn_readfirstlane(tid_ >> 6), wr = wid >> 2, wc = wid & 3, fr = lane & 15, fq = lane >> 4;
  const int pmask = pos_mask(m0);
#pragma unroll
  for (int bj = 0; bj < 2; ++bj)
#pragma unroll
    for (int n = 0; n < 2; ++n) {
      const int row = m0 + bj * 128 + wc * 32 + n * 16 + fr;
      const int pos = row & pmask;
      bf16_t* zrow = p.z + (size_t)row * ZLD;
#pragma unroll
      for (int ai = 0; ai < 2; ++ai) {
        const int fb = n0 + ai * 128 + wr * 64;
        if (fb >= Z_BQ && fb < Z_BV) {
          const float sc = fb < Z_BK ? SCALE_B : 1.f;
#pragma unroll
          for (int m = 0; m < 2; ++m) {
            const int f0 = m * 16 + fq * 4;
            rope_quad4(p.cs64 + pos * 32 + f0, acc[ai][bj][m][n], acc[ai][bj][m + 2][n], sc, zrow + fb + f0, zrow + fb + 32 + f0);
          }
        } else {
#pragma unroll
          for (int tj = 0; tj < 2; ++tj) {
            const int n32 = fb + tj * 32;
            if (n32 >= DIN) continue;
            const bool rope = (n32 < Z_AV) || (n32 == Z_DKR);
            const float sc = (n32 < Z_AK) ? SCALE_A : ((n32 >= Z_CQ && n32 < Z_CK) ? SCALE_C : 1.f);
            if (rope) {
              rope_quad4(p.cs32 + pos * 16 + fq * 4, acc[ai][bj][2 * tj][n], acc[ai][bj][2 * tj + 1][n], sc, zrow + n32 + fq * 4, zrow + n32 + 16 + fq * 4);
            } else {
              *(uint2*)(zrow + n32 + fq * 4) = pack4v(acc[ai][bj][2 * tj][n], sc);
              *(uint2*)(zrow + n32 + 16 + fq * 4) = pack4v(acc[ai][bj][2 * tj + 1][n], sc);
            }
          }
        }
      }
    }
}

DI void tile_rs(const bf16_t* A, int lda, int K, float* rsv) {
  const int t = otid();
  const uint4* src = (const uint4*)(A + (size_t)(t >> 1) * lda + (t & 1) * (K >> 1));
  float ss = 0.f;
  for (int c = 0; c < (K >> 4); ++c) {
    const uint4 u = src[c];
    ss += bflo(u.x) * bflo(u.x) + bfhi(u.x) * bfhi(u.x) + bflo(u.y) * bflo(u.y) + bfhi(u.y) * bfhi(u.y)
        + bflo(u.z) * bflo(u.z) + bfhi(u.z) * bfhi(u.z) + bflo(u.w) * bflo(u.w) + bfhi(u.w) * bfhi(u.w);
  }
  ss += __shfl_xor(ss, 1);
  if ((t & 1) == 0) rsv[t >> 1] = rsqrtf(ss / (float)K + EPS);
}

DI void upproj_tile(const Params& p, int layer, int tm, int sel, char* smem) {
  const int m0 = tm * 256;
  const int pmask = pos_mask(m0);
  float* rsv = (float*)(smem + SM_RS);
  const int tid_ = otid(); const int lane = tid_ & 63, wave = __builtin_amdgcn_readfirstlane(tid_ >> 6), wm = wave >> 2, wn = wave & 3, r = lane & 31, h = lane >> 5;
  f32x16 acc[4][2]; zero_acc(acc);
  __syncthreads();
  if (sel < 2) {
    const int n0 = sel * 256;
    const bf16_t* A = p.z + (size_t)m0 * ZLD + Z_DCQ;
    tile_rs(A, ZLD, 256, rsv);
    gemm_core(A, ZLD, p.wuqT + ((size_t)layer * 384 + n0) * 256, 256, 256, acc, smem);
#pragma unroll
    for (int ti = 0; ti < 4; ++ti) {
      const int rl = wm * 128 + ti * 32 + r, row = m0 + rl;
      const float rsc = rsv[rl] * SCALE_D;
      bf16_t* qrow = p.qd + (size_t)row * 384;
#pragma unroll
      for (int tj = 0; tj < 2; ++tj) {
        const int n = n0 + wn * 64 + tj * 32;
        if (n >= 384) continue;
        if ((n % 96) == 64) {
#pragma unroll
          for (int g = 0; g < 2; ++g) {
            const int f0 = 8 * g + 4 * h;
            rope_quad(p.cs32 + (row & pmask) * 16 + f0, acc[ti][tj], acc[ti][tj], g, g + 2, rsc, qrow + n + f0, qrow + n + 16 + f0);
          }
        } else {
#pragma unroll
          for (int g = 0; g < 4; ++g)
            *(uint2*)(qrow + n + 8 * g + 4 * h) = pack4(acc[ti][tj][4 * g] * rsc, acc[ti][tj][4 * g + 1] * rsc, acc[ti][tj][4 * g + 2] * rsc, acc[ti][tj][4 * g + 3] * rsc);
        }
      }
    }
  } else {
    const int n0 = (sel - 2) * 256;
    const bf16_t* A = p.z + (size_t)m0 * ZLD + Z_DCKV;
    tile_rs(A, ZLD, 128, rsv);
    gemm_core(A, ZLD, p.wukvT + ((size_t)layer * 512 + n0) * 128, 128, 128, acc, smem);
#pragma unroll
    for (int ti = 0; ti < 4; ++ti) {
      const int rl = wm * 128 + ti * 32 + r, row = m0 + rl;
      const float rsc = rsv[rl];
      bf16_t* krow = p.kvd + (size_t)row * 512 + n0 + wn * 64;
#pragma unroll
      for (int tj = 0; tj < 2; ++tj)
#pragma unroll
        for (int g = 0; g < 4; ++g)
          *(uint2*)(krow + tj * 32 + 8 * g + 4 * h) = pack4(acc[ti][tj][4 * g] * rsc, acc[ti][tj][4 * g + 1] * rsc, acc[ti][tj][4 * g + 2] * rsc, acc[ti][tj][4 * g + 3] * rsc);
    }
  }
}

DI void outproj_tile(const Params& p, int layer, int tm, int tn, char* smem, bool staged, const NextTile& nx) {
  f32x4 acc[2][2][4][2]; zero_acc8(acc);
  const int m0 = tm * 256, n0 = tn * 256;
  gemm8(p.woutT + ((size_t)layer * DM + n0) * DM, DM, p.hn + (size_t)m0 * DM, DM, DM, acc, smem, staged);
  if (nx.has) gemm8_stage0(nx.P, nx.ldp, nx.Q, nx.ldq, acc, smem);
  const int tid_ = otid(); const int lane = tid_ & 63, wid = __builtin_amdgcn_readfirstlane(tid_ >> 6), wr = wid >> 2, wc = wid & 3, fr = lane & 15, fq = lane >> 4;
#pragma unroll
  for (int bj = 0; bj < 2; ++bj)
#pragma unroll
    for (int n = 0; n < 2; ++n) {
      const int row = m0 + bj * 128 + wc * 32 + n * 16 + fr;
      const float* hrow = (layer == 0 ? xrow(p, row) : p.out + (size_t)row * DM) + n0 + wr * 64 + fq * 4;
      float* orow = p.out + (size_t)row * DM + n0 + wr * 64 + fq * 4;
#pragma unroll
      for (int ai = 0; ai < 2; ++ai)
#pragma unroll
        for (int m = 0; m < 4; ++m) {
          const float4 hv = *(const float4*)(hrow + ai * 128 + m * 16);
          const f32x4 a = acc[ai][bj][m][n];
          *(float4*)(orow + ai * 128 + m * 16) = make_float4(hv.x + a[0], hv.y + a[1], hv.z + a[2], hv.w + a[3]);
        }
    }
}

DI void pproj_tile(const Params& p, int layer, int tm, int tn, char* smem, bool staged, const NextTile& nx) {
  f32x4 acc[2][2][4][2]; zero_acc8(acc);
  const int m0 = tm * 256, n0 = tn * 256;
  gemm8(p.wppT + ((size_t)layer * DM + n0) * 256, 256, p.pb + ((size_t)layer * NTOK + m0) * 256, 256, 256, acc, smem, staged);
  if (nx.has) gemm8_stage0(nx.P, nx.ldp, nx.Q, nx.ldq, acc, smem);
  const int tid_ = otid(); const int lane = tid_ & 63, wid = __builtin_amdgcn_readfirstlane(tid_ >> 6), wr = wid >> 2, wc = wid & 3, fr = lane & 15, fq = lane >> 4;
#pragma unroll
  for (int bj = 0; bj < 2; ++bj)
#pragma unroll
    for (int n = 0; n < 2; ++n) {
      const int row = m0 + bj * 128 + wc * 32 + n * 16 + fr;
      bf16_t* prow = p.z + (size_t)row * DM + n0 + wr * 64 + fq * 4;
#pragma unroll
      for (int ai = 0; ai < 2; ++ai)
#pragma unroll
        for (int m = 0; m < 4; ++m) *(uint2*)(prow + ai * 128 + m * 16) = pack4v(acc[ai][bj][m][n], 1.f);
    }
}

DI void ple_tile(const Params& p, int layer, int tm, int tn, char* smem, bool staged, const NextTile& nx) {
  f32x4 acc[2][2][4][2]; zero_acc8(acc);
  const int m0 = tm * 256, n0 = tn * 256;
  gemm8(p.wpgT + ((size_t)layer * DM + n0) * DM, DM, p.hn + (size_t)m0 * DM, DM, DM, acc, smem, staged);
  if (nx.has) gemm8_stage0(nx.P, nx.ldp, nx.Q, nx.ldq, acc, smem);
  const int tid_ = otid(); const int lane = tid_ & 63, wid = __builtin_amdgcn_readfirstlane(tid_ >> 6), wr = wid >> 2, wc = wid & 3, fr = lane & 15, fq = lane >> 4;
#pragma unroll
  for (int bj = 0; bj < 2; ++bj)
#pragma unroll
    for (int n = 0; n < 2; ++n) {
      const int row = m0 + bj * 128 + wc * 32 + n * 16 + fr;
      float* orow = p.out + (size_t)row * DM + n0 + wr * 64 + fq * 4;
      const bf16_t* prow = p.z + (size_t)row * DM + n0 + wr * 64 + fq * 4;
#pragma unroll
      for (int ai = 0; ai < 2; ++ai)
#pragma unroll
        for (int m = 0; m < 4; ++m) {
          const float4 ov = *(const float4*)(orow + ai * 128 + m * 16);
          const uint2 pu = *(const uint2*)(prow + ai * 128 + m * 16);
          const f32x4 a = acc[ai][bj][m][n];
          *(float4*)(orow + ai * 128 + m * 16) = make_float4(ov.x + sigm(a[0]) * bflo(pu.x), ov.y + sigm(a[1]) * bfhi(pu.x),
                                                            ov.z + sigm(a[2]) * bflo(pu.y), ov.w + sigm(a[3]) * bfhi(pu.y));
        }
    }
}

template <int MODE>
DI void attn_item(const Params& p, int layer, int v, char* smem) {
  constexpr int NMAPS = (MODE == 0) ? 2 : 1;
  constexpr int KS = (MODE == 0) ? 2 : ((MODE == 3) ? 6 : 4);
  constexpr int DK = (MODE == 3) ? 96 : 64;
  constexpr int KSTR = (DK + 8) * 2;
  constexpr int VSTR = 144;
  constexpr int KBUF = 64 * KSTR;
  constexpr int BUFB = KBUF + 64 * VSTR;
  constexpr bool LAZY = (MODE == 0 || MODE == 3);
  const int tid = otid(), lane = tid & 63, wave = __builtin_amdgcn_readfirstlane(tid >> 6), r = lane & 31, h = lane >> 5;
  int seq, head, qt, S, row0;
  if (v < 1024) {
    const int b = v & 255, k = v >> 8, x = b & 7, j = b >> 3, pr = x + 8 * k;
    seq = pr >> 2; head = pr & 3; qt = j; S = 8192; row0 = seq * 8192;
  } else {
    const int b = v - 1024, x = b & 7, j = b >> 3, pr = x + 8 * (j >> 4);
    seq = pr >> 2; head = pr & 3; qt = j & 15; S = 4096; row0 = NPROMPT + seq * 4096;
  }
  const int q0 = qt * 256, nkt = S >> 6;
  int kt_lo = 0, kt_hi = nkt, cR = 0, clo = 0;
  if (MODE == 1) { kt_lo = max(0, 4 * qt - 2); kt_hi = min(nkt, 4 * qt + 6); }
  if (MODE == 2) {
    const int R0 = 4 * qt;
    kt_lo = min(max(R0 - 4, 0), nkt - 8); kt_hi = min(max(R0 - 1, 0), nkt - 8) + 8;
    cR = R0 + (wave >> 1); clo = min(max(cR - 4, 0), nkt - 8);
  }
  const bf16_t *qp, *kp, *vp; int ldq, ldk, ldv;
  if (MODE == 0) { qp = p.z + Z_AQ + head * 64; kp = p.z + Z_AK + head * 64; vp = p.z + Z_AV + head * 64; ldq = ldk = ldv = ZLD; }
  else if (MODE == 1) { qp = p.z + Z_BQ + head * 64; kp = p.z + Z_BK + (head >> 1) * 64; vp = p.z + Z_BV + (head >> 1) * 64; ldq = ldk = ldv = ZLD; }
  else if (MODE == 2) { qp = p.z + Z_CQ + head * 64; kp = p.z + Z_CK + head * 64; vp = p.z + Z_CV + head * 64; ldq = ldk = ldv = ZLD; }
  else { qp = p.qd + head * 96; ldq = 384; kp = p.kvd + head * 128; vp = p.kvd + head * 128 + 64; ldk = ldv = 512; }

  float* bias = (float*)(smem + SM_BIAS);
  if (MODE == 2) {
    const float* rp = p.c_rpb + (size_t)(layer * 4 + head) * 465;
    for (int i = tid; i < 465; i += NTHR) bias[i] = rp[i] * LOG2E;
  }

  bf16x8 qf[NMAPS][KS];
  {
    const bf16_t* qrow = qp + (size_t)(row0 + q0 + wave * 32 + r) * ldq + 8 * h;
#pragma unroll
    for (int m = 0; m < NMAPS; ++m)
#pragma unroll
      for (int ks = 0; ks < KS; ++ks) qf[m][ks] = *(const bf16x8*)(qrow + (m * KS + ks) * 16);
  }
  float mrun[NMAPS], lrun[NMAPS];
  f32x16 o[NMAPS][2];
  f32x16 negm[NMAPS];
  bool zref[NMAPS];
#pragma unroll
  for (int m = 0; m < NMAPS; ++m) { mrun[m] = LAZY ? 0.f : -1e30f; lrun[m] = 0.f; o[m][0] = f32x16{}; o[m][1] = f32x16{}; negm[m] = f32x16{}; zref[m] = true; }
  if (MODE == 1) { mrun[0] = p.b_sink[layer * 4 + head] * LOG2E; lrun[0] = (h == 0) ? 1.f : 0.f; }

  const int lrow = tid >> 3, lcc = tid & 7;
  const bf16_t* kg = kp + (size_t)(row0 + lrow) * ldk + lcc * 8;
  const bf16_t* vg = vp + (size_t)(row0 + lrow) * ldv + lcc * 8;
  const bf16_t* k2g = p.z + (size_t)(row0 + ((tid & 255) >> 2)) * ZLD + Z_DKR + (tid & 3) * 8;
  u32x4 kr0, vr0, k2r = u32x4{};
#define ATT_LOAD(kt_)                                                                              \
  {                                                                                                \
    const size_t ro_ = (size_t)(kt_) * 64;                                                         \
    kr0 = *(const u32x4*)(kg + ro_ * ldk);                                                         \
    vr0 = *(const u32x4*)(vg + ro_ * ldv);                                                         \
    if (MODE == 3) { if (tid < 256) k2r = *(const u32x4*)(k2g + ro_ * ZLD); }                      \
  }
#define ATT_STORE(buf_)                                                                            \
  {                                                                                                \
    char* kb_ = smem + (buf_) * BUFB;                                                              \
    *(u32x4*)(kb_ + lrow * KSTR + lcc * 16) = kr0;                                                 \
    *(u32x4*)(kb_ + KBUF + lrow * VSTR + lcc * 16) = vr0;                                          \
    if (MODE == 3) { if (tid < 256) *(u32x4*)(kb_ + (tid >> 2) * KSTR + 128 + (tid & 3) * 16) = k2r; } \
  }
  ATT_LOAD(kt_lo);
  ATT_STORE(0);
  __syncthreads();

  const int i16 = lane & 15;
  const int voff = (4 * h + (i16 >> 2)) * VSTR + (((lane >> 4) & 1) * 16 + (i16 & 3) * 4) * 2;
  const int qi = q0 + wave * 32 + r;
  const int cc = (wave & 1) * 32 + r;
  const int ccs = min(max(cc - 8, 0), 48);

  if (wave >= 4) __builtin_amdgcn_s_setprio(1);
#pragma unroll 1
  for (int kt = kt_lo; kt < kt_hi; ++kt) {
    const int cur = (kt - kt_lo) & 1;
    if (kt + 1 < kt_hi) ATT_LOAD(kt + 1);
    const bool active = (MODE == 2) ? (kt >= clo && kt < clo + 8)
                      : ((MODE == 1) ? (kt * 64 + 63 >= q0 + wave * 32 - 128 && kt * 64 <= q0 + wave * 32 + 31 + 128) : true);
    if (active) {
      const char* kb = smem + cur * BUFB;
      const char* vb = kb + KBUF;
      bf16x8 pf[NMAPS][2][2];
#pragma unroll
      for (int m = 0; m < NMAPS; ++m) {
        f32x16 st[2];
        auto qk_chain = [&](const bool use_ref) {
#pragma unroll
          for (int sub = 0; sub < 2; ++sub) {
            f32x16 s;
            if (use_ref) s = negm[m]; else s = f32x16{};
#pragma unroll
            for (int ks = 0; ks < KS; ++ks) {
              const bf16x8 kf = *(const bf16x8*)(kb + (sub * 32 + r) * KSTR + ((m * KS + ks) * 16 + 8 * h) * 2);
              s = MFMA(kf, qf[m][ks], s);
            }
            st[sub] = s;
          }
        };
        if (LAZY && !zref[m]) qk_chain(true); else qk_chain(false);
        if (MODE == 1) {
          int tb = kt * 64 + 4 * h - qi + 128;
          asm volatile("" : "+v"(tb));
#pragma unroll
          for (int sub = 0; sub < 2; ++sub)
#pragma unroll
            for (int i = 0; i < 16; ++i) {
              const int c0 = sub * 32 + (i & 3) + 8 * (i >> 2);
              if ((unsigned)(tb + c0) > 256u) st[sub][i] = -INFINITY;
            }
        }
        if (MODE == 2) {
          int tcc = 4 * h - cc + 15 + (kt - cR + 7) * 31, tcs = 4 * h - ccs;
          asm volatile("" : "+v"(tcc), "+v"(tcs));
#pragma unroll
          for (int sub = 0; sub < 2; ++sub)
#pragma unroll
            for (int i = 0; i < 16; ++i) {
              const int c0 = sub * 32 + (i & 3) + 8 * (i >> 2);
              const bool valid = (unsigned)(c0 + tcs) < 16u;
              const int idx = valid ? tcc + c0 : 0;
              const float bv = bias[idx];
              st[sub][i] = valid ? st[sub][i] + bv : -INFINITY;
            }
        }
        auto tile_max = [&]() {
          float mx_ = fmaxf(fmaxf(st[0][0], st[0][1]), st[1][0]);
          float mb_ = fmaxf(fmaxf(st[0][2], st[0][3]), st[1][1]);
          mx_ = fmaxf(fmaxf(mx_, st[1][2]), st[1][3]);
#pragma unroll
          for (int i = 4; i < 16; i += 4) {
            mx_ = fmaxf(fmaxf(mx_, st[0][i]), st[0][i + 1]); mb_ = fmaxf(fmaxf(mb_, st[0][i + 2]), st[0][i + 3]);
            mx_ = fmaxf(fmaxf(mx_, st[1][i]), st[1][i + 1]); mb_ = fmaxf(fmaxf(mb_, st[1][i + 2]), st[1][i + 3]);
          }
          return swap_max(fmaxf(mx_, mb_));
        };
        float mx = 0.f;
        if (!LAZY) mx = tile_max();
        if (LAZY) {
          int ia = max(max(__float_as_int(st[0][0]), __float_as_int(st[0][1])), __float_as_int(st[1][0]));
          int ib = max(max(__float_as_int(st[0][2]), __float_as_int(st[0][3])), __float_as_int(st[1][1]));
          ia = max(max(ia, __float_as_int(st[1][2])), __float_as_int(st[1][3]));
#pragma unroll
          for (int i = 4; i < 16; i += 4) {
            ia = max(max(ia, __float_as_int(st[0][i])), __float_as_int(st[0][i + 1])); ib = max(max(ib, __float_as_int(st[0][i + 2])), __float_as_int(st[0][i + 3]));
            ia = max(max(ia, __float_as_int(st[1][i])), __float_as_int(st[1][i + 1])); ib = max(max(ib, __float_as_int(st[1][i + 2])), __float_as_int(st[1][i + 3]));
          }
          ia = max(ia, ib);
          const bool first = (kt == kt_lo);
          bool need = __builtin_amdgcn_ballot_w64(ia > 0x41000000) != 0;
          if (first) { mx = tile_max(); need = need || (__builtin_amdgcn_ballot_w64(mx < -8.f) != 0); }
          if (need) {
            if (!first) mx = tile_max();
            zref[m] = false;
            const float delta = first ? mx : fmaxf(mx, 0.f);
            const float alpha = first ? 1.f : ex2(-delta);
            mrun[m] += delta;
            lrun[m] *= alpha;
#pragma unroll
            for (int i = 0; i < 16; ++i) { o[m][0][i] *= alpha; o[m][1][i] *= alpha; st[0][i] -= delta; st[1][i] -= delta; }
            const float nm = -mrun[m];
#pragma unroll
            for (int i = 0; i < 16; ++i) negm[m][i] = nm;
          }
          f32x2 l2[4] = {{0.f, 0.f}, {0.f, 0.f}, {0.f, 0.f}, {0.f, 0.f}};
#pragma unroll
          for (int sub = 0; sub < 2; ++sub)
#pragma unroll
            for (int i = 0; i < 16; i += 2) {
              const float p0 = ex2(st[sub][i]), p1 = ex2(st[sub][i + 1]);
              st[sub][i] = p0; st[sub][i + 1] = p1;
              l2[(i >> 1) & 3] += f32x2{p0, p1};
            }
          const f32x2 lt = (l2[0] + l2[1]) + (l2[2] + l2[3]);
          lrun[m] += lt[0] + lt[1];
        } else {
          const float mnew = fmaxf(mrun[m], mx);
          const float alpha = ex2(mrun[m] - mnew);
          mrun[m] = mnew;
          float ls = 0.f;
#pragma unroll
          for (int sub = 0; sub < 2; ++sub)
#pragma unroll
            for (int i = 0; i < 16; ++i) { const float pv = ex2(st[sub][i] - mnew); ls += pv; st[sub][i] = pv; }
          lrun[m] = lrun[m] * alpha + ls;
#pragma unroll
          for (int i = 0; i < 16; ++i) { o[m][0][i] *= alpha; o[m][1][i] *= alpha; }
        }
#pragma unroll
        for (int sub = 0; sub < 2; ++sub)
#pragma unroll
          for (int kk = 0; kk < 2; ++kk) {
            const uint4 u = make_uint4(cvtpk(st[sub][8 * kk + 0], st[sub][8 * kk + 1]), cvtpk(st[sub][8 * kk + 2], st[sub][8 * kk + 3]),
                                       cvtpk(st[sub][8 * kk + 4], st[sub][8 * kk + 5]), cvtpk(st[sub][8 * kk + 6], st[sub][8 * kk + 7]));
            pf[m][sub][kk] = __builtin_bit_cast(bf16x8, u);
          }
      }
#pragma unroll
      for (int sub = 0; sub < 2; ++sub)
#pragma unroll
        for (int kk = 0; kk < 2; ++kk)
#pragma unroll
          for (int dvt = 0; dvt < 2; ++dvt) {
            const char* va = vb + voff + (sub * 32 + kk * 16) * VSTR + dvt * 64;
            const s16x4 lo = vtr(va), hi = vtr(va + 8 * VSTR);
            const bf16x8 vf = __builtin_shufflevector(lo, hi, 0, 1, 2, 3, 4, 5, 6, 7);
#pragma unroll
            for (int m = 0; m < NMAPS; ++m) o[m][dvt] = MFMA(vf, pf[m][sub][kk], o[m][dvt]);
          }
    }
    if (kt + 1 < kt_hi) ATT_STORE(cur ^ 1);
    __syncthreads();
  }
  if (wave >= 4) __builtin_amdgcn_s_setprio(0);
#undef ATT_LOAD
#undef ATT_STORE

  float inv[NMAPS];
#pragma unroll
  for (int m = 0; m < NMAPS; ++m) inv[m] = 1.f / swap_sum(lrun[m]);
  f32x16 res[2];
  if (MODE == 0) {
    const float lam = p.lam[layer];
    const float lam_init = 0.8f - 0.6f * __expf(-0.3f * (float)layer);
    float ss = 0.f;
#pragma unroll
    for (int dvt = 0; dvt < 2; ++dvt)
#pragma unroll
      for (int i = 0; i < 16; ++i) { const float t = o[0][dvt][i] * inv[0] - lam * (o[NMAPS - 1][dvt][i] * inv[NMAPS - 1]); res[dvt][i] = t; ss += t * t; }
    ss = swap_sum(ss);
    const float rs = rsqrtf(ss * (1.f / 64.f) + EPS) * (1.f - lam_init);
    const float* sg = p.a_subln_g + layer * 64;
#pragma unroll
    for (int dvt = 0; dvt < 2; ++dvt)
#pragma unroll
      for (int i = 0; i < 16; ++i) res[dvt][i] *= rs * sg[dvt * 32 + crow(i, h)];
  } else {
#pragma unroll
    for (int dvt = 0; dvt < 2; ++dvt)
#pragma unroll
      for (int i = 0; i < 16; ++i) res[dvt][i] = o[0][dvt][i] * inv[0];
  }
  {
    const size_t row = (size_t)(row0 + qi);
    const bf16_t* gp = p.z + row * ZLD + Z_GATE + MODE * 256 + head * 64;
    bf16_t* mp = p.hn + row * DM + MODE * 256 + head * 64;
#pragma unroll
    for (int dvt = 0; dvt < 2; ++dvt)
#pragma unroll
      for (int ig = 0; ig < 4; ++ig) {
        const int dv0 = dvt * 32 + ig * 8 + 4 * h;
        const uint2 gu = *(const uint2*)(gp + dv0);
        const float g0 = bflo(gu.x), g1 = bfhi(gu.x), g2 = bflo(gu.y), g3 = bfhi(gu.y);
        const float a0 = res[dvt][ig * 4 + 0] * g0 * sigm(g0), a1 = res[dvt][ig * 4 + 1] * g1 * sigm(g1);
        const float a2 = res[dvt][ig * 4 + 2] * g2 * sigm(g2), a3 = res[dvt][ig * 4 + 3] * g3 * sigm(g3);
        *(uint2*)(mp + dv0) = make_uint2(cvtpk(a0, a1), cvtpk(a2, a3));
      }
  }
}

#define XB_TMO      128
#define XB_XCNT(j)  (256  + 64 * (j))
#define XB_XSUB(j)  (1280 + 64 * (j))
#define XB_XGEN(j)  (2304 + 64 * (j))
#define XB_TOP      3328
#define XB_TOPGEN   3392
#define XB_SPIN_CAP (1u << 18)
#define LAS __attribute__((address_space(3)))
DI unsigned xb_ld(unsigned* p) { return __hip_atomic_load(p, __ATOMIC_RELAXED, __HIP_MEMORY_SCOPE_AGENT); }
DI unsigned xb_add(unsigned* p, unsigned v) { return __hip_atomic_fetch_add(p, v, __ATOMIC_RELAXED, __HIP_MEMORY_SCOPE_AGENT); }
DI unsigned xb_xcc_id() { return (unsigned)__builtin_amdgcn_s_getreg((3 << 11) | 20) & 0xFu; }
#define XB_SPIN(cond, bar) do { unsigned _sp = 0; while (cond) { __builtin_amdgcn_s_sleep(1); \
    if ((++_sp & 255u) == 0u) { if (xb_ld(&(bar)[XB_TMO])) break; if (_sp > XB_SPIN_CAP) { atomicAdd(&(bar)[XB_TMO], 1u); break; } } } } while (0)
struct XcdBarrier { unsigned* bar; unsigned x; volatile LAS unsigned* st; };
DI XcdBarrier xcd_barrier_post(unsigned* bar, volatile LAS unsigned* st) {
  XcdBarrier b; b.bar = bar; b.x = xb_xcc_id(); b.st = st;
  if (threadIdx.x == 0) (void)xb_add(&bar[XB_XCNT(b.x)], 1u);
  return b;
}
DI void xcd_barrier_complete(unsigned* bar, unsigned x, unsigned& nloc, unsigned& nx) {
  const unsigned G = gridDim.x * gridDim.y * gridDim.z;
  unsigned sum, cnt, mine, sp = 0u;
  for (;;) {
    sum = 0u; cnt = 0u; mine = 0u;
#pragma unroll
    for (unsigned j = 0; j < 16; ++j) { const unsigned c = xb_ld(&bar[XB_XCNT(j)]); sum += c; cnt += (c > 0u) ? 1u : 0u; mine = (j == x) ? c : mine; }
    if (sum == G) break;
    __builtin_amdgcn_s_sleep(1);
    if ((++sp & 255u) == 0u) { if (xb_ld(&bar[XB_TMO])) break; if (sp > XB_SPIN_CAP) { atomicAdd(&bar[XB_TMO], 1u); break; } }
  }
  nloc = mine > 0u ? mine : 1u; nx = cnt > 0u ? cnt : 1u;
}
DI void xcd_barrier(const XcdBarrier& b) {
  asm volatile("s_waitcnt vmcnt(0)" ::: "memory");
  __syncthreads();
  if (threadIdx.x == 0) {
    unsigned* bar = b.bar;
    __builtin_amdgcn_s_waitcnt(0);
    unsigned nloc = b.st[0], nx = b.st[1];
    if (nloc == 0u) { xcd_barrier_complete(bar, b.x, nloc, nx); b.st[0] = nloc; b.st[1] = nx; }
    const unsigned old = xb_add(&bar[XB_XSUB(b.x)], 1u);
    const unsigned gen = old / nloc;
    if (old + 1u == (gen + 1u) * nloc) {
      __builtin_amdgcn_fence(__ATOMIC_RELEASE, "agent");
      asm volatile("s_waitcnt vmcnt(0)" ::: "memory");
      const unsigned og = xb_add(&bar[XB_TOP], 1u);
      const unsigned tg = og / nx;
      if (og + 1u == (tg + 1u) * nx) xb_add(&bar[XB_TOPGEN], 1u);
      else XB_SPIN(xb_ld(&bar[XB_TOPGEN]) == tg, bar);
      __builtin_amdgcn_fence(__ATOMIC_ACQUIRE, "agent");
      xb_add(&bar[XB_XGEN(b.x)], 1u);
      asm volatile("s_waitcnt vmcnt(0)" ::: "memory");
    } else {
      XB_SPIN(xb_ld(&bar[XB_XGEN(b.x)]) == gen, bar);
      __builtin_amdgcn_fence(__ATOMIC_ACQUIRE, "agent");
      asm volatile("s_waitcnt vmcnt(0)" ::: "memory");
    }
  }
  __syncthreads();
}

DI void row_ssq_exchange(const Params& p, int slot, int tm, int tn, float (&ssp)[2][2], char* smem, int lane, int wr, int wc) {
  const int fr = lane & 15, fq = lane >> 4;
  float* lpart = (float*)(smem + 131072);
  float* lrs = lpart + 512;
  __syncthreads();
#pragma unroll
  for (int bj = 0; bj < 2; ++bj)
#pragma unroll
    for (int n = 0; n < 2; ++n) {
      float v = ssp[bj][n];
      v += __shfl_xor(v, 16); v += __shfl_xor(v, 32);
      if (fq == 0) lpart[wr * 256 + bj * 128 + wc * 32 + n * 16 + fr] = v;
    }
  __syncthreads();
  const int t = otid();
  unsigned* xp = p.xpart + ((size_t)(slot * 320 + tm) * 4) * 256;
  if (t < 256) __hip_atomic_store(xp + tn * 256 + t, __float_as_uint(lpart[t] + lpart[256 + t]), __ATOMIC_RELAXED, __HIP_MEMORY_SCOPE_AGENT);
  asm volatile("s_waitcnt vmcnt(0)" ::: "memory");
  __syncthreads();
  if (t == 0) { unsigned* c = p.xcnt + slot * 320 + tm; (void)xb_add(c, 1u); XB_SPIN(xb_ld(c) < 4u, p.bar); }
  __syncthreads();
  if (t < 256) {
    float tot = 0.f;
#pragma unroll
    for (int q = 0; q < 4; ++q) tot += __uint_as_float(__hip_atomic_load(xp + q * 256 + t, __ATOMIC_RELAXED, __HIP_MEMORY_SCOPE_AGENT));
    lrs[t] = rsqrtf(tot * (1.f / 1024.f) + EPS);
  }
  __syncthreads();
}

DI void outproj_tile_f(const Params& p, int layer, int tm, int tn, char* smem, bool staged, const NextTile& nx) {
  f32x4 acc[2][2][4][2]; zero_acc8(acc);
  const int m0 = tm * 256, n0 = tn * 256;
  gemm8(p.woutT + ((size_t)layer * DM + n0) * DM, DM, p.hn + (size_t)m0 * DM, DM, DM, acc, smem, staged);
  if (nx.has) gemm8_stage0(nx.P, nx.ldp, nx.Q, nx.ldq, acc, smem);
  const int tid_ = otid(); const int lane = tid_ & 63, wid = __builtin_amdgcn_readfirstlane(tid_ >> 6), wr = wid >> 2, wc = wid & 3, fr = lane & 15, fq = lane >> 4;
  float ssp[2][2];
#pragma unroll
  for (int bj = 0; bj < 2; ++bj)
#pragma unroll
    for (int n = 0; n < 2; ++n) {
      const int row = m0 + bj * 128 + wc * 32 + n * 16 + fr;
      const float* hrow = (layer == 0 ? xrow(p, row) : p.out + (size_t)row * DM) + n0 + wr * 64 + fq * 4;
      float* orow = p.out + (size_t)row * DM + n0 + wr * 64 + fq * 4;
      float ss = 0.f;
#pragma unroll
      for (int ai = 0; ai < 2; ++ai)
#pragma unroll
        for (int m = 0; m < 4; ++m) {
          const float4 hv = *(const float4*)(hrow + ai * 128 + m * 16);
          f32x4 a = acc[ai][bj][m][n];
          a[0] += hv.x; a[1] += hv.y; a[2] += hv.z; a[3] += hv.w;
          *(float4*)(orow + ai * 128 + m * 16) = make_float4(a[0], a[1], a[2], a[3]);
          ss += a[0] * a[0] + a[1] * a[1] + a[2] * a[2] + a[3] * a[3];
          acc[ai][bj][m][n] = a;
        }
      ssp[bj][n] = ss;
    }
  row_ssq_exchange(p, 2 * layer, tm, tn, ssp, smem, lane, wr, wc);
  const float* lrs = (const float*)(smem + 131072) + 512;
  const float* g = p.ple_norm_g + layer * DM + n0 + wr * 64 + fq * 4;
#pragma unroll
  for (int bj = 0; bj < 2; ++bj)
#pragma unroll
    for (int n = 0; n < 2; ++n) {
      const int tl = bj * 128 + wc * 32 + n * 16 + fr;
      const float rs = lrs[tl];
      bf16_t* brow = p.hn + (size_t)(m0 + tl) * DM + n0 + wr * 64 + fq * 4;
#pragma unroll
      for (int ai = 0; ai < 2; ++ai)
#pragma unroll
        for (int m = 0; m < 4; ++m) {
          const float4 gv = *(const float4*)(g + ai * 128 + m * 16);
          const f32x4 a = acc[ai][bj][m][n];
          *(uint2*)(brow + ai * 128 + m * 16) = pack4(a[0] * rs * gv.x, a[1] * rs * gv.y, a[2] * rs * gv.z, a[3] * rs * gv.w);
        }
    }
}

DI void ple_tile_f(const Params& p, int layer, int tm, int tn, char* smem, bool staged, const NextTile& nx) {
  f32x4 acc[2][2][4][2]; zero_acc8(acc);
  const int m0 = tm * 256, n0 = tn * 256;
  gemm8(p.wpgT + ((size_t)layer * DM + n0) * DM, DM, p.hn + (size_t)m0 * DM, DM, DM, acc, smem, staged);
  if (nx.has) gemm8_stage0(nx.P, nx.ldp, nx.Q, nx.ldq, acc, smem);
  const int tid_ = otid(); const int lane = tid_ & 63, wid = __builtin_amdgcn_readfirstlane(tid_ >> 6), wr = wid >> 2, wc = wid & 3, fr = lane & 15, fq = lane >> 4;
  float ssp[2][2];
#pragma unroll
  for (int bj = 0; bj < 2; ++bj)
#pragma unroll
    for (int n = 0; n < 2; ++n) {
      const int row = m0 + bj * 128 + wc * 32 + n * 16 + fr;
      float* orow = p.out + (size_t)row * DM + n0 + wr * 64 + fq * 4;
      const bf16_t* prow = p.z + (size_t)row * DM + n0 + wr * 64 + fq * 4;
      float ss = 0.f;
#pragma unroll
      for (int ai = 0; ai < 2; ++ai)
#pragma unroll
        for (int m = 0; m < 4; ++m) {
          const float4 ov = *(const float4*)(orow + ai * 128 + m * 16);
          const uint2 pu = *(const uint2*)(prow + ai * 128 + m * 16);
          f32x4 a = acc[ai][bj][m][n];
          a[0] = ov.x + sigm(a[0]) * bflo(pu.x); a[1] = ov.y + sigm(a[1]) * bfhi(pu.x);
          a[2] = ov.z + sigm(a[2]) * bflo(pu.y); a[3] = ov.w + sigm(a[3]) * bfhi(pu.y);
          if (layer == 0) *(float4*)(orow + ai * 128 + m * 16) = make_float4(a[0], a[1], a[2], a[3]);
          ss += a[0] * a[0] + a[1] * a[1] + a[2] * a[2] + a[3] * a[3];
          acc[ai][bj][m][n] = a;
        }
      ssp[bj][n] = ss;
    }
  row_ssq_exchange(p, 2 * layer + 1, tm, tn, ssp, smem, lane, wr, wc);
  const float* lrs = (const float*)(smem + 131072) + 512;
  const float* g = (layer == 0 ? p.norm_g + DM : p.final_norm_g) + n0 + wr * 64 + fq * 4;
#pragma unroll
  for (int bj = 0; bj < 2; ++bj)
#pragma unroll
    for (int n = 0; n < 2; ++n) {
      const int tl = bj * 128 + wc * 32 + n * 16 + fr;
      const float rs = lrs[tl];
      bf16_t* brow = p.hn + (size_t)(m0 + tl) * DM + n0 + wr * 64 + fq * 4;
      float* orow = p.out + (size_t)(m0 + tl) * DM + n0 + wr * 64 + fq * 4;
#pragma unroll
      for (int ai = 0; ai < 2; ++ai)
#pragma unroll
        for (int m = 0; m < 4; ++m) {
          const float4 gv = *(const float4*)(g + ai * 128 + m * 16);
          const f32x4 a = acc[ai][bj][m][n];
          if (layer == 0) *(uint2*)(brow + ai * 128 + m * 16) = pack4(a[0] * rs * gv.x, a[1] * rs * gv.y, a[2] * rs * gv.z, a[3] * rs * gv.w);
          else *(float4*)(orow + ai * 128 + m * 16) = make_float4(a[0] * rs * gv.x, a[1] * rs * gv.y, a[2] * rs * gv.z, a[3] * rs * gv.w);
        }
    }
}

__global__ void __launch_bounds__(512, 2) mega_fwd(Params p) {
  __shared__ __attribute__((aligned(16))) char smem[SMEM_BYTES];
  cg::grid_group grid = cg::this_grid();
  const int nb = gridDim.x;

  if (threadIdx.x < 4) ((unsigned*)(smem + SM_XB))[threadIdx.x] = 0u;
  phase_prep(p, smem);
  phase_norm(p, 0, 0);
  grid.sync();
  const XcdBarrier xb = xcd_barrier_post(p.bar, (volatile LAS unsigned*)(lds_cptr)(smem + SM_XB));
#pragma unroll 1
  for (int layer = 0; layer < 2; ++layer) {
    {
      bool staged = false;
      for (int v = blockIdx.x; v < 18 * 256; v += nb) {
        const int b = v & 255, k = v >> 8, x = b & 7, j = b >> 3, st = k * 8 + x;
        if (st >= 140) continue;
        const int tm = (st / 7) * 16 + (j >> 1), tn = (st % 7) * 2 + (j & 1);
        NextTile nx;
        {
          const int v2 = v + nb, b2 = v2 & 255, k2 = v2 >> 8, st2 = k2 * 8 + (b2 & 7), j2 = b2 >> 3;
          nx.has = (v2 < 18 * 256) && (st2 < 140);
          const int tm2 = (st2 / 7) * 16 + (j2 >> 1), tn2 = (st2 % 7) * 2 + (j2 & 1);
          nx.P = p.winT + ((size_t)layer * DINP + tn2 * 256) * DM; nx.Q = p.hn + (size_t)tm2 * 256 * DM; nx.ldp = DM; nx.ldq = DM;
        }
        inproj_tile(p, layer, tm, tn, smem, staged, nx);
        staged = nx.has;
      }
    }
    xcd_barrier(xb);
    for (int v = blockIdx.x; v < 1280 + 1280 + 1280 + 1280; v += nb) {
      if (v < 1280) attn_item<0>(p, layer, v, smem);
      else if (v < 2560) { const int u = v - 1280; upproj_tile(p, layer, u >> 2, u & 3, smem); }
      else if (v < 3840) attn_item<1>(p, layer, v - 2560, smem);
      else attn_item<2>(p, layer, v - 3840, smem);
    }
    xcd_barrier(xb);
    for (int v = blockIdx.x; v < 1280; v += nb) attn_item<3>(p, layer, v, smem);
    xcd_barrier(xb);
    {
      bool staged = false;
      for (int v = blockIdx.x; v < 2560; v += nb) {
        const int vv = v < 1280 ? v : v - 1280;
        const int b = vv & 255, k = vv >> 8, x = b & 7, j = b >> 3, st = k * 8 + x;
        NextTile nx;
        {
          const int v2 = v + nb, vv2 = v2 < 1280 ? v2 : v2 - 1280;
          const int b2 = vv2 & 255, st2 = (vv2 >> 8) * 8 + (b2 & 7), j2 = b2 >> 3, tm2 = st2 * 8 + (j2 >> 2), tn2 = j2 & 3;
          nx.has = v2 < 2560;
          if (v2 < 1280) { nx.P = p.woutT + ((size_t)layer * DM + tn2 * 256) * DM; nx.Q = p.hn + (size_t)tm2 * 256 * DM; nx.ldp = DM; nx.ldq = DM; }
          else { nx.P = p.wppT + ((size_t)layer * DM + tn2 * 256) * 256; nx.Q = p.pb + ((size_t)layer * NTOK + tm2 * 256) * 256; nx.ldp = 256; nx.ldq = 256; }
        }
        if (v < 1280) outproj_tile_f(p, layer, st * 8 + (j >> 2), j & 3, smem, staged, nx);
        else pproj_tile(p, layer, st * 8 + (j >> 2), j & 3, smem, staged, nx);
        staged = nx.has;
      }
    }
    xcd_barrier(xb);
    {
      bool staged = false;
      for (int v = blockIdx.x; v < 1280; v += nb) {
        const int b = v & 255, k = v >> 8, x = b & 7, j = b >> 3, st = k * 8 + x;
        NextTile nx;
        {
          const int v2 = v + nb, b2 = v2 & 255, st2 = (v2 >> 8) * 8 + (b2 & 7), j2 = b2 >> 3, tm2 = st2 * 8 + (j2 >> 2), tn2 = j2 & 3;
          nx.has = v2 < 1280;
          nx.P = p.wpgT + ((size_t)layer * DM + tn2 * 256) * DM; nx.Q = p.hn + (size_t)tm2 * 256 * DM; nx.ldp = DM; nx.ldq = DM;
        }
        ple_tile_f(p, layer, st * 8 + (j >> 2), j & 3, smem, staged, nx);
        staged = nx.has;
      }
    }
    if (layer == 0) xcd_barrier(xb);
  }
}

extern "C" void kernel_launch(void* const* d_in, const int* in_sizes, int n_in, void* d_out, int out_size, void* d_ws, size_t ws_size,
                              hipStream_t stream) {
  Params p{};
  p.x_prompt = (const float*)d_in[0]; p.x_sample = (const float*)d_in[1]; p.p_prompt = (const float*)d_in[2]; p.p_sample = (const float*)d_in[3];
  p.norm_g = (const float*)d_in[4]; p.w_in = (const float*)d_in[5]; p.a_lambda = (const float*)d_in[6]; p.a_subln_g = (const float*)d_in[7];
  p.b_sink = (const float*)d_in[8]; p.c_rpb = (const float*)d_in[9]; p.d_q_norm_g = (const float*)d_in[10]; p.d_kv_norm_g = (const float*)d_in[11];
  p.d_w_uq = (const float*)d_in[12]; p.d_w_ukv = (const float*)d_in[13]; p.w_out = (const float*)d_in[14]; p.ple_norm_g = (const float*)d_in[15];
  p.w_ple_gate = (const float*)d_in[16]; p.w_ple_proj = (const float*)d_in[17]; p.final_norm_g = (const float*)d_in[18];
  p.out = (float*)d_out;
  char* w = (char*)d_ws; size_t off = 0;
  auto carve = [&](size_t bytes) { char* r = w + off; off += (bytes + 255) & ~(size_t)255; return r; };
  p.hn = (bf16_t*)carve((size_t)NTOK * DM * 2);
  p.z = (bf16_t*)carve((size_t)NTOK * ZLD * 2);
  p.qd = (bf16_t*)carve((size_t)NTOK * 384 * 2);
  p.pb = (bf16_t*)carve((size_t)2 * NTOK * 256 * 2);
  p.kvd = (bf16_t*)carve((size_t)NTOK * 512 * 2);
  p.winT = (bf16_t*)carve((size_t)2 * DINP * DM * 2);
  p.wuqT = (bf16_t*)carve((size_t)2 * 384 * 256 * 2);
  p.wukvT = (bf16_t*)carve((size_t)2 * 512 * 128 * 2);
  p.woutT = (bf16_t*)carve((size_t)2 * DM * DM * 2);
  p.wpgT = (bf16_t*)carve((size_t)2 * DM * DM * 2);
  p.wppT = (bf16_t*)carve((size_t)2 * DM * 256 * 2);
  p.cs32 = (float2*)carve((size_t)8192 * 16 * 8);
  p.cs64 = (float2*)carve((size_t)8192 * 32 * 8);
  p.lam = (float*)carve(256);
  p.bar = (unsigned*)carve((size_t)XCD_BAR_WORDS * 4);
  p.xpart = (unsigned*)carve((size_t)4 * 320 * 4 * 256 * 4);
  p.xcnt = (unsigned*)carve((size_t)4 * 320 * 4);
  if (off > ws_size) { fprintf(stderr, "workspace too small: need %zu have %zu\n", off, ws_size); return; }
  static int grid_blocks = 0;
  if (!grid_blocks) {
    int dev = 0, cus = 0, per_cu = 0;
    hipGetDevice(&dev);
    hipDeviceGetAttribute(&cus, hipDeviceAttributeMultiprocessorCount, dev);
    hipOccupancyMaxActiveBlocksPerMultiprocessor(&per_cu, mega_fwd, NTHR, 0);
    if (per_cu > 1) per_cu = 1;
    if (per_cu < 1) per_cu = 1;
    grid_blocks = cus * per_cu;
  }
  void* args[] = {&p};
  hipError_t e = hipLaunchCooperativeKernel((void*)mega_fwd, dim3(grid_blocks), dim3(NTHR), args, 0, stream);
  if (e != hipSuccess) fprintf(stderr, "cooperative launch failed: %s (grid %d)\n", hipGetErrorString(e), grid_blocks);
}
```

```cpp
#include <hip/hip_runtime.h>
#include <hip/hip_cooperative_groups.h>
#include <stdint.h>
#include <stdio.h>
namespace cg = cooperative_groups;

typedef __attribute__((ext_vector_type(8))) short bf16x8;
typedef __attribute__((ext_vector_type(4))) short s16x4;
typedef __attribute__((ext_vector_type(16))) float f32x16;
typedef short v4i16_t __attribute__((ext_vector_type(4)));
typedef __bf16 bf16v2 __attribute__((ext_vector_type(2)));
typedef unsigned short bf16_t;
typedef unsigned u32x4 __attribute__((ext_vector_type(4)));
typedef float f32x2 __attribute__((ext_vector_type(2)));
typedef float f32x4 __attribute__((ext_vector_type(4)));
typedef __attribute__((address_space(3))) unsigned* lds_uptr;
typedef __attribute__((address_space(3))) const char* lds_cptr;

#define DI __device__ __forceinline__
#define MFMA(a, b, c) __builtin_amdgcn_mfma_f32_32x32x16_bf16((a), (b), (c), 0, 0, 0)

constexpr int NTOK = 81920, NPROMPT = 65536, DM = 1024, DIN = 3488, DINP = 3584, ZLD = 3488;
constexpr int Z_AQ = 0, Z_AK = 256, Z_AV = 512, Z_BQ = 768, Z_BK = 1024, Z_BV = 1152, Z_CQ = 1280, Z_CK = 1536, Z_CV = 1792,
              Z_DCQ = 2048, Z_DCKV = 2304, Z_DKR = 2432, Z_GATE = 2464;
constexpr float LOG2E = 1.4426950408889634f;
constexpr float SCALE_A = 0.17677669529663687f * LOG2E;
constexpr float SCALE_B = 0.125f * LOG2E;
constexpr float SCALE_C = 0.125f * LOG2E;
constexpr float SCALE_D = 0.10206207261596575f * LOG2E;
constexpr float EPS = 1e-6f;

constexpr int G_ROWB = 144;
constexpr int G_TILEB = 256 * G_ROWB;
constexpr int SM_RS = 4 * G_TILEB;
constexpr int SM_BIAS = 46080;
constexpr int SM_XB = SM_RS + 1024;
constexpr int SMEM_BYTES = SM_XB + 16;
constexpr int NTHR = 512;
#define XCD_BAR_WORDS 3456

struct Params {
  const float* x_prompt; const float* x_sample; const float* p_prompt; const float* p_sample;
  const float* norm_g; const float* w_in; const float* a_lambda; const float* a_subln_g; const float* b_sink; const float* c_rpb;
  const float* d_q_norm_g; const float* d_kv_norm_g; const float* d_w_uq; const float* d_w_ukv; const float* w_out; const float* ple_norm_g;
  const float* w_ple_gate; const float* w_ple_proj; const float* final_norm_g;
  float* out;
  bf16_t* hn;
  bf16_t* z;
  bf16_t* qd;
  bf16_t* pb;
  bf16_t* kvd;
  bf16_t* winT; bf16_t* wuqT; bf16_t* wukvT; bf16_t* woutT; bf16_t* wpgT; bf16_t* wppT;
  float2* cs32; float2* cs64; float* lam;
  unsigned* xpart;
  unsigned* xcnt;
  unsigned* bar;
};

DI unsigned cvtpk(float lo, float hi) { bf16v2 v = {(__bf16)lo, (__bf16)hi}; return __builtin_bit_cast(unsigned, v); }
DI bf16_t f2bf(float x) { __bf16 b = (__bf16)x; return __builtin_bit_cast(bf16_t, b); }
DI float bf2f(unsigned v16) { return __uint_as_float(v16 << 16); }
DI float bflo(unsigned u) { return __uint_as_float(u << 16); }
DI float bfhi(unsigned u) { return __uint_as_float(u & 0xffff0000u); }
DI int otid() { int t = threadIdx.x; asm volatile("" : "+v"(t)); return t; }
DI int crow(int i, int h) { return (i & 3) + 8 * (i >> 2) + 4 * h; }
DI float ex2(float x) { return __builtin_amdgcn_exp2f(x); }
DI float sigm(float x) { return 1.f / (1.f + __expf(-x)); }
DI const float* xrow(const Params& p, int row) { return row < NPROMPT ? p.x_prompt + (size_t)row * DM : p.x_sample + (size_t)(row - NPROMPT) * DM; }
DI int pos_of(int row) { return row < NPROMPT ? (row & 8191) : (row & 4095); }
DI int pos_mask(int m0) { return m0 < NPROMPT ? 8191 : 4095; }
DI float swap_max(float m) { auto rr = __builtin_amdgcn_permlane32_swap(__float_as_uint(m), __float_as_uint(m), false, false); return fmaxf(__uint_as_float(rr[0]), __uint_as_float(rr[1])); }
DI float swap_sum(float m) { auto rr = __builtin_amdgcn_permlane32_swap(__float_as_uint(m), __float_as_uint(m), false, false); return __uint_as_float(rr[0]) + __uint_as_float(rr[1]); }
DI s16x4 vtr(const char* p) { return __builtin_bit_cast(s16x4, __builtin_amdgcn_ds_read_tr16_b64_v4i16((__attribute__((address_space(3))) v4i16_t*)(lds_cptr)p)); }

DI void transpose_tile(const float* __restrict__ W, int K, int N, bf16_t* __restrict__ WT, const float* __restrict__ gfold, int tile, char* smem) {
  const int kt = K >> 6;
  const int n0 = (tile / kt) * 64, k0 = (tile % kt) * 64;
  float* t = (float*)smem;
  const int tid = otid();
  __syncthreads();
  if (tid < 256) {
    const int nn = tid & 63, kb = tid >> 6;
#pragma unroll
    for (int i = 0; i < 16; ++i) {
      const int kk = kb + 4 * i;
      float v = 0.f;
      if (n0 + nn < N) { v = W[(size_t)(k0 + kk) * N + n0 + nn]; if (gfold) v *= gfold[k0 + kk]; }
      t[kk * 65 + nn] = v;
    }
  }
  __syncthreads();
  if (tid < 256) {
    const int nl = tid >> 2, kq = (tid & 3) * 16;
    unsigned u[8];
#pragma unroll
    for (int j = 0; j < 8; ++j) u[j] = cvtpk(t[(kq + 2 * j) * 65 + nl], t[(kq + 2 * j + 1) * 65 + nl]);
    uint4* dst = (uint4*)(WT + (size_t)(n0 + nl) * K + k0 + kq);
    dst[0] = make_uint4(u[0], u[1], u[2], u[3]);
    dst[1] = make_uint4(u[4], u[5], u[6], u[7]);
  }
}

DI void phase_prep(const Params& p, char* smem) {
  for (int v = blockIdx.x; v < 2 * 1512; v += gridDim.x) {
    const int layer = v / 1512; int t = v % 1512;
    if (t < 896) { transpose_tile(p.w_in + (size_t)layer * DM * DIN, DM, DIN, p.winT + (size_t)layer * DINP * DM, nullptr, t, smem); continue; }
    t -= 896;
    if (t < 24) { transpose_tile(p.d_w_uq + (size_t)layer * 256 * 384, 256, 384, p.wuqT + (size_t)layer * 384 * 256, p.d_q_norm_g + layer * 256, t, smem); continue; }
    t -= 24;
    if (t < 16) { transpose_tile(p.d_w_ukv + (size_t)layer * 128 * 512, 128, 512, p.wukvT + (size_t)layer * 512 * 128, p.d_kv_norm_g + layer * 128, t, smem); continue; }
    t -= 16;
    if (t < 256) { transpose_tile(p.w_out + (size_t)layer * DM * DM, DM, DM, p.woutT + (size_t)layer * DM * DM, nullptr, t, smem); continue; }
    t -= 256;
    if (t < 256) { transpose_tile(p.w_ple_gate + (size_t)layer * DM * DM, DM, DM, p.wpgT + (size_t)layer * DM * DM, nullptr, t, smem); continue; }
    t -= 256;
    transpose_tile(p.w_ple_proj + (size_t)layer * 256 * DM, 256, DM, p.wppT + (size_t)layer * DM * 256, nullptr, t, smem);
  }
  const int gt = blockIdx.x * NTHR + otid(), nt = gridDim.x * NTHR;
  for (int i = gt; i < XCD_BAR_WORDS; i += nt) p.bar[i] = 0u;
  for (int i = gt; i < 4 * 320; i += nt) p.xcnt[i] = 0u;
  for (int i = gt; i < 8192 * 48; i += nt) {
    int pos, f, dim; float2* dst;
    if (i < 8192 * 16) { pos = i >> 4; f = i & 15; dim = 32; dst = p.cs32 + i; }
    else { const int j = i - 8192 * 16; pos = j >> 5; f = j & 31; dim = 64; dst = p.cs64 + j; }
    const float inv = exp2f(-(float)(2 * f) / (float)dim * 13.287712379549449f);
    const double ang = (double)pos * (double)inv;
    double rev = ang * 0.15915494309189535;
    rev = rev - __builtin_rint(rev);
    const float fr = (float)rev;
    *dst = make_float2(__builtin_amdgcn_cosf(fr), __builtin_amdgcn_sinf(fr));
  }
  if (blockIdx.x == 0 && threadIdx.x < 2) {
    const int layer = threadIdx.x;
    const float* lv = p.a_lambda + layer * 128;
    float s1 = 0.f, s2 = 0.f;
    for (int i = 0; i < 32; ++i) { s1 += lv[i] * lv[32 + i]; s2 += lv[64 + i] * lv[96 + i]; }
    const float lam_init = 0.8f - 0.6f * expf(-0.3f * (float)layer);
    p.lam[layer] = expf(s1) - expf(s2) + lam_init;
  }
}

DI void phase_norm(const Params& p, int layer, int kind) {
  const int tid_ = otid(); const int lane = tid_ & 63, wave = __builtin_amdgcn_readfirstlane(tid_ >> 6);
  const float* g = kind == 0 ? p.norm_g + layer * DM : (kind == 1 ? p.ple_norm_g + layer * DM : p.final_norm_g);
  float4 g4[4];
#pragma unroll
  for (int j = 0; j < 4; ++j) g4[j] = ((const float4*)g)[lane + 64 * j];
  for (int row = blockIdx.x * 8 + wave; row < NTOK; row += gridDim.x * 8) {
    const float* src = (kind == 0 && layer == 0) ? xrow(p, row) : p.out + (size_t)row * DM;
    float4 v[4];
#pragma unroll
    for (int j = 0; j < 4; ++j) v[j] = ((const float4*)src)[lane + 64 * j];
    float ss = 0.f;
#pragma unroll
    for (int j = 0; j < 4; ++j) ss += v[j].x * v[j].x + v[j].y * v[j].y + v[j].z * v[j].z + v[j].w * v[j].w;
#pragma unroll
    for (int o = 32; o >= 1; o >>= 1) ss += __shfl_xor(ss, o);
    const float rs = rsqrtf(ss * (1.f / 1024.f) + EPS);
    if (kind == 2) {
      float4* dst = (float4*)(p.out + (size_t)row * DM);
#pragma unroll
      for (int j = 0; j < 4; ++j) dst[lane + 64 * j] = make_float4(v[j].x * rs * g4[j].x, v[j].y * rs * g4[j].y, v[j].z * rs * g4[j].z, v[j].w * rs * g4[j].w);
    } else {
      uint2* dst = (uint2*)(p.hn + (size_t)row * DM);
#pragma unroll
      for (int j = 0; j < 4; ++j) dst[lane + 64 * j] = make_uint2(cvtpk(v[j].x * rs * g4[j].x, v[j].y * rs * g4[j].y), cvtpk(v[j].z * rs * g4[j].z, v[j].w * rs * g4[j].w));
      if (kind == 0) {
#pragma unroll
        for (int l = 0; l < 2; ++l) {
          const float* ps = row < NPROMPT ? p.p_prompt + ((size_t)l * NPROMPT + row) * 256 : p.p_sample + ((size_t)l * (NTOK - NPROMPT) + (row - NPROMPT)) * 256;
          const float4 pv = ((const float4*)ps)[lane];
          ((uint2*)(p.pb + ((size_t)l * NTOK + row) * 256))[lane] = make_uint2(cvtpk(pv.x, pv.y), cvtpk(pv.z, pv.w));
        }
      }
    }
  }
}

DI void gemm_core(const bf16_t* __restrict__ A, int lda, const bf16_t* __restrict__ W, int ldw, int K, f32x16 (&acc)[4][2], char* smem) {
  const int tid = otid(), lane = tid & 63, wave = __builtin_amdgcn_readfirstlane(tid >> 6), wm = wave >> 2, wn = wave & 3, r = lane & 31, h = lane >> 5;
  const int lrow = tid >> 3, lcc = tid & 7;
  const char* ag = (const char*)(A + (size_t)lrow * lda + lcc * 8);
  const char* wg = (const char*)(W + (size_t)lrow * ldw + lcc * 8);
  const size_t astep = (size_t)64 * lda * 2, wstep = (size_t)64 * ldw * 2;
  char* As = smem; char* Bs = smem + 2 * G_TILEB;
  const int soff = lrow * G_ROWB + lcc * 16;
  u32x4 ra[4], rb[4];
#pragma unroll
  for (int i = 0; i < 4; ++i) { ra[i] = *(const u32x4*)(ag + i * astep); rb[i] = *(const u32x4*)(wg + i * wstep); }
#pragma unroll
  for (int i = 0; i < 4; ++i) { *(u32x4*)(As + soff + i * 64 * G_ROWB) = ra[i]; *(u32x4*)(Bs + soff + i * 64 * G_ROWB) = rb[i]; }
  __syncthreads();
  const int nk = K >> 6;
  const int aoff = (wm * 128 + r) * G_ROWB + h * 16;
  const int boff = (wn * 64 + r) * G_ROWB + h * 16;
#pragma unroll 1
  for (int kt = 0; kt < nk; ++kt) {
    const int cur = kt & 1;
    if (kt + 1 < nk) {
#pragma unroll
      for (int i = 0; i < 4; ++i) { ra[i] = *(const u32x4*)(ag + i * astep + (size_t)(kt + 1) * 128); rb[i] = *(const u32x4*)(wg + i * wstep + (size_t)(kt + 1) * 128); }
    }
    const char* Ac = As + cur * G_TILEB + aoff; const char* Bc = Bs + cur * G_TILEB + boff;
#pragma unroll
    for (int ks = 0; ks < 4; ++ks) {
      const bf16x8 b0 = *(const bf16x8*)(Bc + ks * 32), b1 = *(const bf16x8*)(Bc + 32 * G_ROWB + ks * 32);
#pragma unroll
      for (int ti = 0; ti < 4; ++ti) {
        const bf16x8 a = *(const bf16x8*)(Ac + ti * 32 * G_ROWB + ks * 32);
        acc[ti][0] = MFMA(b0, a, acc[ti][0]); acc[ti][1] = MFMA(b1, a, acc[ti][1]);
      }
    }
    if (kt + 1 < nk) {
      const int nb = cur ^ 1;
#pragma unroll
      for (int i = 0; i < 4; ++i) { *(u32x4*)(As + nb * G_TILEB + soff + i * 64 * G_ROWB) = ra[i]; *(u32x4*)(Bs + nb * G_TILEB + soff + i * 64 * G_ROWB) = rb[i]; }
    }
    __syncthreads();
  }
}

DI void zero_acc(f32x16 (&acc)[4][2]) {
#pragma unroll
  for (int a = 0; a < 4; ++a)
#pragma unroll
    for (int b = 0; b < 2; ++b) acc[a][b] = f32x16{};
}

DI uint2 pack4(float a, float b, float c, float d) { return make_uint2(cvtpk(a, b), cvtpk(c, d)); }
DI void rope_quad(const float2* cs, const f32x16& t1, const f32x16& t2, int q1, int q2, float sc, bf16_t* d1, bf16_t* d2) {
  const float4 c01 = ((const float4*)cs)[0], c23 = ((const float4*)cs)[1];
  const float c[4] = {c01.x, c01.z, c23.x, c23.z}, sn[4] = {c01.y, c01.w, c23.y, c23.w};
  float o1[4], o2[4];
#pragma unroll
  for (int j = 0; j < 4; ++j) {
    const float x1 = t1[q1 * 4 + j], x2 = t2[q2 * 4 + j];
    o1[j] = (x1 * c[j] - x2 * sn[j]) * sc; o2[j] = (x2 * c[j] + x1 * sn[j]) * sc;
  }
  *(uint2*)d1 = pack4(o1[0], o1[1], o1[2], o1[3]);
  *(uint2*)d2 = pack4(o2[0], o2[1], o2[2], o2[3]);
}

DI void g8_stage_rc(int b, int& R, int& C) {
  const int st = b / 1024, sb = b % 1024, swz = sb ^ (((sb >> 9) & 1) << 5);
  R = (st >> 1) * 16 + swz / 64; C = (st & 1) * 32 + (swz % 64) / 2;
}
#define G8_MFMA(a, b, c) __builtin_amdgcn_mfma_f32_16x16x32_bf16((a), (b), (c), 0, 0, 0)
template <bool STAGE0_ONLY>
DI void gemm8_impl(const bf16_t* __restrict__ P, int ldp, const bf16_t* __restrict__ Q, int ldq, int K, f32x4 (&acc)[2][2][4][2], char* smem, bool staged) {
  const int tid = otid(), lane = tid & 63, wid = __builtin_amdgcn_readfirstlane(tid >> 6), wr = wid >> 2, wc = wid & 3, fr = lane & 15, fq = lane >> 4;
  int r0, c0;
  g8_stage_rc(tid * 16, r0, c0);
  const unsigned pof = (unsigned)(r0 * ldp + c0) * 2u, qof = (unsigned)(r0 * ldq + c0) * 2u;
  const char* const Pb = (const char*)P; const char* const Qb = (const char*)Q;
  char* const sdst = smem + tid * 16;
  const int ob = fr * 64 + fq * 16, obs = ob ^ (((ob >> 9) & 1) << 5);
  const char* const ard = smem + wr * 8192 + obs;
  const char* const brd = smem + wc * 4096 + obs;
#define G8_SA(b, hh) (((b) * 2 + (hh)) * 16384)
#define G8_SB(b, hh) ((4 + (b) * 2 + (hh)) * 16384)
#define G8_STAGE_P(b, hh, kt) { const char* u_ = Pb + ((size_t)((hh) * 128) * ldp + (size_t)(kt) * 64) * 2;                \
    __builtin_amdgcn_global_load_lds((const unsigned*)(u_ + pof), (lds_uptr)(sdst + G8_SA(b, hh)), 16, 0, 0);               \
    __builtin_amdgcn_global_load_lds((const unsigned*)(u_ + (size_t)ldp * 128 + pof), (lds_uptr)(sdst + G8_SA(b, hh) + 8192), 16, 0, 0); }
#define G8_STAGE_Q(b, hh, kt) { const char* u_ = Qb + ((size_t)((hh) * 128) * ldq + (size_t)(kt) * 64) * 2;                \
    __builtin_amdgcn_global_load_lds((const unsigned*)(u_ + qof), (lds_uptr)(sdst + G8_SB(b, hh)), 16, 0, 0);               \
    __builtin_amdgcn_global_load_lds((const unsigned*)(u_ + (size_t)ldq * 128 + qof), (lds_uptr)(sdst + G8_SB(b, hh) + 8192), 16, 0, 0); }
#define G8_LDA(dst, b, hh) _Pragma("unroll") for (int m = 0; m < 4; ++m) _Pragma("unroll") for (int k = 0; k < 2; ++k) \
    dst[m][k] = *(const bf16x8*)(ard + G8_SA(b, hh) + m * 2048 + k * 1024)
#define G8_LDB(dst, b, hh) _Pragma("unroll") for (int n = 0; n < 2; ++n) _Pragma("unroll") for (int k = 0; k < 2; ++k) \
    dst[n][k] = *(const bf16x8*)(brd + G8_SB(b, hh) + n * 2048 + k * 1024)
#define G8_MMA(ai, bj, At_, Bt_) do { __builtin_amdgcn_s_setprio(1);                                                      \
    _Pragma("unroll") for (int m = 0; m < 4; ++m) _Pragma("unroll") for (int n = 0; n < 2; ++n) _Pragma("unroll") for (int k = 0; k < 2; ++k) \
      acc[ai][bj][m][n] = G8_MFMA(At_[m][k], Bt_[n][k], acc[ai][bj][m][n]);                                                \
    __builtin_amdgcn_s_setprio(0); } while (0)
#define G8_WAIT_V(n) asm volatile("s_waitcnt vmcnt(" #n ")" ::: "memory")
#define G8_WAIT_L(n) asm volatile("s_waitcnt lgkmcnt(" #n ")" ::: "memory")
#define G8_BAR __builtin_amdgcn_s_barrier()
#define G8_SCHED __builtin_amdgcn_sched_barrier(0)
  bf16x8 At[4][2], B0[2][2], B1[2][2];
  const int nt = K >> 6;
  if (STAGE0_ONLY) {
    G8_STAGE_Q(0, 0, 0); G8_STAGE_P(0, 0, 0);
    G8_STAGE_Q(0, 1, 0); G8_STAGE_P(0, 1, 0);
    return;
  }
  if (!staged) {
    __syncthreads();
    G8_STAGE_Q(0, 0, 0); G8_STAGE_P(0, 0, 0);
    G8_STAGE_Q(0, 1, 0); G8_STAGE_P(0, 1, 0);
  }
  if (wr == 1) G8_BAR;
  G8_WAIT_V(4); G8_BAR;
  G8_STAGE_Q(1, 0, 1); G8_STAGE_P(1, 0, 1); G8_STAGE_Q(1, 1, 1);
  G8_WAIT_V(6); G8_BAR;
#pragma unroll 1
  for (int t = 0; t < nt - 2; t += 2) {
    G8_LDB(B0, 0, 0); G8_SCHED; G8_LDA(At, 0, 0); G8_STAGE_P(1, 1, t + 1);
    G8_WAIT_L(8); G8_BAR; G8_WAIT_L(0); G8_MMA(0, 0, At, B0); G8_BAR; G8_SCHED;
    G8_LDB(B1, 0, 1); G8_STAGE_Q(0, 0, t + 2);
    G8_BAR; G8_WAIT_L(0); G8_MMA(0, 1, At, B1); G8_BAR;
    G8_LDA(At, 0, 1); G8_STAGE_P(0, 0, t + 2);
    G8_BAR; G8_WAIT_L(0); G8_MMA(1, 0, At, B0); G8_BAR; G8_SCHED;
    G8_STAGE_Q(0, 1, t + 2);
    G8_WAIT_V(6); G8_BAR; G8_MMA(1, 1, At, B1); G8_BAR;
    G8_LDB(B0, 1, 0); G8_SCHED; G8_LDA(At, 1, 0); G8_STAGE_P(0, 1, t + 2);
    G8_WAIT_L(8); G8_BAR; G8_WAIT_L(0); G8_MMA(0, 0, At, B0); G8_BAR; G8_SCHED;
    G8_LDB(B1, 1, 1); G8_STAGE_Q(1, 0, t + 3);
    G8_BAR; G8_WAIT_L(0); G8_MMA(0, 1, At, B1); G8_BAR;
    G8_LDA(At, 1, 1); G8_STAGE_P(1, 0, t + 3);
    G8_BAR; G8_WAIT_L(0); G8_MMA(1, 0, At, B0); G8_BAR; G8_SCHED;
    G8_STAGE_Q(1, 1, t + 3);
    G8_WAIT_V(6); G8_BAR; G8_MMA(1, 1, At, B1); G8_BAR;
  }
  { G8_LDB(B0, 0, 0); G8_LDA(At, 0, 0); G8_STAGE_P(1, 1, nt - 1);
    G8_BAR; G8_WAIT_L(0); G8_MMA(0, 0, At, B0); G8_BAR;
    G8_LDB(B1, 0, 1); G8_BAR; G8_WAIT_L(0); G8_MMA(0, 1, At, B1); G8_BAR;
    G8_LDA(At, 0, 1); G8_WAIT_V(4); G8_BAR; G8_WAIT_L(0); G8_MMA(1, 0, At, B0); G8_MMA(1, 1, At, B1); G8_BAR; }
  { G8_LDB(B0, 1, 0); G8_LDA(At, 1, 0); G8_WAIT_V(2); G8_BAR; G8_WAIT_L(0); G8_MMA(0, 0, At, B0); G8_BAR;
    G8_LDB(B1, 1, 1); G8_WAIT_V(0); G8_BAR; G8_WAIT_L(0); G8_MMA(0, 1, At, B1); G8_BAR;
    G8_LDA(At, 1, 1); G8_BAR; G8_WAIT_L(0); G8_MMA(1, 0, At, B0); G8_MMA(1, 1, At, B1); G8_BAR; }
  if (wr == 0) G8_BAR;
#undef G8_SA
#undef G8_SB
#undef G8_STAGE_P
#undef G8_STAGE_Q
#undef G8_LDA
#undef G8_LDB
#undef G8_MMA
#undef G8_WAIT_V
#undef G8_WAIT_L
#undef G8_BAR
#undef G8_SCHED
}

DI void gemm8(const bf16_t* P, int ldp, const bf16_t* Q, int ldq, int K, f32x4 (&acc)[2][2][4][2], char* smem, bool staged) {
  gemm8_impl<false>(P, ldp, Q, ldq, K, acc, smem, staged);
}
DI void gemm8_stage0(const bf16_t* P, int ldp, const bf16_t* Q, int ldq, f32x4 (&acc)[2][2][4][2], char* smem) {
  gemm8_impl<true>(P, ldp, Q, ldq, 256, acc, smem, false);
}
struct NextTile { const bf16_t* P; const bf16_t* Q; int ldp; int ldq; bool has; };
DI void zero_acc8(f32x4 (&acc)[2][2][4][2]) {
#pragma unroll
  for (int a = 0; a < 2; ++a)
#pragma unroll
    for (int b = 0; b < 2; ++b)
#pragma unroll
      for (int m = 0; m < 4; ++m)
#pragma unroll
        for (int n = 0; n < 2; ++n) acc[a][b][m][n] = f32x4{0.f, 0.f, 0.f, 0.f};
}
DI uint2 pack4v(f32x4 v, float sc) { return make_uint2(cvtpk(v[0] * sc, v[1] * sc), cvtpk(v[2] * sc, v[3] * sc)); }
DI void rope_quad4(const float2* cs, f32x4 x1, f32x4 x2, float sc, bf16_t* d1, bf16_t* d2) {
  const float4 c01 = ((const float4*)cs)[0], c23 = ((const float4*)cs)[1];
  const float c[4] = {c01.x, c01.z, c23.x, c23.z}, sn[4] = {c01.y, c01.w, c23.y, c23.w};
  float o1[4], o2[4];
#pragma unroll
  for (int j = 0; j < 4; ++j) { o1[j] = (x1[j] * c[j] - x2[j] * sn[j]) * sc; o2[j] = (x2[j] * c[j] + x1[j] * sn[j]) * sc; }
  *(uint2*)d1 = pack4(o1[0], o1[1], o1[2], o1[3]);
  *(uint2*)d2 = pack4(o2[0], o2[1], o2[2], o2[3]);
}

DI void inproj_tile(const Params& p, int layer, int tm, int tn, char* smem, bool staged, const NextTile& nx) {
  f32x4 acc[2][2][4][2]; zero_acc8(acc);
  const int m0 = tm * 256, n0 = tn * 256;
  gemm8(p.winT + ((size_t)layer * DINP + n0) * DM, DM, p.hn + (size_t)m0 * DM, DM, DM, acc, smem, staged);
  if (nx.has) gemm8_stage0(nx.P, nx.ldp, nx.Q, nx.ldq, acc, smem);
  const int tid_ = otid(); const int lane = tid_ & 63, wid = __builtin_amdgcn_readfirstlane(tid_ >> 6), wr = wid >> 2, wc = wid & 3, fr = lane & 15, fq = lane >> 4;
  const int pmask = pos_mask(m0);
#pragma unroll
  for (int bj = 0; bj < 2; ++bj)
#pragma unroll
    for (int n = 0; n < 2; ++n) {
      const int row = m0 + bj * 128 + wc * 32 + n * 16 + fr;
      const int pos = row & pmask;
      bf16_t* zrow = p.z + (size_t)row * ZLD;
#pragma unroll
      for (int ai = 0; ai < 2; ++ai) {
        const int fb = n0 + ai * 128 + wr * 64;
        if (fb >= Z_BQ && fb < Z_BV) {
          const float sc = fb < Z_BK ? SCALE_B : 1.f;
#pragma unroll
          for (int m = 0; m < 2; ++m) {
            const int f0 = m * 16 + fq * 4;
            rope_quad4(p.cs64 + pos * 32 + f0, acc[ai][bj][m][n], acc[ai][bj][m + 2][n], sc, zrow + fb + f0, zrow + fb + 32 + f0);
          }
        } else {
#pragma unroll
          for (int tj = 0; tj < 2; ++tj) {
            const int n32 = fb + tj * 32;
            if (n32 >= DIN) continue;
            const bool rope = (n32 < Z_AV) || (n32 == Z_DKR);
            const float sc = (n32 < Z_AK) ? SCALE_A : ((n32 >= Z_CQ && n32 < Z_CK) ? SCALE_C : 1.f);
            if (rope) {
              rope_quad4(p.cs32 + pos * 16 + fq * 4, acc[ai][bj][2 * tj][n], acc[ai][bj][2 * tj + 1][n], sc, zrow + n32 + fq * 4, zrow + n32 + 16 + fq * 4);
            } else {
              *(uint2*)(zrow + n32 + fq * 4) = pack4v(acc[ai][bj][2 * tj][n], sc);
              *(uint2*)(zrow + n32 + 16 + fq * 4) = pack4v(acc[ai][bj][2 * tj + 1][n], sc);
            }
          }
        }
      }
    }
}

DI void tile_rs(const bf16_t* A, int lda, int K, float* rsv) {
  const int t = otid();
  const uint4* src = (const uint4*)(A + (size_t)(t >> 1) * lda + (t & 1) * (K >> 1));
  float ss = 0.f;
  for (int c = 0; c < (K >> 4); ++c) {
    const uint4 u = src[c];
    ss += bflo(u.x) * bflo(u.x) + bfhi(u.x) * bfhi(u.x) + bflo(u.y) * bflo(u.y) + bfhi(u.y) * bfhi(u.y)
        + bflo(u.z) * bflo(u.z) + bfhi(u.z) * bfhi(u.z) + bflo(u.w) * bflo(u.w) + bfhi(u.w) * bfhi(u.w);
  }
  ss += __shfl_xor(ss, 1);
  if ((t & 1) == 0) rsv[t >> 1] = rsqrtf(ss / (float)K + EPS);
}

DI void upproj_tile(const Params& p, int layer, int tm, int sel, char* smem) {
  const int m0 = tm * 256;
  const int pmask = pos_mask(m0);
  float* rsv = (float*)(smem + SM_RS);
  const int tid_ = otid(); const int lane = tid_ & 63, wave = __builtin_amdgcn_readfirstlane(tid_ >> 6), wm = wave >> 2, wn = wave & 3, r = lane & 31, h = lane >> 5;
  f32x16 acc[4][2]; zero_acc(acc);
  __syncthreads();
  if (sel < 2) {
    const int n0 = sel * 256;
    const bf16_t* A = p.z + (size_t)m0 * ZLD + Z_DCQ;
    tile_rs(A, ZLD, 256, rsv);
    gemm_core(A, ZLD, p.wuqT + ((size_t)layer * 384 + n0) * 256, 256, 256, acc, smem);
#pragma unroll
    for (int ti = 0; ti < 4; ++ti) {
      const int rl = wm * 128 + ti * 32 + r, row = m0 + rl;
      const float rsc = rsv[rl] * SCALE_D;
      bf16_t* qrow = p.qd + (size_t)row * 384;
#pragma unroll
      for (int tj = 0; tj < 2; ++tj) {
        const int n = n0 + wn * 64 + tj * 32;
        if (n >= 384) continue;
        if ((n % 96) == 64) {
#pragma unroll
          for (int g = 0; g < 2; ++g) {
            const int f0 = 8 * g + 4 * h;
            rope_quad(p.cs32 + (row & pmask) * 16 + f0, acc[ti][tj], acc[ti][tj], g, g + 2, rsc, qrow + n + f0, qrow + n + 16 + f0);
          }
        } else {
#pragma unroll
          for (int g = 0; g < 4; ++g)
            *(uint2*)(qrow + n + 8 * g + 4 * h) = pack4(acc[ti][tj][4 * g] * rsc, acc[ti][tj][4 * g + 1] * rsc, acc[ti][tj][4 * g + 2] * rsc, acc[ti][tj][4 * g + 3] * rsc);
        }
      }
    }
  } else {
    const int n0 = (sel - 2) * 256;
    const bf16_t* A = p.z + (size_t)m0 * ZLD + Z_DCKV;
    tile_rs(A, ZLD, 128, rsv);
    gemm_core(A, ZLD, p.wukvT + ((size_t)layer * 512 + n0) * 128, 128, 128, acc, smem);
#pragma unroll
    for (int ti = 0; ti < 4; ++ti) {
      const int rl = wm * 128 + ti * 32 + r, row = m0 + rl;
      const float rsc = rsv[rl];
      bf16_t* krow = p.kvd + (size_t)row * 512 + n0 + wn * 64;
#pragma unroll
      for (int tj = 0; tj < 2; ++tj)
#pragma unroll
        for (int g = 0; g < 4; ++g)
          *(uint2*)(krow + tj * 32 + 8 * g + 4 * h) = pack4(acc[ti][tj][4 * g] * rsc, acc[ti][tj][4 * g + 1] * rsc, acc[ti][tj][4 * g + 2] * rsc, acc[ti][tj][4 * g + 3] * rsc);
    }
  }
}

DI void outproj_tile(const Params& p, int layer, int tm, int tn, char* smem, bool staged, const NextTile& nx) {
  f32x4 acc[2][2][4][2]; zero_acc8(acc);
  const int m0 = tm * 256, n0 = tn * 256;
  gemm8(p.woutT + ((size_t)layer * DM + n0) * DM, DM, p.hn + (size_t)m0 * DM, DM, DM, acc, smem, staged);
  if (nx.has) gemm8_stage0(nx.P, nx.ldp, nx.Q, nx.ldq, acc, smem);
  const int tid_ = otid(); const int lane = tid_ & 63, wid = __builtin_amdgcn_readfirstlane(tid_ >> 6), wr = wid >> 2, wc = wid & 3, fr = lane & 15, fq = lane >> 4;
#pragma unroll
  for (int bj = 0; bj < 2; ++bj)
#pragma unroll
    for (int n = 0; n < 2; ++n) {
      const int row = m0 + bj * 128 + wc * 32 + n * 16 + fr;
      const float* hrow = (layer == 0 ? xrow(p, row) : p.out + (size_t)row * DM) + n0 + wr * 64 + fq * 4;
      float* orow = p.out + (size_t)row * DM + n0 + wr * 64 + fq * 4;
#pragma unroll
      for (int ai = 0; ai < 2; ++ai)
#pragma unroll
        for (int m = 0; m < 4; ++m) {
          const float4 hv = *(const float4*)(hrow + ai * 128 + m * 16);
          const f32x4 a = acc[ai][bj][m][n];
          *(float4*)(orow + ai * 128 + m * 16) = make_float4(hv.x + a[0], hv.y + a[1], hv.z + a[2], hv.w + a[3]);
        }
    }
}

DI void pproj_tile(const Params& p, int layer, int tm, int tn, char* smem, bool staged, const NextTile& nx) {
  f32x4 acc[2][2][4][2]; zero_acc8(acc);
  const int m0 = tm * 256, n0 = tn * 256;
  gemm8(p.wppT + ((size_t)layer * DM + n0) * 256, 256, p.pb + ((size_t)layer * NTOK + m0) * 256, 256, 256, acc, smem, staged);
  if (nx.has) gemm8_stage0(nx.P, nx.ldp, nx.Q, nx.ldq, acc, smem);
  const int tid_ = otid(); const int lane = tid_ & 63, wid = __builtin_amdgcn_readfirstlane(tid_ >> 6), wr = wid >> 2, wc = wid & 3, fr = lane & 15, fq = lane >> 4;
#pragma unroll
  for (int bj = 0; bj < 2; ++bj)
#pragma unroll
    for (int n = 0; n < 2; ++n) {
      const int row = m0 + bj * 128 + wc * 32 + n * 16 + fr;
      bf16_t* prow = p.z + (size_t)row * DM + n0 + wr * 64 + fq * 4;
#pragma unroll
      for (int ai = 0; ai < 2; ++ai)
#pragma unroll
        for (int m = 0; m < 4; ++m) *(uint2*)(prow + ai * 128 + m * 16) = pack4v(acc[ai][bj][m][n], 1.f);
    }
}

DI void ple_tile(const Params& p, int layer, int tm, int tn, char* smem, bool staged, const NextTile& nx) {
  f32x4 acc[2][2][4][2]; zero_acc8(acc);
  const int m0 = tm * 256, n0 = tn * 256;
  gemm8(p.wpgT + ((size_t)layer * DM + n0) * DM, DM, p.hn + (size_t)m0 * DM, DM, DM, acc, smem, staged);
  if (nx.has) gemm8_stage0(nx.P, nx.ldp, nx.Q, nx.ldq, acc, smem);
  const int tid_ = otid(); const int lane = tid_ & 63, wid = __builtin_amdgcn_readfirstlane(tid_ >> 6), wr = wid >> 2, wc = wid & 3, fr = lane & 15, fq = lane >> 4;
#pragma unroll
  for (int bj = 0; bj < 2; ++bj)
#pragma unroll
    for (int n = 0; n < 2; ++n) {
      const int row = m0 + bj * 128 + wc * 32 + n * 16 + fr;
      float* orow = p.out + (size_t)row * DM + n0 + wr * 64 + fq * 4;
      const bf16_t* prow = p.z + (size_t)row * DM + n0 + wr * 64 + fq * 4;
#pragma unroll
      for (int ai = 0; ai < 2; ++ai)
#pragma unroll
        for (int m = 0; m < 4; ++m) {
          const float4 ov = *(const float4*)(orow + ai * 128 + m * 16);
          const uint2 pu = *(const uint2*)(prow + ai * 128 + m * 16);
          const f32x4 a = acc[ai][bj][m][n];
          *(float4*)(orow + ai * 128 + m * 16) = make_float4(ov.x + sigm(a[0]) * bflo(pu.x), ov.y + sigm(a[1]) * bfhi(pu.x),
                                                            ov.z + sigm(a[2]) * bflo(pu.y), ov.w + sigm(a[3]) * bfhi(pu.y));
        }
    }
}

template <int MODE>
DI void attn_item(const Params& p, int layer, int v, char* smem) {
  constexpr int NMAPS = (MODE == 0) ? 2 : 1;
  constexpr int KS = (MODE == 0) ? 2 : ((MODE == 3) ? 6 : 4);
  constexpr int DK = (MODE == 3) ? 96 : 64;
  constexpr int KSTR = (DK + 8) * 2;
  constexpr int VSTR = 144;
  constexpr int KBUF = 64 * KSTR;
  constexpr int BUFB = KBUF + 64 * VSTR;
  constexpr bool LAZY = (MODE == 0 || MODE == 3);
  const int tid = otid(), lane = tid & 63, wave = __builtin_amdgcn_readfirstlane(tid >> 6), r = lane & 31, h = lane >> 5;
  int seq, head, qt, S, row0;
  if (v < 1024) {
    const int b = v & 255, k = v >> 8, x = b & 7, j = b >> 3, pr = x + 8 * k;
    seq = pr >> 2; head = pr & 3; qt = j; S = 8192; row0 = seq * 8192;
  } else {
    const int b = v - 1024, x = b & 7, j = b >> 3, pr = x + 8 * (j >> 4);
    seq = pr >> 2; head = pr & 3; qt = j & 15; S = 4096; row0 = NPROMPT + seq * 4096;
  }
  const int q0 = qt * 256, nkt = S >> 6;
  int kt_lo = 0, kt_hi = nkt, cR = 0, clo = 0;
  if (MODE == 1) { kt_lo = max(0, 4 * qt - 2); kt_hi = min(nkt, 4 * qt + 6); }
  if (MODE == 2) {
    const int R0 = 4 * qt;
    kt_lo = min(max(R0 - 4, 0), nkt - 8); kt_hi = min(max(R0 - 1, 0), nkt - 8) + 8;
    cR = R0 + (wave >> 1); clo = min(max(cR - 4, 0), nkt - 8);
  }
  const bf16_t *qp, *kp, *vp; int ldq, ldk, ldv;
  if (MODE == 0) { qp = p.z + Z_AQ + head * 64; kp = p.z + Z_AK + head * 64; vp = p.z + Z_AV + head * 64; ldq = ldk = ldv = ZLD; }
  else if (MODE == 1) { qp = p.z + Z_BQ + head * 64; kp = p.z + Z_BK + (head >> 1) * 64; vp = p.z + Z_BV + (head >> 1) * 64; ldq = ldk = ldv = ZLD; }
  else if (MODE == 2) { qp = p.z + Z_CQ + head * 64; kp = p.z + Z_CK + head * 64; vp = p.z + Z_CV + head * 64; ldq = ldk = ldv = ZLD; }
  else { qp = p.qd + head * 96; ldq = 384; kp = p.kvd + head * 128; vp = p.kvd + head * 128 + 64; ldk = ldv = 512; }

  float* bias = (float*)(smem + SM_BIAS);
  if (MODE == 2) {
    const float* rp = p.c_rpb + (size_t)(layer * 4 + head) * 465;
    for (int i = tid; i < 465; i += NTHR) bias[i] = rp[i] * LOG2E;
  }

  bf16x8 qf[NMAPS][KS];
  {
    const bf16_t* qrow = qp + (size_t)(row0 + q0 + wave * 32 + r) * ldq + 8 * h;
#pragma unroll
    for (int m = 0; m < NMAPS; ++m)
#pragma unroll
      for (int ks = 0; ks < KS; ++ks) qf[m][ks] = *(const bf16x8*)(qrow + (m * KS + ks) * 16);
  }
  float mrun[NMAPS], lrun[NMAPS];
  f32x16 o[NMAPS][2];
  f32x16 negm[NMAPS];
  bool zref[NMAPS];
#pragma unroll
  for (int m = 0; m < NMAPS; ++m) { mrun[m] = LAZY ? 0.f : -1e30f; lrun[m] = 0.f; o[m][0] = f32x16{}; o[m][1] = f32x16{}; negm[m] = f32x16{}; zref[m] = true; }
  if (MODE == 1) { mrun[0] = p.b_sink[layer * 4 + head] * LOG2E; lrun[0] = (h == 0) ? 1.f : 0.f; }

  const int lrow = tid >> 3, lcc = tid & 7;
  const bf16_t* kg = kp + (size_t)(row0 + lrow) * ldk + lcc * 8;
  const bf16_t* vg = vp + (size_t)(row0 + lrow) * ldv + lcc * 8;
  const bf16_t* k2g = p.z + (size_t)(row0 + ((tid & 255) >> 2)) * ZLD + Z_DKR + (tid & 3) * 8;
  u32x4 kr0, vr0, k2r = u32x4{};
#define ATT_LOAD(kt_)                                                                              \
  {                                                                                                \
    const size_t ro_ = (size_t)(kt_) * 64;                                                         \
    kr0 = *(const u32x4*)(kg + ro_ * ldk);                                                         \
    vr0 = *(const u32x4*)(vg + ro_ * ldv);                                                         \
    if (MODE == 3) { if (tid < 256) k2r = *(const u32x4*)(k2g + ro_ * ZLD); }                      \
  }
#define ATT_STORE(buf_)                                                                            \
  {                                                                                                \
    char* kb_ = smem + (buf_) * BUFB;                                                              \
    *(u32x4*)(kb_ + lrow * KSTR + lcc * 16) = kr0;                                                 \
    *(u32x4*)(kb_ + KBUF + lrow * VSTR + lcc * 16) = vr0;                                          \
    if (MODE == 3) { if (tid < 256) *(u32x4*)(kb_ + (tid >> 2) * KSTR + 128 + (tid & 3) * 16) = k2r; } \
  }
  ATT_LOAD(kt_lo);
  ATT_STORE(0);
  __syncthreads();

  const int i16 = lane & 15;
  const int voff = (4 * h + (i16 >> 2)) * VSTR + (((lane >> 4) & 1) * 16 + (i16 & 3) * 4) * 2;
  const int qi = q0 + wave * 32 + r;
  const int cc = (wave & 1) * 32 + r;
  const int ccs = min(max(cc - 8, 0), 48);

  if (wave >= 4) __builtin_amdgcn_s_setprio(1);
#pragma unroll 1
  for (int kt = kt_lo; kt < kt_hi; ++kt) {
    const int cur = (kt - kt_lo) & 1;
    if (kt + 1 < kt_hi) ATT_LOAD(kt + 1);
    const bool active = (MODE == 2) ? (kt >= clo && kt < clo + 8)
                      : ((MODE == 1) ? (kt * 64 + 63 >= q0 + wave * 32 - 128 && kt * 64 <= q0 + wave * 32 + 31 + 128) : true);
    if (active) {
      const char* kb = smem + cur * BUFB;
      const char* vb = kb + KBUF;
      bf16x8 pf[NMAPS][2][2];
#pragma unroll
      for (int m = 0; m < NMAPS; ++m) {
        f32x16 st[2];
        auto qk_chain = [&](const bool use_ref) {
#pragma unroll
          for (int sub = 0; sub < 2; ++sub) {
            f32x16 s;
            if (use_ref) s = negm[m]; else s = f32x16{};
#pragma unroll
            for (int ks = 0; ks < KS; ++ks) {
              const bf16x8 kf = *(const bf16x8*)(kb + (sub * 32 + r) * KSTR + ((m * KS + ks) * 16 + 8 * h) * 2);
              s = MFMA(kf, qf[m][ks], s);
            }
            st[sub] = s;
          }
        };
        if (LAZY && !zref[m]) qk_chain(true); else qk_chain(false);
        if (MODE == 1) {
          int tb = kt * 64 + 4 * h - qi + 128;
          asm volatile("" : "+v"(tb));
#pragma unroll
          for (int sub = 0; sub < 2; ++sub)
#pragma unroll
            for (int i = 0; i < 16; ++i) {
              const int c0 = sub * 32 + (i & 3) + 8 * (i >> 2);
              if ((unsigned)(tb + c0) > 256u) st[sub][i] = -INFINITY;
            }
        }
        if (MODE == 2) {
          int tcc = 4 * h - cc + 15 + (kt - cR + 7) * 31, tcs = 4 * h - ccs;
          asm volatile("" : "+v"(tcc), "+v"(tcs));
#pragma unroll
          for (int sub = 0; sub < 2; ++sub)
#pragma unroll
            for (int i = 0; i < 16; ++i) {
              const int c0 = sub * 32 + (i & 3) + 8 * (i >> 2);
              const bool valid = (unsigned)(c0 + tcs) < 16u;
              const int idx = valid ? tcc + c0 : 0;
              const float bv = bias[idx];
              st[sub][i] = valid ? st[sub][i] + bv : -INFINITY;
            }
        }
        auto tile_max = [&]() {
          float mx_ = fmaxf(fmaxf(st[0][0], st[0][1]), st[1][0]);
          float mb_ = fmaxf(fmaxf(st[0][2], st[0][3]), st[1][1]);
          mx_ = fmaxf(fmaxf(mx_, st[1][2]), st[1][3]);
#pragma unroll
          for (int i = 4; i < 16; i += 4) {
            mx_ = fmaxf(fmaxf(mx_, st[0][i]), st[0][i + 1]); mb_ = fmaxf(fmaxf(mb_, st[0][i + 2]), st[0][i + 3]);
            mx_ = fmaxf(fmaxf(mx_, st[1][i]), st[1][i + 1]); mb_ = fmaxf(fmaxf(mb_, st[1][i + 2]), st[1][i + 3]);
          }
          return swap_max(fmaxf(mx_, mb_));
        };
        float mx = 0.f;
        if (!LAZY) mx = tile_max();
        if (LAZY) {
          int ia = max(max(__float_as_int(st[0][0]), __float_as_int(st[0][1])), __float_as_int(st[1][0]));
          int ib = max(max(__float_as_int(st[0][2]), __float_as_int(st[0][3])), __float_as_int(st[1][1]));
          ia = max(max(ia, __float_as_int(st[1][2])), __float_as_int(st[1][3]));
#pragma unroll
          for (int i = 4; i < 16; i += 4) {
            ia = max(max(ia, __float_as_int(st[0][i])), __float_as_int(st[0][i + 1])); ib = max(max(ib, __float_as_int(st[0][i + 2])), __float_as_int(st[0][i + 3]));
            ia = max(max(ia, __float_as_int(st[1][i])), __float_as_int(st[1][i + 1])); ib = max(max(ib, __float_as_int(st[1][i + 2])), __float_as_int(st[1][i + 3]));
          }
          ia = max(ia, ib);
          const bool first = (kt == kt_lo);
          bool need = __builtin_amdgcn_ballot_w64(ia > 0x41000000) != 0;
          if (first) { mx = tile_max(); need = need || (__builtin_amdgcn_ballot_w64(mx < -8.f) != 0); }
          if (need) {
            if (!first) mx = tile_max();
            zref[m] = false;
            const float delta = first ? mx : fmaxf(mx, 0.f);
            const float alpha = first ? 1.f : ex2(-delta);
            mrun[m] += delta;
            lrun[m] *= alpha;
#pragma unroll
            for (int i = 0; i < 16; ++i) { o[m][0][i] *= alpha; o[m][1][i] *= alpha; st[0][i] -= delta; st[1][i] -= delta; }
            const float nm = -mrun[m];
#pragma unroll
            for (int i = 0; i < 16; ++i) negm[m][i] = nm;
          }
          f32x2 l2[4] = {{0.f, 0.f}, {0.f, 0.f}, {0.f, 0.f}, {0.f, 0.f}};
#pragma unroll
          for (int sub = 0; sub < 2; ++sub)
#pragma unroll
            for (int i = 0; i < 16; i += 2) {
              const float p0 = ex2(st[sub][i]), p1 = ex2(st[sub][i + 1]);
              st[sub][i] = p0; st[sub][i + 1] = p1;
              l2[(i >> 1) & 3] += f32x2{p0, p1};
            }
          const f32x2 lt = (l2[0] + l2[1]) + (l2[2] + l2[3]);
          lrun[m] += lt[0] + lt[1];
        } else {
          const float mnew = fmaxf(mrun[m], mx);
          const float alpha = ex2(mrun[m] - mnew);
          mrun[m] = mnew;
          float ls = 0.f;
#pragma unroll
          for (int sub = 0; sub < 2; ++sub)
#pragma unroll
            for (int i = 0; i < 16; ++i) { const float pv = ex2(st[sub][i] - mnew); ls += pv; st[sub][i] = pv; }
          lrun[m] = lrun[m] * alpha + ls;
#pragma unroll
          for (int i = 0; i < 16; ++i) { o[m][0][i] *= alpha; o[m][1][i] *= alpha; }
        }
#pragma unroll
        for (int sub = 0; sub < 2; ++sub)
#pragma unroll
          for (int kk = 0; kk < 2; ++kk) {
            const uint4 u = make_uint4(cvtpk(st[sub][8 * kk + 0], st[sub][8 * kk + 1]), cvtpk(st[sub][8 * kk + 2], st[sub][8 * kk + 3]),
                                       cvtpk(st[sub][8 * kk + 4], st[sub][8 * kk + 5]), cvtpk(st[sub][8 * kk + 6], st[sub][8 * kk + 7]));
            pf[m][sub][kk] = __builtin_bit_cast(bf16x8, u);
          }
      }
#pragma unroll
      for (int sub = 0; sub < 2; ++sub)
#pragma unroll
        for (int kk = 0; kk < 2; ++kk)
#pragma unroll
          for (int dvt = 0; dvt < 2; ++dvt) {
            const char* va = vb + voff + (sub * 32 + kk * 16) * VSTR + dvt * 64;
            const s16x4 lo = vtr(va), hi = vtr(va + 8 * VSTR);
            const bf16x8 vf = __builtin_shufflevector(lo, hi, 0, 1, 2, 3, 4, 5, 6, 7);
#pragma unroll
            for (int m = 0; m < NMAPS; ++m) o[m][dvt] = MFMA(vf, pf[m][sub][kk], o[m][dvt]);
          }
    }
    if (kt + 1 < kt_hi) ATT_STORE(cur ^ 1);
    __syncthreads();
  }
  if (wave >= 4) __builtin_amdgcn_s_setprio(0);
#undef ATT_LOAD
#undef ATT_STORE

  float inv[NMAPS];
#pragma unroll
  for (int m = 0; m < NMAPS; ++m) inv[m] = 1.f / swap_sum(lrun[m]);
  f32x16 res[2];
  if (MODE == 0) {
    const float lam = p.lam[layer];
    const float lam_init = 0.8f - 0.6f * __expf(-0.3f * (float)layer);
    float ss = 0.f;
#pragma unroll
    for (int dvt = 0; dvt < 2; ++dvt)
#pragma unroll
      for (int i = 0; i < 16; ++i) { const float t = o[0][dvt][i] * inv[0] - lam * (o[NMAPS - 1][dvt][i] * inv[NMAPS - 1]); res[dvt][i] = t; ss += t * t; }
    ss = swap_sum(ss);
    const float rs = rsqrtf(ss * (1.f / 64.f) + EPS) * (1.f - lam_init);
    const float* sg = p.a_subln_g + layer * 64;
#pragma unroll
    for (int dvt = 0; dvt < 2; ++dvt)
#pragma unroll
      for (int i = 0; i < 16; ++i) res[dvt][i] *= rs * sg[dvt * 32 + crow(i, h)];
  } else {
#pragma unroll
    for (int dvt = 0; dvt < 2; ++dvt)
#pragma unroll
      for (int i = 0; i < 16; ++i) res[dvt][i] = o[0][dvt][i] * inv[0];
  }
  {
    const size_t row = (size_t)(row0 + qi);
    const bf16_t* gp = p.z + row * ZLD + Z_GATE + MODE * 256 + head * 64;
    bf16_t* mp = p.hn + row * DM + MODE * 256 + head * 64;
#pragma unroll
    for (int dvt = 0; dvt < 2; ++dvt)
#pragma unroll
      for (int ig = 0; ig < 4; ++ig) {
        const int dv0 = dvt * 32 + ig * 8 + 4 * h;
        const uint2 gu = *(const uint2*)(gp + dv0);
        const float g0 = bflo(gu.x), g1 = bfhi(gu.x), g2 = bflo(gu.y), g3 = bfhi(gu.y);
        const float a0 = res[dvt][ig * 4 + 0] * g0 * sigm(g0), a1 = res[dvt][ig * 4 + 1] * g1 * sigm(g1);
        const float a2 = res[dvt][ig * 4 + 2] * g2 * sigm(g2), a3 = res[dvt][ig * 4 + 3] * g3 * sigm(g3);
        *(uint2*)(mp + dv0) = make_uint2(cvtpk(a0, a1), cvtpk(a2, a3));
      }
  }
}

#define XB_TMO      128
#define XB_XCNT(j)  (256  + 64 * (j))
#define XB_XSUB(j)  (1280 + 64 * (j))
#define XB_XGEN(j)  (2304 + 64 * (j))
#define XB_TOP      3328
#define XB_TOPGEN   3392
#define XB_SPIN_CAP (1u << 18)
#define LAS __attribute__((address_space(3)))
DI unsigned xb_ld(unsigned* p) { return __hip_atomic_load(p, __ATOMIC_RELAXED, __HIP_MEMORY_SCOPE_AGENT); }
DI unsigned xb_add(unsigned* p, unsigned v) { return __hip_atomic_fetch_add(p, v, __ATOMIC_RELAXED, __HIP_MEMORY_SCOPE_AGENT); }
DI unsigned xb_xcc_id() { return (unsigned)__builtin_amdgcn_s_getreg((3 << 11) | 20) & 0xFu; }
#define XB_SPIN(cond, bar) do { unsigned _sp = 0; while (cond) { __builtin_amdgcn_s_sleep(1); \
    if ((++_sp & 255u) == 0u) { if (xb_ld(&(bar)[XB_TMO])) break; if (_sp > XB_SPIN_CAP) { atomicAdd(&(bar)[XB_TMO], 1u); break; } } } } while (0)
struct XcdBarrier { unsigned* bar; unsigned x; volatile LAS unsigned* st; };
DI XcdBarrier xcd_barrier_post(unsigned* bar, volatile LAS unsigned* st) {
  XcdBarrier b; b.bar = bar; b.x = xb_xcc_id(); b.st = st;
  if (threadIdx.x == 0) (void)xb_add(&bar[XB_XCNT(b.x)], 1u);
  return b;
}
DI void xcd_barrier_complete(unsigned* bar, unsigned x, unsigned& nloc, unsigned& nx) {
  const unsigned G = gridDim.x * gridDim.y * gridDim.z;
  unsigned sum, cnt, mine, sp = 0u;
  for (;;) {
    sum = 0u; cnt = 0u; mine = 0u;
#pragma unroll
    for (unsigned j = 0; j < 16; ++j) { const unsigned c = xb_ld(&bar[XB_XCNT(j)]); sum += c; cnt += (c > 0u) ? 1u : 0u; mine = (j == x) ? c : mine; }
    if (sum == G) break;
    __builtin_amdgcn_s_sleep(1);
    if ((++sp & 255u) == 0u) { if (xb_ld(&bar[XB_TMO])) break; if (sp > XB_SPIN_CAP) { atomicAdd(&bar[XB_TMO], 1u); break; } }
  }
  nloc = mine > 0u ? mine : 1u; nx = cnt > 0u ? cnt : 1u;
}
DI void xcd_barrier(const XcdBarrier& b) {
  asm volatile("s_waitcnt vmcnt(0)" ::: "memory");
  __syncthreads();
  if (threadIdx.x == 0) {
    unsigned* bar = b.bar;
    __builtin_amdgcn_s_waitcnt(0);
    unsigned nloc = b.st[0], nx = b.st[1];
    if (nloc == 0u) { xcd_barrier_complete(bar, b.x, nloc, nx); b.st[0] = nloc; b.st[1] = nx; }
    const unsigned old = xb_add(&bar[XB_XSUB(b.x)], 1u);
    const unsigned gen = old / nloc;
    if (old + 1u == (gen + 1u) * nloc) {
      __builtin_amdgcn_fence(__ATOMIC_RELEASE, "agent");
      asm volatile("s_waitcnt vmcnt(0)" ::: "memory");
      const unsigned og = xb_add(&bar[XB_TOP], 1u);
      const unsigned tg = og / nx;
      if (og + 1u == (tg + 1u) * nx) xb_add(&bar[XB_TOPGEN], 1u);
      else XB_SPIN(xb_ld(&bar[XB_TOPGEN]) == tg, bar);
      __builtin_amdgcn_fence(__ATOMIC_ACQUIRE, "agent");
      xb_add(&bar[XB_XGEN(b.x)], 1u);
      asm volatile("s_waitcnt vmcnt(0)" ::: "memory");
    } else {
      XB_SPIN(xb_ld(&bar[XB_XGEN(b.x)]) == gen, bar);
      __builtin_amdgcn_fence(__ATOMIC_ACQUIRE, "agent");
      asm volatile("s_waitcnt vmcnt(0)" ::: "memory");
    }
  }
  __syncthreads();
}

DI void row_ssq_exchange(const Params& p, int slot, int tm, int tn, float (&ssp)[2][2], char* smem, int lane, int wr, int wc) {
  const int fr = lane & 15, fq = lane >> 4;
  float* lpart = (float*)(smem + 131072);
  float* lrs = lpart + 512;
  __syncthreads();
#pragma unroll
  for (int bj = 0; bj < 2; ++bj)
#pragma unroll
    for (int n = 0; n < 2; ++n) {
      float v = ssp[bj][n];
      v += __shfl_xor(v, 16); v += __shfl_xor(v, 32);
      if (fq == 0) lpart[wr * 256 + bj * 128 + wc * 32 + n * 16 + fr] = v;
    }
  __syncthreads();
  const int t = otid();
  unsigned* xp = p.xpart + ((size_t)(slot * 320 + tm) * 4) * 256;
  if (t < 256) __hip_atomic_store(xp + tn * 256 + t, __float_as_uint(lpart[t] + lpart[256 + t]), __ATOMIC_RELAXED, __HIP_MEMORY_SCOPE_AGENT);
  asm volatile("s_waitcnt vmcnt(0)" ::: "memory");
  __syncthreads();
  if (t == 0) { unsigned* c = p.xcnt + slot * 320 + tm; (void)xb_add(c, 1u); XB_SPIN(xb_ld(c) < 4u, p.bar); }
  __syncthreads();
  if (t < 256) {
    float tot = 0.f;
#pragma unroll
    for (int q = 0; q < 4; ++q) tot += __uint_as_float(__hip_atomic_load(xp + q * 256 + t, __ATOMIC_RELAXED, __HIP_MEMORY_SCOPE_AGENT));
    lrs[t] = rsqrtf(tot * (1.f / 1024.f) + EPS);
  }
  __syncthreads();
}

DI void outproj_tile_f(const Params& p, int layer, int tm, int tn, char* smem, bool staged, const NextTile& nx) {
  f32x4 acc[2][2][4][2]; zero_acc8(acc);
  const int m0 = tm * 256, n0 = tn * 256;
  gemm8(p.woutT + ((size_t)layer * DM + n0) * DM, DM, p.hn + (size_t)m0 * DM, DM, DM, acc, smem, staged);
  if (nx.has) gemm8_stage0(nx.P, nx.ldp, nx.Q, nx.ldq, acc, smem);
  const int tid_ = otid(); const int lane = tid_ & 63, wid = __builtin_amdgcn_readfirstlane(tid_ >> 6), wr = wid >> 2, wc = wid & 3, fr = lane & 15, fq = lane >> 4;
  float ssp[2][2];
#pragma unroll
  for (int bj = 0; bj < 2; ++bj)
#pragma unroll
    for (int n = 0; n < 2; ++n) {
      const int row = m0 + bj * 128 + wc * 32 + n * 16 + fr;
      const float* hrow = (layer == 0 ? xrow(p, row) : p.out + (size_t)row * DM) + n0 + wr * 64 + fq * 4;
      bf16_t* orow = p.z + (size_t)NTOK * DM + (size_t)row * DM + n0 + wr * 64 + fq * 4;
      float ss = 0.f;
#pragma unroll
      for (int ai = 0; ai < 2; ++ai)
#pragma unroll
        for (int m = 0; m < 4; ++m) {
          const float4 hv = *(const float4*)(hrow + ai * 128 + m * 16);
          f32x4 a = acc[ai][bj][m][n];
          a[0] += hv.x; a[1] += hv.y; a[2] += hv.z; a[3] += hv.w;
          *(uint2*)(orow + ai * 128 + m * 16) = pack4(a[0], a[1], a[2], a[3]);
          ss += a[0] * a[0] + a[1] * a[1] + a[2] * a[2] + a[3] * a[3];
          acc[ai][bj][m][n] = a;
        }
      ssp[bj][n] = ss;
    }
  row_ssq_exchange(p, 2 * layer, tm, tn, ssp, smem, lane, wr, wc);
  const float* lrs = (const float*)(smem + 131072) + 512;
  const float* g = p.ple_norm_g + layer * DM + n0 + wr * 64 + fq * 4;
#pragma unroll
  for (int bj = 0; bj < 2; ++bj)
#pragma unroll
    for (int n = 0; n < 2; ++n) {
      const int tl = bj * 128 + wc * 32 + n * 16 + fr;
      const float rs = lrs[tl];
      bf16_t* brow = p.hn + (size_t)(m0 + tl) * DM + n0 + wr * 64 + fq * 4;
#pragma unroll
      for (int ai = 0; ai < 2; ++ai)
#pragma unroll
        for (int m = 0; m < 4; ++m) {
          const float4 gv = *(const float4*)(g + ai * 128 + m * 16);
          const f32x4 a = acc[ai][bj][m][n];
          *(uint2*)(brow + ai * 128 + m * 16) = pack4(a[0] * rs * gv.x, a[1] * rs * gv.y, a[2] * rs * gv.z, a[3] * rs * gv.w);
        }
    }
}

DI void ple_tile_f(const Params& p, int layer, int tm, int tn, char* smem, bool staged, const NextTile& nx) {
  f32x4 acc[2][2][4][2]; zero_acc8(acc);
  const int m0 = tm * 256, n0 = tn * 256;
  gemm8(p.wpgT + ((size_t)layer * DM + n0) * DM, DM, p.hn + (size_t)m0 * DM, DM, DM, acc, smem, staged);
  if (nx.has) gemm8_stage0(nx.P, nx.ldp, nx.Q, nx.ldq, acc, smem);
  const int tid_ = otid(); const int lane = tid_ & 63, wid = __builtin_amdgcn_readfirstlane(tid_ >> 6), wr = wid >> 2, wc = wid & 3, fr = lane & 15, fq = lane >> 4;
  float ssp[2][2];
#pragma unroll
  for (int bj = 0; bj < 2; ++bj)
#pragma unroll
    for (int n = 0; n < 2; ++n) {
      const int row = m0 + bj * 128 + wc * 32 + n * 16 + fr;
      float* orow = p.out + (size_t)row * DM + n0 + wr * 64 + fq * 4;
      const bf16_t* prow = p.z + (size_t)row * DM + n0 + wr * 64 + fq * 4;
      const bf16_t* hrow = prow + (size_t)NTOK * DM;
      float ss = 0.f;
#pragma unroll
      for (int ai = 0; ai < 2; ++ai)
#pragma unroll
        for (int m = 0; m < 4; ++m) {
          const uint2 hu = *(const uint2*)(hrow + ai * 128 + m * 16);
          const uint2 pu = *(const uint2*)(prow + ai * 128 + m * 16);
          f32x4 a = acc[ai][bj][m][n];
          a[0] = bflo(hu.x) + sigm(a[0]) * bflo(pu.x); a[1] = bfhi(hu.x) + sigm(a[1]) * bfhi(pu.x);
          a[2] = bflo(hu.y) + sigm(a[2]) * bflo(pu.y); a[3] = bfhi(hu.y) + sigm(a[3]) * bfhi(pu.y);
          if (layer == 0) *(float4*)(orow + ai * 128 + m * 16) = make_float4(a[0], a[1], a[2], a[3]);
          ss += a[0] * a[0] + a[1] * a[1] + a[2] * a[2] + a[3] * a[3];
          acc[ai][bj][m][n] = a;
        }
      ssp[bj][n] = ss;
    }
  row_ssq_exchange(p, 2 * layer + 1, tm, tn, ssp, smem, lane, wr, wc);
  const float* lrs = (const float*)(smem + 131072) + 512;
  const float* g = (layer == 0 ? p.norm_g + DM : p.final_norm_g) + n0 + wr * 64 + fq * 4;
#pragma unroll
  for (int bj = 0; bj < 2; ++bj)
#pragma unroll
    for (int n = 0; n < 2; ++n) {
      const int tl = bj * 128 + wc * 32 + n * 16 + fr;
      const float rs = lrs[tl];
      bf16_t* brow = p.hn + (size_t)(m0 + tl) * DM + n0 + wr * 64 + fq * 4;
      float* orow = p.out + (size_t)(m0 + tl) * DM + n0 + wr * 64 + fq * 4;
#pragma unroll
      for (int ai = 0; ai < 2; ++ai)
#pragma unroll
        for (int m = 0; m < 4; ++m) {
          const float4 gv = *(const float4*)(g + ai * 128 + m * 16);
          const f32x4 a = acc[ai][bj][m][n];
          if (layer == 0) *(uint2*)(brow + ai * 128 + m * 16) = pack4(a[0] * rs * gv.x, a[1] * rs * gv.y, a[2] * rs * gv.z, a[3] * rs * gv.w);
          else *(float4*)(orow + ai * 128 + m * 16) = make_float4(a[0] * rs * gv.x, a[1] * rs * gv.y, a[2] * rs * gv.z, a[3] * rs * gv.w);
        }
    }
}

__global__ void __launch_bounds__(512, 2) mega_fwd(Params p) {
  __shared__ __attribute__((aligned(16))) char smem[SMEM_BYTES];
  cg::grid_group grid = cg::this_grid();
  const int nb = gridDim.x;

  if (threadIdx.x < 4) ((unsigned*)(smem + SM_XB))[threadIdx.x] = 0u;
  phase_prep(p, smem);
  phase_norm(p, 0, 0);
  grid.sync();
  const XcdBarrier xb = xcd_barrier_post(p.bar, (volatile LAS unsigned*)(lds_cptr)(smem + SM_XB));
#pragma unroll 1
  for (int layer = 0; layer < 2; ++layer) {
    {
      bool staged = false;
      for (int v = blockIdx.x; v < 18 * 256; v += nb) {
        const int b = v & 255, k = v >> 8, x = b & 7, j = b >> 3, st = k * 8 + x;
        if (st >= 140) continue;
        const int tm = (st / 7) * 16 + (j >> 1), tn = (st % 7) * 2 + (j & 1);
        NextTile nx;
        {
          const int v2 = v + nb, b2 = v2 & 255, k2 = v2 >> 8, st2 = k2 * 8 + (b2 & 7), j2 = b2 >> 3;
          nx.has = (v2 < 18 * 256) && (st2 < 140);
          const int tm2 = (st2 / 7) * 16 + (j2 >> 1), tn2 = (st2 % 7) * 2 + (j2 & 1);
          nx.P = p.winT + ((size_t)layer * DINP + tn2 * 256) * DM; nx.Q = p.hn + (size_t)tm2 * 256 * DM; nx.ldp = DM; nx.ldq = DM;
        }
        inproj_tile(p, layer, tm, tn, smem, staged, nx);
        staged = nx.has;
      }
    }
    xcd_barrier(xb);
    for (int v = blockIdx.x; v < 1280 + 1280 + 1280 + 1280; v += nb) {
      if (v < 1280) attn_item<0>(p, layer, v, smem);
      else if (v < 2560) { const int u = v - 1280; upproj_tile(p, layer, u >> 2, u & 3, smem); }
      else if (v < 3840) attn_item<1>(p, layer, v - 2560, smem);
      else attn_item<2>(p, layer, v - 3840, smem);
    }
    xcd_barrier(xb);
    for (int v = blockIdx.x; v < 1280; v += nb) attn_item<3>(p, layer, v, smem);
    xcd_barrier(xb);
    {
      bool staged = false;
      for (int v = blockIdx.x; v < 2560; v += nb) {
        const int vv = v < 1280 ? v : v - 1280;
        const int b = vv & 255, k = vv >> 8, x = b & 7, j = b >> 3, st = k * 8 + x;
        NextTile nx;
        {
          const int v2 = v + nb, vv2 = v2 < 1280 ? v2 : v2 - 1280;
          const int b2 = vv2 & 255, st2 = (vv2 >> 8) * 8 + (b2 & 7), j2 = b2 >> 3, tm2 = st2 * 8 + (j2 >> 2), tn2 = j2 & 3;
          nx.has = v2 < 2560;
          if (v2 < 1280) { nx.P = p.woutT + ((size_t)layer * DM + tn2 * 256) * DM; nx.Q = p.hn + (size_t)tm2 * 256 * DM; nx.ldp = DM; nx.ldq = DM; }
          else { nx.P = p.wppT + ((size_t)layer * DM + tn2 * 256) * 256; nx.Q = p.pb + ((size_t)layer * NTOK + tm2 * 256) * 256; nx.ldp = 256; nx.ldq = 256; }
        }
        if (v < 1280) outproj_tile_f(p, layer, st * 8 + (j >> 2), j & 3, smem, staged, nx);
        else pproj_tile(p, layer, st * 8 + (j >> 2), j & 3, smem, staged, nx);
        staged = nx.has;
      }
    }
    xcd_barrier(xb);
    {
      bool staged = false;
      for (int v = blockIdx.x; v < 1280; v += nb) {
        const int b = v & 255, k = v >> 8, x = b & 7, j = b >> 3, st = k * 8 + x;
        NextTile nx;
        {
          const int v2 = v + nb, b2 = v2 & 255, st2 = (v2 >> 8) * 8 + (b2 & 7), j2 = b2 >> 3, tm2 = st2 * 8 + (j2 >> 2), tn2 = j2 & 3;
          nx.has = v2 < 1280;
          nx.P = p.wpgT + ((size_t)layer * DM + tn2 * 256) * DM; nx.Q = p.hn + (size_t)tm2 * 256 * DM; nx.ldp = DM; nx.ldq = DM;
        }
        ple_tile_f(p, layer, st * 8 + (j >> 2), j & 3, smem, staged, nx);
        staged = nx.has;
      }
    }
    if (layer == 0) xcd_barrier(xb);
  }
}

extern "C" void kernel_launch(void* const* d_in, const int* in_sizes, int n_in, void* d_out, int out_size, void* d_ws, size_t ws_size,
                              hipStream_t stream) {
  Params p{};
  p.x_prompt = (const float*)d_in[0]; p.x_sample = (const float*)d_in[1]; p.p_prompt = (const float*)d_in[2]; p.p_sample = (const float*)d_in[3];
  p.norm_g = (const float*)d_in[4]; p.w_in = (const float*)d_in[5]; p.a_lambda = (const float*)d_in[6]; p.a_subln_g = (const float*)d_in[7];
  p.b_sink = (const float*)d_in[8]; p.c_rpb = (const float*)d_in[9]; p.d_q_norm_g = (const float*)d_in[10]; p.d_kv_norm_g = (const float*)d_in[11];
  p.d_w_uq = (const float*)d_in[12]; p.d_w_ukv = (const float*)d_in[13]; p.w_out = (const float*)d_in[14]; p.ple_norm_g = (const float*)d_in[15];
  p.w_ple_gate = (const float*)d_in[16]; p.w_ple_proj = (const float*)d_in[17]; p.final_norm_g = (const float*)d_in[18];
  p.out = (float*)d_out;
  char* w = (char*)d_ws; size_t off = 0;
  auto carve = [&](size_t bytes) { char* r = w + off; off += (bytes + 255) & ~(size_t)255; return r; };
  p.hn = (bf16_t*)carve((size_t)NTOK * DM * 2);
  p.z = (bf16_t*)carve((size_t)NTOK * ZLD * 2);
  p.qd = (bf16_t*)carve((size_t)NTOK * 384 * 2);
  p.pb = (bf16_t*)carve((size_t)2 * NTOK * 256 * 2);
  p.kvd = (bf16_t*)carve((size_t)NTOK * 512 * 2);
  p.winT = (bf16_t*)carve((size_t)2 * DINP * DM * 2);
  p.wuqT = (bf16_t*)carve((size_t)2 * 384 * 256 * 2);
  p.wukvT = (bf16_t*)carve((size_t)2 * 512 * 128 * 2);
  p.woutT = (bf16_t*)carve((size_t)2 * DM * DM * 2);
  p.wpgT = (bf16_t*)carve((size_t)2 * DM * DM * 2);
  p.wppT = (bf16_t*)carve((size_t)2 * DM * 256 * 2);
  p.cs32 = (float2*)carve((size_t)8192 * 16 * 8);
  p.cs64 = (float2*)carve((size_t)8192 * 32 * 8);
  p.lam = (float*)carve(256);
  p.bar = (unsigned*)carve((size_t)XCD_BAR_WORDS * 4);
  p.xpart = (unsigned*)carve((size_t)4 * 320 * 4 * 256 * 4);
  p.xcnt = (unsigned*)carve((size_t)4 * 320 * 4);
  if (off > ws_size) { fprintf(stderr, "workspace too small: need %zu have %zu\n", off, ws_size); return; }
  static int grid_blocks = 0;
  if (!grid_blocks) {
    int dev = 0, cus = 0, per_cu = 0;
    hipGetDevice(&dev);
    hipDeviceGetAttribute(&cus, hipDeviceAttributeMultiprocessorCount, dev);
    hipOccupancyMaxActiveBlocksPerMultiprocessor(&per_cu, mega_fwd, NTHR, 0);
    if (per_cu > 1) per_cu = 1;
    if (per_cu < 1) per_cu = 1;
    grid_blocks = cus * per_cu;
  }
  void* args[] = {&p};
  hipError_t e = hipLaunchCooperativeKernel((void*)mega_fwd, dim3(grid_blocks), dim3(NTHR), args, 0, stream);
  if (e != hipSuccess) fprintf(stderr, "cooperative launch failed: %s (grid %d)\n", hipGetErrorString(e), grid_blocks);
}
```

```cpp
#include <hip/hip_runtime.h>
#include <hip/hip_cooperative_groups.h>
#include <stdint.h>
#include <stdio.h>
namespace cg = cooperative_groups;

typedef __attribute__((ext_vector_type(8))) short bf16x8;
typedef __attribute__((ext_vector_type(4))) short s16x4;
typedef __attribute__((ext_vector_type(16))) float f32x16;
typedef short v4i16_t __attribute__((ext_vector_type(4)));
typedef __bf16 bf16v2 __attribute__((ext_vector_type(2)));
typedef unsigned short bf16_t;
typedef unsigned u32x4 __attribute__((ext_vector_type(4)));
typedef float f32x2 __attribute__((ext_vector_type(2)));
typedef float f32x4 __attribute__((ext_vector_type(4)));
typedef __attribute__((address_space(3))) unsigned* lds_uptr;
typedef __attribute__((address_space(3))) const char* lds_cptr;

#define DI __device__ __forceinline__
#define MFMA(a, b, c) __builtin_amdgcn_mfma_f32_32x32x16_bf16((a), (b), (c), 0, 0, 0)

constexpr int NTOK = 81920, NPROMPT = 65536, DM = 1024, DIN = 3488, DINP = 3584, ZLD = 3488;
constexpr int Z_AQ = 0, Z_AK = 256, Z_AV = 512, Z_BQ = 768, Z_BK = 1024, Z_BV = 1152, Z_CQ = 1280, Z_CK = 1536, Z_CV = 1792,
              Z_DCQ = 2048, Z_DCKV = 2304, Z_DKR = 2432, Z_GATE = 2464;
constexpr float LOG2E = 1.4426950408889634f;
constexpr float SCALE_A = 0.17677669529663687f * LOG2E;
constexpr float SCALE_B = 0.125f * LOG2E;
constexpr float SCALE_C = 0.125f * LOG2E;
constexpr float SCALE_D = 0.10206207261596575f * LOG2E;
constexpr float EPS = 1e-6f;

constexpr int G_ROWB = 144;
constexpr int G_TILEB = 256 * G_ROWB;
constexpr int SM_RS = 4 * G_TILEB;
constexpr int SM_BIAS = 46080;
constexpr int SM_XB = SM_RS + 1024;
constexpr int SMEM_BYTES = SM_XB + 16;
constexpr int NTHR = 512;
#define XCD_BAR_WORDS 3456

struct Params {
  const float* x_prompt; const float* x_sample; const float* p_prompt; const float* p_sample;
  const float* norm_g; const float* w_in; const float* a_lambda; const float* a_subln_g; const float* b_sink; const float* c_rpb;
  const float* d_q_norm_g; const float* d_kv_norm_g; const float* d_w_uq; const float* d_w_ukv; const float* w_out; const float* ple_norm_g;
  const float* w_ple_gate; const float* w_ple_proj; const float* final_norm_g;
  float* out;
  bf16_t* hn;
  bf16_t* z;
  bf16_t* qd;
  bf16_t* pb;
  bf16_t* kvd;
  bf16_t* winT; bf16_t* wuqT; bf16_t* wukvT; bf16_t* woutT; bf16_t* wpgT; bf16_t* wppT;
  float2* cs32; float2* cs64; float* lam;
  unsigned* xpart;
  unsigned* xcnt;
  unsigned* bar;
};

DI unsigned cvtpk(float lo, float hi) { bf16v2 v = {(__bf16)lo, (__bf16)hi}; return __builtin_bit_cast(unsigned, v); }
DI bf16_t f2bf(float x) { __bf16 b = (__bf16)x; return __builtin_bit_cast(bf16_t, b); }
DI float bf2f(unsigned v16) { return __uint_as_float(v16 << 16); }
DI float bflo(unsigned u) { return __uint_as_float(u << 16); }
DI float bfhi(unsigned u) { return __uint_as_float(u & 0xffff0000u); }
DI int otid() { int t = threadIdx.x; asm volatile("" : "+v"(t)); return t; }
DI int crow(int i, int h) { return (i & 3) + 8 * (i >> 2) + 4 * h; }
DI float ex2(float x) { return __builtin_amdgcn_exp2f(x); }
DI float sigm(float x) { return 1.f / (1.f + __expf(-x)); }
DI const float* xrow(const Params& p, int row) { return row < NPROMPT ? p.x_prompt + (size_t)row * DM : p.x_sample + (size_t)(row - NPROMPT) * DM; }
DI int pos_of(int row) { return row < NPROMPT ? (row & 8191) : (row & 4095); }
DI int pos_mask(int m0) { return m0 < NPROMPT ? 8191 : 4095; }
DI float swap_max(float m) { auto rr = __builtin_amdgcn_permlane32_swap(__float_as_uint(m), __float_as_uint(m), false, false); return fmaxf(__uint_as_float(rr[0]), __uint_as_float(rr[1])); }
DI float swap_sum(float m) { auto rr = __builtin_amdgcn_permlane32_swap(__float_as_uint(m), __float_as_uint(m), false, false); return __uint_as_float(rr[0]) + __uint_as_float(rr[1]); }
DI s16x4 vtr(const char* p) { return __builtin_bit_cast(s16x4, __builtin_amdgcn_ds_read_tr16_b64_v4i16((__attribute__((address_space(3))) v4i16_t*)(lds_cptr)p)); }

DI void transpose_tile(const float* __restrict__ W, int K, int N, bf16_t* __restrict__ WT, const float* __restrict__ gfold, int tile, char* smem) {
  const int kt = K >> 6;
  const int n0 = (tile / kt) * 64, k0 = (tile % kt) * 64;
  float* t = (float*)smem;
  const int tid = otid();
  __syncthreads();
  if (tid < 256) {
    const int nn = tid & 63, kb = tid >> 6;
#pragma unroll
    for (int i = 0; i < 16; ++i) {
      const int kk = kb + 4 * i;
      float v = 0.f;
      if (n0 + nn < N) { v = W[(size_t)(k0 + kk) * N + n0 + nn]; if (gfold) v *= gfold[k0 + kk]; }
      t[kk * 65 + nn] = v;
    }
  }
  __syncthreads();
  if (tid < 256) {
    const int nl = tid >> 2, kq = (tid & 3) * 16;
    unsigned u[8];
#pragma unroll
    for (int j = 0; j < 8; ++j) u[j] = cvtpk(t[(kq + 2 * j) * 65 + nl], t[(kq + 2 * j + 1) * 65 + nl]);
    uint4* dst = (uint4*)(WT + (size_t)(n0 + nl) * K + k0 + kq);
    dst[0] = make_uint4(u[0], u[1], u[2], u[3]);
    dst[1] = make_uint4(u[4], u[5], u[6], u[7]);
  }
}

DI void phase_prep(const Params& p, char* smem) {
  for (int v = blockIdx.x; v < 2 * 1512; v += gridDim.x) {
    const int layer = v / 1512; int t = v % 1512;
    if (t < 896) { transpose_tile(p.w_in + (size_t)layer * DM * DIN, DM, DIN, p.winT + (size_t)layer * DINP * DM, nullptr, t, smem); continue; }
    t -= 896;
    if (t < 24) { transpose_tile(p.d_w_uq + (size_t)layer * 256 * 384, 256, 384, p.wuqT + (size_t)layer * 384 * 256, p.d_q_norm_g + layer * 256, t, smem); continue; }
    t -= 24;
    if (t < 16) { transpose_tile(p.d_w_ukv + (size_t)layer * 128 * 512, 128, 512, p.wukvT + (size_t)layer * 512 * 128, p.d_kv_norm_g + layer * 128, t, smem); continue; }
    t -= 16;
    if (t < 256) { transpose_tile(p.w_out + (size_t)layer * DM * DM, DM, DM, p.woutT + (size_t)layer * DM * DM, nullptr, t, smem); continue; }
    t -= 256;
    if (t < 256) { transpose_tile(p.w_ple_gate + (size_t)layer * DM * DM, DM, DM, p.wpgT + (size_t)layer * DM * DM, nullptr, t, smem); continue; }
    t -= 256;
    transpose_tile(p.w_ple_proj + (size_t)layer * 256 * DM, 256, DM, p.wppT + (size_t)layer * DM * 256, nullptr, t, smem);
  }
  const int gt = blockIdx.x * NTHR + otid(), nt = gridDim.x * NTHR;
  for (int i = gt; i < XCD_BAR_WORDS; i += nt) p.bar[i] = 0u;
  for (int i = gt; i < 4 * 320 + 64; i += nt) p.xcnt[i] = 0u;
  for (int i = gt; i < 8192 * 48; i += nt) {
    int pos, f, dim; float2* dst;
    if (i < 8192 * 16) { pos = i >> 4; f = i & 15; dim = 32; dst = p.cs32 + i; }
    else { const int j = i - 8192 * 16; pos = j >> 5; f = j & 31; dim = 64; dst = p.cs64 + j; }
    const float inv = exp2f(-(float)(2 * f) / (float)dim * 13.287712379549449f);
    const double ang = (double)pos * (double)inv;
    double rev = ang * 0.15915494309189535;
    rev = rev - __builtin_rint(rev);
    const float fr = (float)rev;
    *dst = make_float2(__builtin_amdgcn_cosf(fr), __builtin_amdgcn_sinf(fr));
  }
  if (blockIdx.x == 0 && threadIdx.x < 2) {
    const int layer = threadIdx.x;
    const float* lv = p.a_lambda + layer * 128;
    float s1 = 0.f, s2 = 0.f;
    for (int i = 0; i < 32; ++i) { s1 += lv[i] * lv[32 + i]; s2 += lv[64 + i] * lv[96 + i]; }
    const float lam_init = 0.8f - 0.6f * expf(-0.3f * (float)layer);
    p.lam[layer] = expf(s1) - expf(s2) + lam_init;
  }
}

DI void phase_norm(const Params& p, int layer, int kind) {
  const int tid_ = otid(); const int lane = tid_ & 63, wave = __builtin_amdgcn_readfirstlane(tid_ >> 6);
  const float* g = kind == 0 ? p.norm_g + layer * DM : (kind == 1 ? p.ple_norm_g + layer * DM : p.final_norm_g);
  float4 g4[4];
#pragma unroll
  for (int j = 0; j < 4; ++j) g4[j] = ((const float4*)g)[lane + 64 * j];
  for (int row = blockIdx.x * 8 + wave; row < NTOK; row += gridDim.x * 8) {
    const float* src = (kind == 0 && layer == 0) ? xrow(p, row) : p.out + (size_t)row * DM;
    float4 v[4];
#pragma unroll
    for (int j = 0; j < 4; ++j) v[j] = ((const float4*)src)[lane + 64 * j];
    float ss = 0.f;
#pragma unroll
    for (int j = 0; j < 4; ++j) ss += v[j].x * v[j].x + v[j].y * v[j].y + v[j].z * v[j].z + v[j].w * v[j].w;
#pragma unroll
    for (int o = 32; o >= 1; o >>= 1) ss += __shfl_xor(ss, o);
    const float rs = rsqrtf(ss * (1.f / 1024.f) + EPS);
    if (kind == 2) {
      float4* dst = (float4*)(p.out + (size_t)row * DM);
#pragma unroll
      for (int j = 0; j < 4; ++j) dst[lane + 64 * j] = make_float4(v[j].x * rs * g4[j].x, v[j].y * rs * g4[j].y, v[j].z * rs * g4[j].z, v[j].w * rs * g4[j].w);
    } else {
      uint2* dst = (uint2*)(p.hn + (size_t)row * DM);
#pragma unroll
      for (int j = 0; j < 4; ++j) dst[lane + 64 * j] = make_uint2(cvtpk(v[j].x * rs * g4[j].x, v[j].y * rs * g4[j].y), cvtpk(v[j].z * rs * g4[j].z, v[j].w * rs * g4[j].w));
      if (kind == 0) {
#pragma unroll
        for (int l = 0; l < 2; ++l) {
          const float* ps = row < NPROMPT ? p.p_prompt + ((size_t)l * NPROMPT + row) * 256 : p.p_sample + ((size_t)l * (NTOK - NPROMPT) + (row - NPROMPT)) * 256;
          const float4 pv = ((const float4*)ps)[lane];
          ((uint2*)(p.pb + ((size_t)l * NTOK + row) * 256))[lane] = make_uint2(cvtpk(pv.x, pv.y), cvtpk(pv.z, pv.w));
        }
      }
    }
  }
}

DI void gemm_core(const bf16_t* __restrict__ A, int lda, const bf16_t* __restrict__ W, int ldw, int K, f32x16 (&acc)[4][2], char* smem) {
  const int tid = otid(), lane = tid & 63, wave = __builtin_amdgcn_readfirstlane(tid >> 6), wm = wave >> 2, wn = wave & 3, r = lane & 31, h = lane >> 5;
  const int lrow = tid >> 3, lcc = tid & 7;
  const char* ag = (const char*)(A + (size_t)lrow * lda + lcc * 8);
  const char* wg = (const char*)(W + (size_t)lrow * ldw + lcc * 8);
  const size_t astep = (size_t)64 * lda * 2, wstep = (size_t)64 * ldw * 2;
  char* As = smem; char* Bs = smem + 2 * G_TILEB;
  const int soff = lrow * G_ROWB + lcc * 16;
  u32x4 ra[4], rb[4];
#pragma unroll
  for (int i = 0; i < 4; ++i) { ra[i] = *(const u32x4*)(ag + i * astep); rb[i] = *(const u32x4*)(wg + i * wstep); }
#pragma unroll
  for (int i = 0; i < 4; ++i) { *(u32x4*)(As + soff + i * 64 * G_ROWB) = ra[i]; *(u32x4*)(Bs + soff + i * 64 * G_ROWB) = rb[i]; }
  __syncthreads();
  const int nk = K >> 6;
  const int aoff = (wm * 128 + r) * G_ROWB + h * 16;
  const int boff = (wn * 64 + r) * G_ROWB + h * 16;
#pragma unroll 1
  for (int kt = 0; kt < nk; ++kt) {
    const int cur = kt & 1;
    if (kt + 1 < nk) {
#pragma unroll
      for (int i = 0; i < 4; ++i) { ra[i] = *(const u32x4*)(ag + i * astep + (size_t)(kt + 1) * 128); rb[i] = *(const u32x4*)(wg + i * wstep + (size_t)(kt + 1) * 128); }
    }
    const char* Ac = As + cur * G_TILEB + aoff; const char* Bc = Bs + cur * G_TILEB + boff;
#pragma unroll
    for (int ks = 0; ks < 4; ++ks) {
      const bf16x8 b0 = *(const bf16x8*)(Bc + ks * 32), b1 = *(const bf16x8*)(Bc + 32 * G_ROWB + ks * 32);
#pragma unroll
      for (int ti = 0; ti < 4; ++ti) {
        const bf16x8 a = *(const bf16x8*)(Ac + ti * 32 * G_ROWB + ks * 32);
        acc[ti][0] = MFMA(b0, a, acc[ti][0]); acc[ti][1] = MFMA(b1, a, acc[ti][1]);
      }
    }
    if (kt + 1 < nk) {
      const int nb = cur ^ 1;
#pragma unroll
      for (int i = 0; i < 4; ++i) { *(u32x4*)(As + nb * G_TILEB + soff + i * 64 * G_ROWB) = ra[i]; *(u32x4*)(Bs + nb * G_TILEB + soff + i * 64 * G_ROWB) = rb[i]; }
    }
    __syncthreads();
  }
}

DI void zero_acc(f32x16 (&acc)[4][2]) {
#pragma unroll
  for (int a = 0; a < 4; ++a)
#pragma unroll
    for (int b = 0; b < 2; ++b) acc[a][b] = f32x16{};
}

DI uint2 pack4(float a, float b, float c, float d) { return make_uint2(cvtpk(a, b), cvtpk(c, d)); }
DI void rope_quad(const float2* cs, const f32x16& t1, const f32x16& t2, int q1, int q2, float sc, bf16_t* d1, bf16_t* d2) {
  const float4 c01 = ((const float4*)cs)[0], c23 = ((const float4*)cs)[1];
  const float c[4] = {c01.x, c01.z, c23.x, c23.z}, sn[4] = {c01.y, c01.w, c23.y, c23.w};
  float o1[4], o2[4];
#pragma unroll
  for (int j = 0; j < 4; ++j) {
    const float x1 = t1[q1 * 4 + j], x2 = t2[q2 * 4 + j];
    o1[j] = (x1 * c[j] - x2 * sn[j]) * sc; o2[j] = (x2 * c[j] + x1 * sn[j]) * sc;
  }
  *(uint2*)d1 = pack4(o1[0], o1[1], o1[2], o1[3]);
  *(uint2*)d2 = pack4(o2[0], o2[1], o2[2], o2[3]);
}

DI void g8_stage_rc(int b, int& R, int& C) {
  const int st = b / 1024, sb = b % 1024, swz = sb ^ (((sb >> 9) & 1) << 5);
  R = (st >> 1) * 16 + swz / 64; C = (st & 1) * 32 + (swz % 64) / 2;
}
#define G8_MFMA(a, b, c) __builtin_amdgcn_mfma_f32_16x16x32_bf16((a), (b), (c), 0, 0, 0)
template <bool STAGE0_ONLY>
DI void gemm8_impl(const bf16_t* __restrict__ P, int ldp, const bf16_t* __restrict__ Q, int ldq, int K, f32x4 (&acc)[2][2][4][2], char* smem, bool staged) {
  const int tid = otid(), lane = tid & 63, wid = __builtin_amdgcn_readfirstlane(tid >> 6), wr = wid >> 2, wc = wid & 3, fr = lane & 15, fq = lane >> 4;
  int r0, c0;
  g8_stage_rc(tid * 16, r0, c0);
  const unsigned pof = (unsigned)(r0 * ldp + c0) * 2u, qof = (unsigned)(r0 * ldq + c0) * 2u;
  const char* const Pb = (const char*)P; const char* const Qb = (const char*)Q;
  char* const sdst = smem + tid * 16;
  const int ob = fr * 64 + fq * 16, obs = ob ^ (((ob >> 9) & 1) << 5);
  const char* const ard = smem + wr * 8192 + obs;
  const char* const brd = smem + wc * 4096 + obs;
#define G8_SA(b, hh) (((b) * 2 + (hh)) * 16384)
#define G8_SB(b, hh) ((4 + (b) * 2 + (hh)) * 16384)
#define G8_STAGE_P(b, hh, kt) { const char* u_ = Pb + ((size_t)((hh) * 128) * ldp + (size_t)(kt) * 64) * 2;                \
    __builtin_amdgcn_global_load_lds((const unsigned*)(u_ + pof), (lds_uptr)(sdst + G8_SA(b, hh)), 16, 0, 0);               \
    __builtin_amdgcn_global_load_lds((const unsigned*)(u_ + (size_t)ldp * 128 + pof), (lds_uptr)(sdst + G8_SA(b, hh) + 8192), 16, 0, 0); }
#define G8_STAGE_Q(b, hh, kt) { const char* u_ = Qb + ((size_t)((hh) * 128) * ldq + (size_t)(kt) * 64) * 2;                \
    __builtin_amdgcn_global_load_lds((const unsigned*)(u_ + qof), (lds_uptr)(sdst + G8_SB(b, hh)), 16, 0, 0);               \
    __builtin_amdgcn_global_load_lds((const unsigned*)(u_ + (size_t)ldq * 128 + qof), (lds_uptr)(sdst + G8_SB(b, hh) + 8192), 16, 0, 0); }
#define G8_LDA(dst, b, hh) _Pragma("unroll") for (int m = 0; m < 4; ++m) _Pragma("unroll") for (int k = 0; k < 2; ++k) \
    dst[m][k] = *(const bf16x8*)(ard + G8_SA(b, hh) + m * 2048 + k * 1024)
#define G8_LDB(dst, b, hh) _Pragma("unroll") for (int n = 0; n < 2; ++n) _Pragma("unroll") for (int k = 0; k < 2; ++k) \
    dst[n][k] = *(const bf16x8*)(brd + G8_SB(b, hh) + n * 2048 + k * 1024)
#define G8_MMA(ai, bj, At_, Bt_) do { __builtin_amdgcn_s_setprio(1);                                                      \
    _Pragma("unroll") for (int m = 0; m < 4; ++m) _Pragma("unroll") for (int n = 0; n < 2; ++n) _Pragma("unroll") for (int k = 0; k < 2; ++k) \
      acc[ai][bj][m][n] = G8_MFMA(At_[m][k], Bt_[n][k], acc[ai][bj][m][n]);                                                \
    __builtin_amdgcn_s_setprio(0); } while (0)
#define G8_WAIT_V(n) asm volatile("s_waitcnt vmcnt(" #n ")" ::: "memory")
#define G8_WAIT_L(n) asm volatile("s_waitcnt lgkmcnt(" #n ")" ::: "memory")
#define G8_BAR __builtin_amdgcn_s_barrier()
#define G8_SCHED __builtin_amdgcn_sched_barrier(0)
  bf16x8 At[4][2], B0[2][2], B1[2][2];
  const int nt = K >> 6;
  if (STAGE0_ONLY) {
    G8_STAGE_Q(0, 0, 0); G8_STAGE_P(0, 0, 0);
    G8_STAGE_Q(0, 1, 0); G8_STAGE_P(0, 1, 0);
    return;
  }
  if (!staged) {
    __syncthreads();
    G8_STAGE_Q(0, 0, 0); G8_STAGE_P(0, 0, 0);
    G8_STAGE_Q(0, 1, 0); G8_STAGE_P(0, 1, 0);
  }
  if (wr == 1) G8_BAR;
  G8_WAIT_V(4); G8_BAR;
  G8_STAGE_Q(1, 0, 1); G8_STAGE_P(1, 0, 1); G8_STAGE_Q(1, 1, 1);
  G8_WAIT_V(6); G8_BAR;
#pragma unroll 1
  for (int t = 0; t < nt - 2; t += 2) {
    G8_LDB(B0, 0, 0); G8_SCHED; G8_LDA(At, 0, 0); G8_STAGE_P(1, 1, t + 1);
    G8_WAIT_L(8); G8_BAR; G8_WAIT_L(0); G8_MMA(0, 0, At, B0); G8_BAR; G8_SCHED;
    G8_LDB(B1, 0, 1); G8_STAGE_Q(0, 0, t + 2);
    G8_BAR; G8_WAIT_L(0); G8_MMA(0, 1, At, B1); G8_BAR;
    G8_LDA(At, 0, 1); G8_STAGE_P(0, 0, t + 2);
    G8_BAR; G8_WAIT_L(0); G8_MMA(1, 0, At, B0); G8_BAR; G8_SCHED;
    G8_STAGE_Q(0, 1, t + 2);
    G8_WAIT_V(6); G8_BAR; G8_MMA(1, 1, At, B1); G8_BAR;
    G8_LDB(B0, 1, 0); G8_SCHED; G8_LDA(At, 1, 0); G8_STAGE_P(0, 1, t + 2);
    G8_WAIT_L(8); G8_BAR; G8_WAIT_L(0); G8_MMA(0, 0, At, B0); G8_BAR; G8_SCHED;
    G8_LDB(B1, 1, 1); G8_STAGE_Q(1, 0, t + 3);
    G8_BAR; G8_WAIT_L(0); G8_MMA(0, 1, At, B1); G8_BAR;
    G8_LDA(At, 1, 1); G8_STAGE_P(1, 0, t + 3);
    G8_BAR; G8_WAIT_L(0); G8_MMA(1, 0, At, B0); G8_BAR; G8_SCHED;
    G8_STAGE_Q(1, 1, t + 3);
    G8_WAIT_V(6); G8_BAR; G8_MMA(1, 1, At, B1); G8_BAR;
  }
  { G8_LDB(B0, 0, 0); G8_LDA(At, 0, 0); G8_STAGE_P(1, 1, nt - 1);
    G8_BAR; G8_WAIT_L(0); G8_MMA(0, 0, At, B0); G8_BAR;
    G8_LDB(B1, 0, 1); G8_BAR; G8_WAIT_L(0); G8_MMA(0, 1, At, B1); G8_BAR;
    G8_LDA(At, 0, 1); G8_WAIT_V(4); G8_BAR; G8_WAIT_L(0); G8_MMA(1, 0, At, B0); G8_MMA(1, 1, At, B1); G8_BAR; }
  { G8_LDB(B0, 1, 0); G8_LDA(At, 1, 0); G8_WAIT_V(2); G8_BAR; G8_WAIT_L(0); G8_MMA(0, 0, At, B0); G8_BAR;
    G8_LDB(B1, 1, 1); G8_WAIT_V(0); G8_BAR; G8_WAIT_L(0); G8_MMA(0, 1, At, B1); G8_BAR;
    G8_LDA(At, 1, 1); G8_BAR; G8_WAIT_L(0); G8_MMA(1, 0, At, B0); G8_MMA(1, 1, At, B1); G8_BAR; }
  if (wr == 0) G8_BAR;
#undef G8_SA
#undef G8_SB
#undef G8_STAGE_P
#undef G8_STAGE_Q
#undef G8_LDA
#undef G8_LDB
#undef G8_MMA
#undef G8_WAIT_V
#undef G8_WAIT_L
#undef G8_BAR
#undef G8_SCHED
}

DI void gemm8(const bf16_t* P, int ldp, const bf16_t* Q, int ldq, int K, f32x4 (&acc)[2][2][4][2], char* smem, bool staged) {
  gemm8_impl<false>(P, ldp, Q, ldq, K, acc, smem, staged);
}
DI void gemm8_stage0(const bf16_t* P, int ldp, const bf16_t* Q, int ldq, f32x4 (&acc)[2][2][4][2], char* smem) {
  gemm8_impl<true>(P, ldp, Q, ldq, 256, acc, smem, false);
}
struct NextTile { const bf16_t* P; const bf16_t* Q; int ldp; int ldq; bool has; };
DI void zero_acc8(f32x4 (&acc)[2][2][4][2]) {
#pragma unroll
  for (int a = 0; a < 2; ++a)
#pragma unroll
    for (int b = 0; b < 2; ++b)
#pragma unroll
      for (int m = 0; m < 4; ++m)
#pragma unroll
        for (int n = 0; n < 2; ++n) acc[a][b][m][n] = f32x4{0.f, 0.f, 0.f, 0.f};
}
DI uint2 pack4v(f32x4 v, float sc) { return make_uint2(cvtpk(v[0] * sc, v[1] * sc), cvtpk(v[2] * sc, v[3] * sc)); }
DI void rope_quad4(const float2* cs, f32x4 x1, f32x4 x2, float sc, bf16_t* d1, bf16_t* d2) {
  const float4 c01 = ((const float4*)cs)[0], c23 = ((const float4*)cs)[1];
  const float c[4] = {c01.x, c01.z, c23.x, c23.z}, sn[4] = {c01.y, c01.w, c23.y, c23.w};
  float o1[4], o2[4];
#pragma unroll
  for (int j = 0; j < 4; ++j) { o1[j] = (x1[j] * c[j] - x2[j] * sn[j]) * sc; o2[j] = (x2[j] * c[j] + x1[j] * sn[j]) * sc; }
  *(uint2*)d1 = pack4(o1[0], o1[1], o1[2], o1[3]);
  *(uint2*)d2 = pack4(o2[0], o2[1], o2[2], o2[3]);
}

DI void inproj_tile(const Params& p, int layer, int tm, int tn, char* smem, bool staged, const NextTile& nx) {
  f32x4 acc[2][2][4][2]; zero_acc8(acc);
  const int m0 = tm * 256, n0 = tn * 256;
  gemm8(p.winT + ((size_t)layer * DINP + n0) * DM, DM, p.hn + (size_t)m0 * DM, DM, DM, acc, smem, staged);
  if (nx.has) gemm8_stage0(nx.P, nx.ldp, nx.Q, nx.ldq, acc, smem);
  const int tid_ = otid(); const int lane = tid_ & 63, wid = __builtin_amdgcn_readfirstlane(tid_ >> 6), wr = wid >> 2, wc = wid & 3, fr = lane & 15, fq = lane >> 4;
  const int pmask = pos_mask(m0);
#pragma unroll
  for (int bj = 0; bj < 2; ++bj)
#pragma unroll
    for (int n = 0; n < 2; ++n) {
      const int row = m0 + bj * 128 + wc * 32 + n * 16 + fr;
      const int pos = row & pmask;
      bf16_t* zrow = p.z + (size_t)row * ZLD;
#pragma unroll
      for (int ai = 0; ai < 2; ++ai) {
        const int fb = n0 + ai * 128 + wr * 64;
        if (fb >= Z_BQ && fb < Z_BV) {
          const float sc = fb < Z_BK ? SCALE_B : 1.f;
#pragma unroll
          for (int m = 0; m < 2; ++m) {
            const int f0 = m * 16 + fq * 4;
            rope_quad4(p.cs64 + pos * 32 + f0, acc[ai][bj][m][n], acc[ai][bj][m + 2][n], sc, zrow + fb + f0, zrow + fb + 32 + f0);
          }
        } else {
#pragma unroll
          for (int tj = 0; tj < 2; ++tj) {
            const int n32 = fb + tj * 32;
            if (n32 >= DIN) continue;
            const bool rope = (n32 < Z_AV) || (n32 == Z_DKR);
            const float sc = (n32 < Z_AK) ? SCALE_A : ((n32 >= Z_CQ && n32 < Z_CK) ? SCALE_C : 1.f);
            if (rope) {
              rope_quad4(p.cs32 + pos * 16 + fq * 4, acc[ai][bj][2 * tj][n], acc[ai][bj][2 * tj + 1][n], sc, zrow + n32 + fq * 4, zrow + n32 + 16 + fq * 4);
            } else {
              *(uint2*)(zrow + n32 + fq * 4) = pack4v(acc[ai][bj][2 * tj][n], sc);
              *(uint2*)(zrow + n32 + 16 + fq * 4) = pack4v(acc[ai][bj][2 * tj + 1][n], sc);
            }
          }
        }
      }
    }
}

DI void tile_rs(const bf16_t* A, int lda, int K, float* rsv) {
  const int t = otid();
  const uint4* src = (const uint4*)(A + (size_t)(t >> 1) * lda + (t & 1) * (K >> 1));
  float ss = 0.f;
  for (int c = 0; c < (K >> 4); ++c) {
    const uint4 u = src[c];
    ss += bflo(u.x) * bflo(u.x) + bfhi(u.x) * bfhi(u.x) + bflo(u.y) * bflo(u.y) + bfhi(u.y) * bfhi(u.y)
        + bflo(u.z) * bflo(u.z) + bfhi(u.z) * bfhi(u.z) + bflo(u.w) * bflo(u.w) + bfhi(u.w) * bfhi(u.w);
  }
  ss += __shfl_xor(ss, 1);
  if ((t & 1) == 0) rsv[t >> 1] = rsqrtf(ss / (float)K + EPS);
}

DI void upproj_tile(const Params& p, int layer, int tm, int sel, char* smem) {
  const int m0 = tm * 256;
  const int pmask = pos_mask(m0);
  float* rsv = (float*)(smem + SM_RS);
  const int tid_ = otid(); const int lane = tid_ & 63, wave = __builtin_amdgcn_readfirstlane(tid_ >> 6), wm = wave >> 2, wn = wave & 3, r = lane & 31, h = lane >> 5;
  f32x16 acc[4][2]; zero_acc(acc);
  __syncthreads();
  if (sel < 2) {
    const int n0 = sel * 256;
    const bf16_t* A = p.z + (size_t)m0 * ZLD + Z_DCQ;
    tile_rs(A, ZLD, 256, rsv);
    gemm_core(A, ZLD, p.wuqT + ((size_t)layer * 384 + n0) * 256, 256, 256, acc, smem);
#pragma unroll
    for (int ti = 0; ti < 4; ++ti) {
      const int rl = wm * 128 + ti * 32 + r, row = m0 + rl;
      const float rsc = rsv[rl] * SCALE_D;
      bf16_t* qrow = p.qd + (size_t)row * 384;
#pragma unroll
      for (int tj = 0; tj < 2; ++tj) {
        const int n = n0 + wn * 64 + tj * 32;
        if (n >= 384) continue;
        if ((n % 96) == 64) {
#pragma unroll
          for (int g = 0; g < 2; ++g) {
            const int f0 = 8 * g + 4 * h;
            rope_quad(p.cs32 + (row & pmask) * 16 + f0, acc[ti][tj], acc[ti][tj], g, g + 2, rsc, qrow + n + f0, qrow + n + 16 + f0);
          }
        } else {
#pragma unroll
          for (int g = 0; g < 4; ++g)
            *(uint2*)(qrow + n + 8 * g + 4 * h) = pack4(acc[ti][tj][4 * g] * rsc, acc[ti][tj][4 * g + 1] * rsc, acc[ti][tj][4 * g + 2] * rsc, acc[ti][tj][4 * g + 3] * rsc);
        }
      }
    }
  } else {
    const int n0 = (sel - 2) * 256;
    const bf16_t* A = p.z + (size_t)m0 * ZLD + Z_DCKV;
    tile_rs(A, ZLD, 128, rsv);
    gemm_core(A, ZLD, p.wukvT + ((size_t)layer * 512 + n0) * 128, 128, 128, acc, smem);
#pragma unroll
    for (int ti = 0; ti < 4; ++ti) {
      const int rl = wm * 128 + ti * 32 + r, row = m0 + rl;
      const float rsc = rsv[rl];
      bf16_t* krow = p.kvd + (size_t)row * 512 + n0 + wn * 64;
#pragma unroll
      for (int tj = 0; tj < 2; ++tj)
#pragma unroll
        for (int g = 0; g < 4; ++g)
          *(uint2*)(krow + tj * 32 + 8 * g + 4 * h) = pack4(acc[ti][tj][4 * g] * rsc, acc[ti][tj][4 * g + 1] * rsc, acc[ti][tj][4 * g + 2] * rsc, acc[ti][tj][4 * g + 3] * rsc);
    }
  }
}

DI void outproj_tile(const Params& p, int layer, int tm, int tn, char* smem, bool staged, const NextTile& nx) {
  f32x4 acc[2][2][4][2]; zero_acc8(acc);
  const int m0 = tm * 256, n0 = tn * 256;
  gemm8(p.woutT + ((size_t)layer * DM + n0) * DM, DM, p.hn + (size_t)m0 * DM, DM, DM, acc, smem, staged);
  if (nx.has) gemm8_stage0(nx.P, nx.ldp, nx.Q, nx.ldq, acc, smem);
  const int tid_ = otid(); const int lane = tid_ & 63, wid = __builtin_amdgcn_readfirstlane(tid_ >> 6), wr = wid >> 2, wc = wid & 3, fr = lane & 15, fq = lane >> 4;
#pragma unroll
  for (int bj = 0; bj < 2; ++bj)
#pragma unroll
    for (int n = 0; n < 2; ++n) {
      const int row = m0 + bj * 128 + wc * 32 + n * 16 + fr;
      const float* hrow = (layer == 0 ? xrow(p, row) : p.out + (size_t)row * DM) + n0 + wr * 64 + fq * 4;
      float* orow = p.out + (size_t)row * DM + n0 + wr * 64 + fq * 4;
#pragma unroll
      for (int ai = 0; ai < 2; ++ai)
#pragma unroll
        for (int m = 0; m < 4; ++m) {
          const float4 hv = *(const float4*)(hrow + ai * 128 + m * 16);
          const f32x4 a = acc[ai][bj][m][n];
          *(float4*)(orow + ai * 128 + m * 16) = make_float4(hv.x + a[0], hv.y + a[1], hv.z + a[2], hv.w + a[3]);
        }
    }
}

DI void pproj_tile(const Params& p, int layer, int tm, int tn, char* smem, bool staged, const NextTile& nx) {
  f32x4 acc[2][2][4][2]; zero_acc8(acc);
  const int m0 = tm * 256, n0 = tn * 256;
  gemm8(p.wppT + ((size_t)layer * DM + n0) * 256, 256, p.pb + ((size_t)layer * NTOK + m0) * 256, 256, 256, acc, smem, staged);
  if (nx.has) gemm8_stage0(nx.P, nx.ldp, nx.Q, nx.ldq, acc, smem);
  const int tid_ = otid(); const int lane = tid_ & 63, wid = __builtin_amdgcn_readfirstlane(tid_ >> 6), wr = wid >> 2, wc = wid & 3, fr = lane & 15, fq = lane >> 4;
#pragma unroll
  for (int bj = 0; bj < 2; ++bj)
#pragma unroll
    for (int n = 0; n < 2; ++n) {
      const int row = m0 + bj * 128 + wc * 32 + n * 16 + fr;
      bf16_t* prow = p.z + (size_t)row * DM + n0 + wr * 64 + fq * 4;
#pragma unroll
      for (int ai = 0; ai < 2; ++ai)
#pragma unroll
        for (int m = 0; m < 4; ++m) *(uint2*)(prow + ai * 128 + m * 16) = pack4v(acc[ai][bj][m][n], 1.f);
    }
}

DI void ple_tile(const Params& p, int layer, int tm, int tn, char* smem, bool staged, const NextTile& nx) {
  f32x4 acc[2][2][4][2]; zero_acc8(acc);
  const int m0 = tm * 256, n0 = tn * 256;
  gemm8(p.wpgT + ((size_t)layer * DM + n0) * DM, DM, p.hn + (size_t)m0 * DM, DM, DM, acc, smem, staged);
  if (nx.has) gemm8_stage0(nx.P, nx.ldp, nx.Q, nx.ldq, acc, smem);
  const int tid_ = otid(); const int lane = tid_ & 63, wid = __builtin_amdgcn_readfirstlane(tid_ >> 6), wr = wid >> 2, wc = wid & 3, fr = lane & 15, fq = lane >> 4;
#pragma unroll
  for (int bj = 0; bj < 2; ++bj)
#pragma unroll
    for (int n = 0; n < 2; ++n) {
      const int row = m0 + bj * 128 + wc * 32 + n * 16 + fr;
      float* orow = p.out + (size_t)row * DM + n0 + wr * 64 + fq * 4;
      const bf16_t* prow = p.z + (size_t)row * DM + n0 + wr * 64 + fq * 4;
#pragma unroll
      for (int ai = 0; ai < 2; ++ai)
#pragma unroll
        for (int m = 0; m < 4; ++m) {
          const float4 ov = *(const float4*)(orow + ai * 128 + m * 16);
          const uint2 pu = *(const uint2*)(prow + ai * 128 + m * 16);
          const f32x4 a = acc[ai][bj][m][n];
          *(float4*)(orow + ai * 128 + m * 16) = make_float4(ov.x + sigm(a[0]) * bflo(pu.x), ov.y + sigm(a[1]) * bfhi(pu.x),
                                                            ov.z + sigm(a[2]) * bflo(pu.y), ov.w + sigm(a[3]) * bfhi(pu.y));
        }
    }
}

template <int MODE>
DI void attn_item(const Params& p, int layer, int v, char* smem) {
  constexpr int NMAPS = (MODE == 0) ? 2 : 1;
  constexpr int KS = (MODE == 0) ? 2 : ((MODE == 3) ? 6 : 4);
  constexpr int DK = (MODE == 3) ? 96 : 64;
  constexpr int KSTR = (DK + 8) * 2;
  constexpr int VSTR = 144;
  constexpr int KBUF = 64 * KSTR;
  constexpr int BUFB = KBUF + 64 * VSTR;
  constexpr bool LAZY = (MODE == 0 || MODE == 3);
  const int tid = otid(), lane = tid & 63, wave = __builtin_amdgcn_readfirstlane(tid >> 6), r = lane & 31, h = lane >> 5;
  int seq, head, qt, S, row0;
  if (v < 1024) {
    const int b = v & 255, k = v >> 8, x = b & 7, j = b >> 3, pr = x + 8 * k;
    seq = pr >> 2; head = pr & 3; qt = j; S = 8192; row0 = seq * 8192;
  } else {
    const int b = v - 1024, x = b & 7, j = b >> 3, pr = x + 8 * (j >> 4);
    seq = pr >> 2; head = pr & 3; qt = j & 15; S = 4096; row0 = NPROMPT + seq * 4096;
  }
  const int q0 = qt * 256, nkt = S >> 6;
  int kt_lo = 0, kt_hi = nkt, cR = 0, clo = 0;
  if (MODE == 1) { kt_lo = max(0, 4 * qt - 2); kt_hi = min(nkt, 4 * qt + 6); }
  if (MODE == 2) {
    const int R0 = 4 * qt;
    kt_lo = min(max(R0 - 4, 0), nkt - 8); kt_hi = min(max(R0 - 1, 0), nkt - 8) + 8;
    cR = R0 + (wave >> 1); clo = min(max(cR - 4, 0), nkt - 8);
  }
  const bf16_t *qp, *kp, *vp; int ldq, ldk, ldv;
  if (MODE == 0) { qp = p.z + Z_AQ + head * 64; kp = p.z + Z_AK + head * 64; vp = p.z + Z_AV + head * 64; ldq = ldk = ldv = ZLD; }
  else if (MODE == 1) { qp = p.z + Z_BQ + head * 64; kp = p.z + Z_BK + (head >> 1) * 64; vp = p.z + Z_BV + (head >> 1) * 64; ldq = ldk = ldv = ZLD; }
  else if (MODE == 2) { qp = p.z + Z_CQ + head * 64; kp = p.z + Z_CK + head * 64; vp = p.z + Z_CV + head * 64; ldq = ldk = ldv = ZLD; }
  else { qp = p.qd + head * 96; ldq = 384; kp = p.kvd + head * 128; vp = p.kvd + head * 128 + 64; ldk = ldv = 512; }

  float* bias = (float*)(smem + SM_BIAS);
  if (MODE == 2) {
    const float* rp = p.c_rpb + (size_t)(layer * 4 + head) * 465;
    for (int i = tid; i < 465; i += NTHR) bias[i] = rp[i] * LOG2E;
  }

  bf16x8 qf[NMAPS][KS];
  {
    const bf16_t* qrow = qp + (size_t)(row0 + q0 + wave * 32 + r) * ldq + 8 * h;
#pragma unroll
    for (int m = 0; m < NMAPS; ++m)
#pragma unroll
      for (int ks = 0; ks < KS; ++ks) qf[m][ks] = *(const bf16x8*)(qrow + (m * KS + ks) * 16);
  }
  float mrun[NMAPS], lrun[NMAPS];
  f32x16 o[NMAPS][2];
  f32x16 negm[NMAPS];
  bool zref[NMAPS];
#pragma unroll
  for (int m = 0; m < NMAPS; ++m) { mrun[m] = LAZY ? 0.f : -1e30f; lrun[m] = 0.f; o[m][0] = f32x16{}; o[m][1] = f32x16{}; negm[m] = f32x16{}; zref[m] = true; }
  if (MODE == 1) { mrun[0] = p.b_sink[layer * 4 + head] * LOG2E; lrun[0] = (h == 0) ? 1.f : 0.f; }

  const int lrow = tid >> 3, lcc = tid & 7;
  const bf16_t* kg = kp + (size_t)(row0 + lrow) * ldk + lcc * 8;
  const bf16_t* vg = vp + (size_t)(row0 + lrow) * ldv + lcc * 8;
  const bf16_t* k2g = p.z + (size_t)(row0 + ((tid & 255) >> 2)) * ZLD + Z_DKR + (tid & 3) * 8;
  u32x4 kr0, vr0, k2r = u32x4{};
#define ATT_LOAD(kt_)                                                                              \
  {                                                                                                \
    const size_t ro_ = (size_t)(kt_) * 64;                                                         \
    kr0 = *(const u32x4*)(kg + ro_ * ldk);                                                         \
    vr0 = *(const u32x4*)(vg + ro_ * ldv);                                                         \
    if (MODE == 3) { if (tid < 256) k2r = *(const u32x4*)(k2g + ro_ * ZLD); }                      \
  }
#define ATT_STORE(buf_)                                                                            \
  {                                                                                                \
    char* kb_ = smem + (buf_) * BUFB;                                                              \
    *(u32x4*)(kb_ + lrow * KSTR + lcc * 16) = kr0;                                                 \
    *(u32x4*)(kb_ + KBUF + lrow * VSTR + lcc * 16) = vr0;                                          \
    if (MODE == 3) { if (tid < 256) *(u32x4*)(kb_ + (tid >> 2) * KSTR + 128 + (tid & 3) * 16) = k2r; } \
  }
  ATT_LOAD(kt_lo);
  ATT_STORE(0);
  __syncthreads();

  const int i16 = lane & 15;
  const int voff = (4 * h + (i16 >> 2)) * VSTR + (((lane >> 4) & 1) * 16 + (i16 & 3) * 4) * 2;
  const int qi = q0 + wave * 32 + r;
  const int cc = (wave & 1) * 32 + r;
  const int ccs = min(max(cc - 8, 0), 48);

  if (wave >= 4) __builtin_amdgcn_s_setprio(1);
#pragma unroll 1
  for (int kt = kt_lo; kt < kt_hi; ++kt) {
    const int cur = (kt - kt_lo) & 1;
    if (kt + 1 < kt_hi) ATT_LOAD(kt + 1);
    const bool active = (MODE == 2) ? (kt >= clo && kt < clo + 8)
                      : ((MODE == 1) ? (kt * 64 + 63 >= q0 + wave * 32 - 128 && kt * 64 <= q0 + wave * 32 + 31 + 128) : true);
    if (active) {
      const char* kb = smem + cur * BUFB;
      const char* vb = kb + KBUF;
      bf16x8 pf[NMAPS][2][2];
#pragma unroll
      for (int m = 0; m < NMAPS; ++m) {
        f32x16 st[2];
        auto qk_chain = [&](const bool use_ref) {
#pragma unroll
          for (int sub = 0; sub < 2; ++sub) {
            f32x16 s;
            if (use_ref) s = negm[m]; else s = f32x16{};
#pragma unroll
            for (int ks = 0; ks < KS; ++ks) {
              const bf16x8 kf = *(const bf16x8*)(kb + (sub * 32 + r) * KSTR + ((m * KS + ks) * 16 + 8 * h) * 2);
              s = MFMA(kf, qf[m][ks], s);
            }
            st[sub] = s;
          }
        };
        if (LAZY && !zref[m]) qk_chain(true); else qk_chain(false);
        if (MODE == 1) {
          int tb = kt * 64 + 4 * h - qi + 128;
          asm volatile("" : "+v"(tb));
#pragma unroll
          for (int sub = 0; sub < 2; ++sub)
#pragma unroll
            for (int i = 0; i < 16; ++i) {
              const int c0 = sub * 32 + (i & 3) + 8 * (i >> 2);
              if ((unsigned)(tb + c0) > 256u) st[sub][i] = -INFINITY;
            }
        }
        if (MODE == 2) {
          int tcc = 4 * h - cc + 15 + (kt - cR + 7) * 31, tcs = 4 * h - ccs;
          asm volatile("" : "+v"(tcc), "+v"(tcs));
#pragma unroll
          for (int sub = 0; sub < 2; ++sub)
#pragma unroll
            for (int i = 0; i < 16; ++i) {
              const int c0 = sub * 32 + (i & 3) + 8 * (i >> 2);
              const bool valid = (unsigned)(c0 + tcs) < 16u;
              const int idx = valid ? tcc + c0 : 0;
              const float bv = bias[idx];
              st[sub][i] = valid ? st[sub][i] + bv : -INFINITY;
            }
        }
        auto tile_max = [&]() {
          float mx_ = fmaxf(fmaxf(st[0][0], st[0][1]), st[1][0]);
          float mb_ = fmaxf(fmaxf(st[0][2], st[0][3]), st[1][1]);
          mx_ = fmaxf(fmaxf(mx_, st[1][2]), st[1][3]);
#pragma unroll
          for (int i = 4; i < 16; i += 4) {
            mx_ = fmaxf(fmaxf(mx_, st[0][i]), st[0][i + 1]); mb_ = fmaxf(fmaxf(mb_, st[0][i + 2]), st[0][i + 3]);
            mx_ = fmaxf(fmaxf(mx_, st[1][i]), st[1][i + 1]); mb_ = fmaxf(fmaxf(mb_, st[1][i + 2]), st[1][i + 3]);
          }
          return swap_max(fmaxf(mx_, mb_));
        };
        float mx = 0.f;
        if (!LAZY) mx = tile_max();
        if (LAZY) {
          int ia = max(max(__float_as_int(st[0][0]), __float_as_int(st[0][1])), __float_as_int(st[1][0]));
          int ib = max(max(__float_as_int(st[0][2]), __float_as_int(st[0][3])), __float_as_int(st[1][1]));
          ia = max(max(ia, __float_as_int(st[1][2])), __float_as_int(st[1][3]));
#pragma unroll
          for (int i = 4; i < 16; i += 4) {
            ia = max(max(ia, __float_as_int(st[0][i])), __float_as_int(st[0][i + 1])); ib = max(max(ib, __float_as_int(st[0][i + 2])), __float_as_int(st[0][i + 3]));
            ia = max(max(ia, __float_as_int(st[1][i])), __float_as_int(st[1][i + 1])); ib = max(max(ib, __float_as_int(st[1][i + 2])), __float_as_int(st[1][i + 3]));
          }
          ia = max(ia, ib);
          const bool first = (kt == kt_lo);
          bool need = __builtin_amdgcn_ballot_w64(ia > 0x41000000) != 0;
          if (first) { mx = tile_max(); need = need || (__builtin_amdgcn_ballot_w64(mx < -8.f) != 0); }
          if (need) {
            if (!first) mx = tile_max();
            zref[m] = false;
            const float delta = first ? mx : fmaxf(mx, 0.f);
            const float alpha = first ? 1.f : ex2(-delta);
            mrun[m] += delta;
            lrun[m] *= alpha;
#pragma unroll
            for (int i = 0; i < 16; ++i) { o[m][0][i] *= alpha; o[m][1][i] *= alpha; st[0][i] -= delta; st[1][i] -= delta; }
            const float nm = -mrun[m];
#pragma unroll
            for (int i = 0; i < 16; ++i) negm[m][i] = nm;
          }
          f32x2 l2[4] = {{0.f, 0.f}, {0.f, 0.f}, {0.f, 0.f}, {0.f, 0.f}};
#pragma unroll
          for (int sub = 0; sub < 2; ++sub)
#pragma unroll
            for (int i = 0; i < 16; i += 2) {
              const float p0 = ex2(st[sub][i]), p1 = ex2(st[sub][i + 1]);
              st[sub][i] = p0; st[sub][i + 1] = p1;
              l2[(i >> 1) & 3] += f32x2{p0, p1};
            }
          const f32x2 lt = (l2[0] + l2[1]) + (l2[2] + l2[3]);
          lrun[m] += lt[0] + lt[1];
        } else {
          const float mnew = fmaxf(mrun[m], mx);
          const float alpha = ex2(mrun[m] - mnew);
          mrun[m] = mnew;
          float ls = 0.f;
#pragma unroll
          for (int sub = 0; sub < 2; ++sub)
#pragma unroll
            for (int i = 0; i < 16; ++i) { const float pv = ex2(st[sub][i] - mnew); ls += pv; st[sub][i] = pv; }
          lrun[m] = lrun[m] * alpha + ls;
#pragma unroll
          for (int i = 0; i < 16; ++i) { o[m][0][i] *= alpha; o[m][1][i] *= alpha; }
        }
#pragma unroll
        for (int sub = 0; sub < 2; ++sub)
#pragma unroll
          for (int kk = 0; kk < 2; ++kk) {
            const uint4 u = make_uint4(cvtpk(st[sub][8 * kk + 0], st[sub][8 * kk + 1]), cvtpk(st[sub][8 * kk + 2], st[sub][8 * kk + 3]),
                                       cvtpk(st[sub][8 * kk + 4], st[sub][8 * kk + 5]), cvtpk(st[sub][8 * kk + 6], st[sub][8 * kk + 7]));
            pf[m][sub][kk] = __builtin_bit_cast(bf16x8, u);
          }
      }
#pragma unroll
      for (int sub = 0; sub < 2; ++sub)
#pragma unroll
        for (int kk = 0; kk < 2; ++kk)
#pragma unroll
          for (int dvt = 0; dvt < 2; ++dvt) {
            const char* va = vb + voff + (sub * 32 + kk * 16) * VSTR + dvt * 64;
            const s16x4 lo = vtr(va), hi = vtr(va + 8 * VSTR);
            const bf16x8 vf = __builtin_shufflevector(lo, hi, 0, 1, 2, 3, 4, 5, 6, 7);
#pragma unroll
            for (int m = 0; m < NMAPS; ++m) o[m][dvt] = MFMA(vf, pf[m][sub][kk], o[m][dvt]);
          }
    }
    if (kt + 1 < kt_hi) ATT_STORE(cur ^ 1);
    __syncthreads();
  }
  if (wave >= 4) __builtin_amdgcn_s_setprio(0);
#undef ATT_LOAD
#undef ATT_STORE

  float inv[NMAPS];
#pragma unroll
  for (int m = 0; m < NMAPS; ++m) inv[m] = 1.f / swap_sum(lrun[m]);
  f32x16 res[2];
  if (MODE == 0) {
    const float lam = p.lam[layer];
    const float lam_init = 0.8f - 0.6f * __expf(-0.3f * (float)layer);
    float ss = 0.f;
#pragma unroll
    for (int dvt = 0; dvt < 2; ++dvt)
#pragma unroll
      for (int i = 0; i < 16; ++i) { const float t = o[0][dvt][i] * inv[0] - lam * (o[NMAPS - 1][dvt][i] * inv[NMAPS - 1]); res[dvt][i] = t; ss += t * t; }
    ss = swap_sum(ss);
    const float rs = rsqrtf(ss * (1.f / 64.f) + EPS) * (1.f - lam_init);
    const float* sg = p.a_subln_g + layer * 64;
#pragma unroll
    for (int dvt = 0; dvt < 2; ++dvt)
#pragma unroll
      for (int i = 0; i < 16; ++i) res[dvt][i] *= rs * sg[dvt * 32 + crow(i, h)];
  } else {
#pragma unroll
    for (int dvt = 0; dvt < 2; ++dvt)
#pragma unroll
      for (int i = 0; i < 16; ++i) res[dvt][i] = o[0][dvt][i] * inv[0];
  }
  {
    const size_t row = (size_t)(row0 + qi);
    const bf16_t* gp = p.z + row * ZLD + Z_GATE + MODE * 256 + head * 64;
    bf16_t* mp = p.hn + row * DM + MODE * 256 + head * 64;
#pragma unroll
    for (int dvt = 0; dvt < 2; ++dvt)
#pragma unroll
      for (int ig = 0; ig < 4; ++ig) {
        const int dv0 = dvt * 32 + ig * 8 + 4 * h;
        const uint2 gu = *(const uint2*)(gp + dv0);
        const float g0 = bflo(gu.x), g1 = bfhi(gu.x), g2 = bflo(gu.y), g3 = bfhi(gu.y);
        const float a0 = res[dvt][ig * 4 + 0] * g0 * sigm(g0), a1 = res[dvt][ig * 4 + 1] * g1 * sigm(g1);
        const float a2 = res[dvt][ig * 4 + 2] * g2 * sigm(g2), a3 = res[dvt][ig * 4 + 3] * g3 * sigm(g3);
        *(uint2*)(mp + dv0) = make_uint2(cvtpk(a0, a1), cvtpk(a2, a3));
      }
  }
}

#define XB_TMO      128
#define XB_XCNT(j)  (256  + 64 * (j))
#define XB_XSUB(j)  (1280 + 64 * (j))
#define XB_XGEN(j)  (2304 + 64 * (j))
#define XB_TOP      3328
#define XB_TOPGEN   3392
#define XB_SPIN_CAP (1u << 18)
#define LAS __attribute__((address_space(3)))
DI unsigned xb_ld(unsigned* p) { return __hip_atomic_load(p, __ATOMIC_RELAXED, __HIP_MEMORY_SCOPE_AGENT); }
DI unsigned xb_add(unsigned* p, unsigned v) { return __hip_atomic_fetch_add(p, v, __ATOMIC_RELAXED, __HIP_MEMORY_SCOPE_AGENT); }
DI unsigned xb_xcc_id() { return (unsigned)__builtin_amdgcn_s_getreg((3 << 11) | 20) & 0xFu; }
#define XB_SPIN(cond, bar) do { unsigned _sp = 0; while (cond) { __builtin_amdgcn_s_sleep(1); \
    if ((++_sp & 255u) == 0u) { if (xb_ld(&(bar)[XB_TMO])) break; if (_sp > XB_SPIN_CAP) { atomicAdd(&(bar)[XB_TMO], 1u); break; } } } } while (0)
struct XcdBarrier { unsigned* bar; unsigned x; volatile LAS unsigned* st; };
DI XcdBarrier xcd_barrier_post(unsigned* bar, volatile LAS unsigned* st) {
  XcdBarrier b; b.bar = bar; b.x = xb_xcc_id(); b.st = st;
  if (threadIdx.x == 0) (void)xb_add(&bar[XB_XCNT(b.x)], 1u);
  return b;
}
DI void xcd_barrier_complete(unsigned* bar, unsigned x, unsigned& nloc, unsigned& nx) {
  const unsigned G = gridDim.x * gridDim.y * gridDim.z;
  unsigned sum, cnt, mine, sp = 0u;
  for (;;) {
    sum = 0u; cnt = 0u; mine = 0u;
#pragma unroll
    for (unsigned j = 0; j < 16; ++j) { const unsigned c = xb_ld(&bar[XB_XCNT(j)]); sum += c; cnt += (c > 0u) ? 1u : 0u; mine = (j == x) ? c : mine; }
    if (sum == G) break;
    __builtin_amdgcn_s_sleep(1);
    if ((++sp & 255u) == 0u) { if (xb_ld(&bar[XB_TMO])) break; if (sp > XB_SPIN_CAP) { atomicAdd(&bar[XB_TMO], 1u); break; } }
  }
  nloc = mine > 0u ? mine : 1u; nx = cnt > 0u ? cnt : 1u;
}
DI void xcd_barrier(const XcdBarrier& b) {
  asm volatile("s_waitcnt vmcnt(0)" ::: "memory");
  __syncthreads();
  if (threadIdx.x == 0) {
    unsigned* bar = b.bar;
    __builtin_amdgcn_s_waitcnt(0);
    unsigned nloc = b.st[0], nx = b.st[1];
    if (nloc == 0u) { xcd_barrier_complete(bar, b.x, nloc, nx); b.st[0] = nloc; b.st[1] = nx; }
    const unsigned old = xb_add(&bar[XB_XSUB(b.x)], 1u);
    const unsigned gen = old / nloc;
    if (old + 1u == (gen + 1u) * nloc) {
      __builtin_amdgcn_fence(__ATOMIC_RELEASE, "agent");
      asm volatile("s_waitcnt vmcnt(0)" ::: "memory");
      const unsigned og = xb_add(&bar[XB_TOP], 1u);
      const unsigned tg = og / nx;
      if (og + 1u == (tg + 1u) * nx) xb_add(&bar[XB_TOPGEN], 1u);
      else XB_SPIN(xb_ld(&bar[XB_TOPGEN]) == tg, bar);
      __builtin_amdgcn_fence(__ATOMIC_ACQUIRE, "agent");
      xb_add(&bar[XB_XGEN(b.x)], 1u);
      asm volatile("s_waitcnt vmcnt(0)" ::: "memory");
    } else {
      XB_SPIN(xb_ld(&bar[XB_XGEN(b.x)]) == gen, bar);
      __builtin_amdgcn_fence(__ATOMIC_ACQUIRE, "agent");
      asm volatile("s_waitcnt vmcnt(0)" ::: "memory");
    }
  }
  __syncthreads();
}

DI void row_ssq_exchange(const Params& p, int slot, int tm, int tn, float (&ssp)[2][2], char* smem, int lane, int wr, int wc) {
  const int fr = lane & 15, fq = lane >> 4;
  float* lpart = (float*)(smem + 131072);
  float* lrs = lpart + 512;
  __syncthreads();
#pragma unroll
  for (int bj = 0; bj < 2; ++bj)
#pragma unroll
    for (int n = 0; n < 2; ++n) {
      float v = ssp[bj][n];
      v += __shfl_xor(v, 16); v += __shfl_xor(v, 32);
      if (fq == 0) lpart[wr * 256 + bj * 128 + wc * 32 + n * 16 + fr] = v;
    }
  __syncthreads();
  const int t = otid();
  unsigned* xp = p.xpart + ((size_t)(slot * 320 + tm) * 4) * 256;
  if (t < 256) __hip_atomic_store(xp + tn * 256 + t, __float_as_uint(lpart[t] + lpart[256 + t]), __ATOMIC_RELAXED, __HIP_MEMORY_SCOPE_AGENT);
  asm volatile("s_waitcnt vmcnt(0)" ::: "memory");
  __syncthreads();
  if (t == 0) { unsigned* c = p.xcnt + slot * 320 + tm; (void)xb_add(c, 1u); XB_SPIN(xb_ld(c) < 4u, p.bar); }
  __syncthreads();
  if (t < 256) {
    float tot = 0.f;
#pragma unroll
    for (int q = 0; q < 4; ++q) tot += __uint_as_float(__hip_atomic_load(xp + q * 256 + t, __ATOMIC_RELAXED, __HIP_MEMORY_SCOPE_AGENT));
    lrs[t] = rsqrtf(tot * (1.f / 1024.f) + EPS);
  }
  __syncthreads();
}

DI void outproj_tile_f(const Params& p, int layer, int tm, int tn, char* smem, bool staged, const NextTile& nx) {
  f32x4 acc[2][2][4][2]; zero_acc8(acc);
  const int m0 = tm * 256, n0 = tn * 256;
  gemm8(p.woutT + ((size_t)layer * DM + n0) * DM, DM, p.hn + (size_t)m0 * DM, DM, DM, acc, smem, staged);
  if (nx.has) gemm8_stage0(nx.P, nx.ldp, nx.Q, nx.ldq, acc, smem);
  const int tid_ = otid(); const int lane = tid_ & 63, wid = __builtin_amdgcn_readfirstlane(tid_ >> 6), wr = wid >> 2, wc = wid & 3, fr = lane & 15, fq = lane >> 4;
  float ssp[2][2];
#pragma unroll
  for (int bj = 0; bj < 2; ++bj)
#pragma unroll
    for (int n = 0; n < 2; ++n) {
      const int row = m0 + bj * 128 + wc * 32 + n * 16 + fr;
      const float* hrow = (layer == 0 ? xrow(p, row) : p.out + (size_t)row * DM) + n0 + wr * 64 + fq * 4;
      bf16_t* orow = p.z + (size_t)NTOK * DM + (size_t)row * DM + n0 + wr * 64 + fq * 4;
      float ss = 0.f;
#pragma unroll
      for (int ai = 0; ai < 2; ++ai)
#pragma unroll
        for (int m = 0; m < 4; ++m) {
          const float4 hv = *(const float4*)(hrow + ai * 128 + m * 16);
          f32x4 a = acc[ai][bj][m][n];
          a[0] += hv.x; a[1] += hv.y; a[2] += hv.z; a[3] += hv.w;
          *(uint2*)(orow + ai * 128 + m * 16) = pack4(a[0], a[1], a[2], a[3]);
          ss += a[0] * a[0] + a[1] * a[1] + a[2] * a[2] + a[3] * a[3];
          acc[ai][bj][m][n] = a;
        }
      ssp[bj][n] = ss;
    }
  row_ssq_exchange(p, 2 * layer, tm, tn, ssp, smem, lane, wr, wc);
  const float* lrs = (const float*)(smem + 131072) + 512;
  const float* g = p.ple_norm_g + layer * DM + n0 + wr * 64 + fq * 4;
#pragma unroll
  for (int bj = 0; bj < 2; ++bj)
#pragma unroll
    for (int n = 0; n < 2; ++n) {
      const int tl = bj * 128 + wc * 32 + n * 16 + fr;
      const float rs = lrs[tl];
      bf16_t* brow = p.hn + (size_t)(m0 + tl) * DM + n0 + wr * 64 + fq * 4;
#pragma unroll
      for (int ai = 0; ai < 2; ++ai)
#pragma unroll
        for (int m = 0; m < 4; ++m) {
          const float4 gv = *(const float4*)(g + ai * 128 + m * 16);
          const f32x4 a = acc[ai][bj][m][n];
          *(uint2*)(brow + ai * 128 + m * 16) = pack4(a[0] * rs * gv.x, a[1] * rs * gv.y, a[2] * rs * gv.z, a[3] * rs * gv.w);
        }
    }
}

DI void ple_tile_f(const Params& p, int layer, int tm, int tn, char* smem, bool staged, const NextTile& nx) {
  f32x4 acc[2][2][4][2]; zero_acc8(acc);
  const int m0 = tm * 256, n0 = tn * 256;
  gemm8(p.wpgT + ((size_t)layer * DM + n0) * DM, DM, p.hn + (size_t)m0 * DM, DM, DM, acc, smem, staged);
  if (nx.has) gemm8_stage0(nx.P, nx.ldp, nx.Q, nx.ldq, acc, smem);
  const int tid_ = otid(); const int lane = tid_ & 63, wid = __builtin_amdgcn_readfirstlane(tid_ >> 6), wr = wid >> 2, wc = wid & 3, fr = lane & 15, fq = lane >> 4;
  float ssp[2][2];
#pragma unroll
  for (int bj = 0; bj < 2; ++bj)
#pragma unroll
    for (int n = 0; n < 2; ++n) {
      const int row = m0 + bj * 128 + wc * 32 + n * 16 + fr;
      float* orow = p.out + (size_t)row * DM + n0 + wr * 64 + fq * 4;
      const bf16_t* prow = p.z + (size_t)row * DM + n0 + wr * 64 + fq * 4;
      const bf16_t* hrow = prow + (size_t)NTOK * DM;
      float ss = 0.f;
#pragma unroll
      for (int ai = 0; ai < 2; ++ai)
#pragma unroll
        for (int m = 0; m < 4; ++m) {
          const uint2 hu = *(const uint2*)(hrow + ai * 128 + m * 16);
          const uint2 pu = *(const uint2*)(prow + ai * 128 + m * 16);
          f32x4 a = acc[ai][bj][m][n];
          a[0] = bflo(hu.x) + sigm(a[0]) * bflo(pu.x); a[1] = bfhi(hu.x) + sigm(a[1]) * bfhi(pu.x);
          a[2] = bflo(hu.y) + sigm(a[2]) * bflo(pu.y); a[3] = bfhi(hu.y) + sigm(a[3]) * bfhi(pu.y);
          if (layer == 0) *(float4*)(orow + ai * 128 + m * 16) = make_float4(a[0], a[1], a[2], a[3]);
          ss += a[0] * a[0] + a[1] * a[1] + a[2] * a[2] + a[3] * a[3];
          acc[ai][bj][m][n] = a;
        }
      ssp[bj][n] = ss;
    }
  row_ssq_exchange(p, 2 * layer + 1, tm, tn, ssp, smem, lane, wr, wc);
  const float* lrs = (const float*)(smem + 131072) + 512;
  const float* g = (layer == 0 ? p.norm_g + DM : p.final_norm_g) + n0 + wr * 64 + fq * 4;
#pragma unroll
  for (int bj = 0; bj < 2; ++bj)
#pragma unroll
    for (int n = 0; n < 2; ++n) {
      const int tl = bj * 128 + wc * 32 + n * 16 + fr;
      const float rs = lrs[tl];
      bf16_t* brow = p.hn + (size_t)(m0 + tl) * DM + n0 + wr * 64 + fq * 4;
      float* orow = p.out + (size_t)(m0 + tl) * DM + n0 + wr * 64 + fq * 4;
#pragma unroll
      for (int ai = 0; ai < 2; ++ai)
#pragma unroll
        for (int m = 0; m < 4; ++m) {
          const float4 gv = *(const float4*)(g + ai * 128 + m * 16);
          const f32x4 a = acc[ai][bj][m][n];
          if (layer == 0) *(uint2*)(brow + ai * 128 + m * 16) = pack4(a[0] * rs * gv.x, a[1] * rs * gv.y, a[2] * rs * gv.z, a[3] * rs * gv.w);
          else *(float4*)(orow + ai * 128 + m * 16) = make_float4(a[0] * rs * gv.x, a[1] * rs * gv.y, a[2] * rs * gv.z, a[3] * rs * gv.w);
        }
    }
}

__global__ void __launch_bounds__(512, 2) mega_fwd(Params p) {
  __shared__ __attribute__((aligned(16))) char smem[SMEM_BYTES];
  cg::grid_group grid = cg::this_grid();
  const int nb = gridDim.x;

  if (threadIdx.x < 4) ((unsigned*)(smem + SM_XB))[threadIdx.x] = 0u;
  phase_prep(p, smem);
  phase_norm(p, 0, 0);
  grid.sync();
  const XcdBarrier xb = xcd_barrier_post(p.bar, (volatile LAS unsigned*)(lds_cptr)(smem + SM_XB));
#pragma unroll 1
  for (int layer = 0; layer < 2; ++layer) {
    {
      bool staged = false;
      for (int v = blockIdx.x; v < 18 * 256; v += nb) {
        const int b = v & 255, k = v >> 8, x = b & 7, j = b >> 3, st = k * 8 + x;
        if (st >= 140) continue;
        const int tm = (st / 7) * 16 + (j >> 1), tn = (st % 7) * 2 + (j & 1);
        NextTile nx;
        {
          const int v2 = v + nb, b2 = v2 & 255, k2 = v2 >> 8, st2 = k2 * 8 + (b2 & 7), j2 = b2 >> 3;
          nx.has = (v2 < 18 * 256) && (st2 < 140);
          const int tm2 = (st2 / 7) * 16 + (j2 >> 1), tn2 = (st2 % 7) * 2 + (j2 & 1);
          nx.P = p.winT + ((size_t)layer * DINP + tn2 * 256) * DM; nx.Q = p.hn + (size_t)tm2 * 256 * DM; nx.ldp = DM; nx.ldq = DM;
        }
        inproj_tile(p, layer, tm, tn, smem, staged, nx);
        staged = nx.has;
      }
    }
    xcd_barrier(xb);
    {
      unsigned* upc = p.xcnt + 4 * 320 + layer * 32;
      bool pub = false, acq = false;
      for (int v = blockIdx.x; v < 5 * 1280; v += nb) {
        if (v >= 2560 && !pub) {
          pub = true;
          asm volatile("s_waitcnt vmcnt(0)" ::: "memory");
          __syncthreads();
          if (threadIdx.x == 0) {
            __builtin_amdgcn_fence(__ATOMIC_RELEASE, "agent");
            asm volatile("s_waitcnt vmcnt(0)" ::: "memory");
            (void)xb_add(upc, 1u);
          }
        }
        if (v >= 5120 && !acq) {
          acq = true;
          if (threadIdx.x == 0) {
            XB_SPIN(xb_ld(upc) < (unsigned)nb, p.bar);
            __builtin_amdgcn_fence(__ATOMIC_ACQUIRE, "agent");
            asm volatile("s_waitcnt vmcnt(0)" ::: "memory");
          }
          __syncthreads();
        }
        if (v < 1280) attn_item<0>(p, layer, v, smem);
        else if (v < 2560) { const int u = v - 1280; upproj_tile(p, layer, u >> 2, u & 3, smem); }
        else if (v < 3840) attn_item<1>(p, layer, v - 2560, smem);
        else if (v < 5120) attn_item<2>(p, layer, v - 3840, smem);
        else attn_item<3>(p, layer, v - 5120, smem);
      }
    }
    xcd_barrier(xb);
    {
      bool staged = false;
      for (int v = blockIdx.x; v < 2560; v += nb) {
        const int vv = v < 1280 ? v : v - 1280;
        const int b = vv & 255, k = vv >> 8, x = b & 7, j = b >> 3, st = k * 8 + x;
        NextTile nx;
        {
          const int v2 = v + nb, vv2 = v2 < 1280 ? v2 : v2 - 1280;
          const int b2 = vv2 & 255, st2 = (vv2 >> 8) * 8 + (b2 & 7), j2 = b2 >> 3, tm2 = st2 * 8 + (j2 >> 2), tn2 = j2 & 3;
          nx.has = v2 < 2560;
          if (v2 < 1280) { nx.P = p.woutT + ((size_t)layer * DM + tn2 * 256) * DM; nx.Q = p.hn + (size_t)tm2 * 256 * DM; nx.ldp = DM; nx.ldq = DM; }
          else { nx.P = p.wppT + ((size_t)layer * DM + tn2 * 256) * 256; nx.Q = p.pb + ((size_t)layer * NTOK + tm2 * 256) * 256; nx.ldp = 256; nx.ldq = 256; }
        }
        if (v < 1280) outproj_tile_f(p, layer, st * 8 + (j >> 2), j & 3, smem, staged, nx);
        else pproj_tile(p, layer, st * 8 + (j >> 2), j & 3, smem, staged, nx);
        staged = nx.has;
      }
    }
    xcd_barrier(xb);
    {
      bool staged = false;
      for (int v = blockIdx.x; v < 1280; v += nb) {
        const int b = v & 255, k = v >> 8, x = b & 7, j = b >> 3, st = k * 8 + x;
        NextTile nx;
        {
          const int v2 = v + nb, b2 = v2 & 255, st2 = (v2 >> 8) * 8 + (b2 & 7), j2 = b2 >> 3, tm2 = st2 * 8 + (j2 >> 2), tn2 = j2 & 3;
          nx.has = v2 < 1280;
          nx.P = p.wpgT + ((size_t)layer * DM + tn2 * 256) * DM; nx.Q = p.hn + (size_t)tm2 * 256 * DM; nx.ldp = DM; nx.ldq = DM;
        }
        ple_tile_f(p, layer, st * 8 + (j >> 2), j & 3, smem, staged, nx);
        staged = nx.has;
      }
    }
    if (layer == 0) xcd_barrier(xb);
  }
}

extern "C" void kernel_launch(void* const* d_in, const int* in_sizes, int n_in, void* d_out, int out_size, void* d_ws, size_t ws_size,
                              hipStream_t stream) {
  Params p{};
  p.x_prompt = (const float*)d_in[0]; p.x_sample = (const float*)d_in[1]; p.p_prompt = (const float*)d_in[2]; p.p_sample = (const float*)d_in[3];
  p.norm_g = (const float*)d_in[4]; p.w_in = (const float*)d_in[5]; p.a_lambda = (const float*)d_in[6]; p.a_subln_g = (const float*)d_in[7];
  p.b_sink = (const float*)d_in[8]; p.c_rpb = (const float*)d_in[9]; p.d_q_norm_g = (const float*)d_in[10]; p.d_kv_norm_g = (const float*)d_in[11];
  p.d_w_uq = (const float*)d_in[12]; p.d_w_ukv = (const float*)d_in[13]; p.w_out = (const float*)d_in[14]; p.ple_norm_g = (const float*)d_in[15];
  p.w_ple_gate = (const float*)d_in[16]; p.w_ple_proj = (const float*)d_in[17]; p.final_norm_g = (const float*)d_in[18];
  p.out = (float*)d_out;
  char* w = (char*)d_ws; size_t off = 0;
  auto carve = [&](size_t bytes) { char* r = w + off; off += (bytes + 255) & ~(size_t)255; return r; };
  p.hn = (bf16_t*)carve((size_t)NTOK * DM * 2);
  p.z = (bf16_t*)carve((size_t)NTOK * ZLD * 2);
  p.qd = (bf16_t*)carve((size_t)NTOK * 384 * 2);
  p.pb = (bf16_t*)carve((size_t)2 * NTOK * 256 * 2);
  p.kvd = (bf16_t*)carve((size_t)NTOK * 512 * 2);
  p.winT = (bf16_t*)carve((size_t)2 * DINP * DM * 2);
  p.wuqT = (bf16_t*)carve((size_t)2 * 384 * 256 * 2);
  p.wukvT = (bf16_t*)carve((size_t)2 * 512 * 128 * 2);
  p.woutT = (bf16_t*)carve((size_t)2 * DM * DM * 2);
  p.wpgT = (bf16_t*)carve((size_t)2 * DM * DM * 2);
  p.wppT = (bf16_t*)carve((size_t)2 * DM * 256 * 2);
  p.cs32 = (float2*)carve((size_t)8192 * 16 * 8);
  p.cs64 = (float2*)carve((size_t)8192 * 32 * 8);
  p.lam = (float*)carve(256);
  p.bar = (unsigned*)carve((size_t)XCD_BAR_WORDS * 4);
  p.xpart = (unsigned*)carve((size_t)4 * 320 * 4 * 256 * 4);
  p.xcnt = (unsigned*)carve((size_t)(4 * 320 + 64) * 4);
  if (off > ws_size) { fprintf(stderr, "workspace too small: need %zu have %zu\n", off, ws_size); return; }
  static int grid_blocks = 0;
  if (!grid_blocks) {
    int dev = 0, cus = 0, per_cu = 0;
    hipGetDevice(&dev);
    hipDeviceGetAttribute(&cus, hipDeviceAttributeMultiprocessorCount, dev);
    hipOccupancyMaxActiveBlocksPerMultiprocessor(&per_cu, mega_fwd, NTHR, 0);
    if (per_cu > 1) per_cu = 1;
    if (per_cu < 1) per_cu = 1;
    grid_blocks = cus * per_cu;
  }
  void* args[] = {&p};
  hipError_t e = hipLaunchCooperativeKernel((void*)mega_fwd, dim3(grid_blocks), dim3(NTHR), args, 0, stream);
  if (e != hipSuccess) fprintf(stderr, "cooperative launch failed: %s (grid %d)\n", hipGetErrorString(e), grid_blocks);
}
```
